# Optimizing an MI355X kernel written in HIP

```python
import math
import jax
import jax.numpy as jnp
from jax import lax
import numpy as np

D_MODEL = 4096
BATCH = 1
SEQ = 8192
DEPTH = 4

GRID_W = 64
CTX_LEN = 256
HEAD_DIM = 128
W_MIX = 3 * D_MODEL // 8
N_Q_HEADS = W_MIX // HEAD_DIM
N_KV_HEADS = N_Q_HEADS // 3
GQA_GROUP = N_Q_HEADS // N_KV_HEADS
KV_W = N_KV_HEADS * HEAD_DIM
Q_BLOCK = 128
ROPE_THETA = 10000.0
LRU_BLOCKS = W_MIX // HEAD_DIM
LRU_BLOCK_W = W_MIX // LRU_BLOCKS
LRU_C = 8.0
CONV_A = 4
CONV_B = 3
HYENA_ORDER = 2
HYENA_BANDS = 16
HYENA_EMB = 2 * HYENA_BANDS + 1
HYENA_HIDDEN = 64
HYENA_FAST_DECAY = 0.3
HYENA_SLOW_DECAY = 1.5
HYENA_TARGET = 1e-2
D_FF = D_MODEL
MOD_RANK = 256
N_MOD = 9
N_BRANCH = 3
EPS = 1e-6

COL_AX = 0
COL_CK = COL_AX + W_MIX
COL_CV = COL_CK + KV_W
COL_AG = COL_CV + KV_W
COL_B = COL_AG + W_MIX
COL_CQ = COL_B + 3 * W_MIX
COL_G = COL_CQ + W_MIX
N_IN = COL_G + N_BRANCH * D_MODEL

kernel_name = 'hybrid_rglru_hyena_gqa_dit'


def rms_norm(x, g):
    xf = x.astype(jnp.float32)
    y = xf * lax.rsqrt(jnp.mean(xf * xf, axis=-1, keepdims=True) + EPS)
    return (y * g.astype(jnp.float32)).astype(x.dtype)


def modulate(x, shift, scale):
    return x * (1.0 + scale) + shift


def ada_modulation(s, w_down, w_up, b):
    m = (s @ w_down) @ w_up + b
    return m.reshape(s.shape[0], N_MOD, 1, D_MODEL)


def swiglu(x, w_gu, w_down):
    a, b = jnp.split(x @ w_gu, 2, axis=-1)
    return (jax.nn.silu(a) * b) @ w_down


def ffn_sublayer(x, shift, scale, gate, g_norm, w_gu, w_down):
    return x + 0.5 * gate * swiglu(modulate(rms_norm(x, g_norm), shift, scale), w_gu, w_down)


def dw_conv(x, w):
    K = w.shape[0]
    L = x.shape[1]
    left = (K - 1) // 2
    xp = jnp.pad(x, ((0, 0), (left, K - 1 - left), (0, 0)))
    y = xp[:, 0:L] * w[0]
    for k in range(1, K):
        y = y + xp[:, k:k + L] * w[k]
    return y


def axial_rope_tables(n_tokens):
    rows = n_tokens // GRID_W
    row = jnp.repeat(jnp.arange(rows, dtype=jnp.float32), GRID_W)
    col = jnp.tile(jnp.arange(GRID_W, dtype=jnp.float32), rows)
    n_pairs = HEAD_DIM // 4
    inv = ROPE_THETA ** (-jnp.arange(n_pairs, dtype=jnp.float32) / n_pairs)
    ang = jnp.concatenate([row[:, None] * inv, col[:, None] * inv], axis=-1)
    return jnp.cos(ang), jnp.sin(ang)


def rope_2d(t, cos, sin):
    tp = t.reshape(*t.shape[:-1], HEAD_DIM // 2, 2).astype(jnp.float32)
    c = cos[None, :, None, :]
    s = sin[None, :, None, :]
    t0, t1 = tp[..., 0], tp[..., 1]
    out = jnp.stack([t0 * c - t1 * s, t0 * s + t1 * c], axis=-1)
    return out.reshape(t.shape).astype(t.dtype)


def _lin_combine(left, right):
    a1, b1 = left
    a2, b2 = right
    return a1 * a2, a2 * b1 + b2


def rglru(x, w_a, b_a, w_x, b_x, lam, h0, reverse):
    bsz, L, W = x.shape
    xf = x.astype(jnp.float32)
    xb = xf.reshape(bsz, L, LRU_BLOCKS, LRU_BLOCK_W)
    r = jax.nn.sigmoid(jnp.einsum('blnd,nde->blne', xb, w_a.astype(jnp.float32)).reshape(bsz, L, W)
                       + b_a.astype(jnp.float32))
    i = jax.nn.sigmoid(jnp.einsum('blnd,nde->blne', xb, w_x.astype(jnp.float32)).reshape(bsz, L, W)
                       + b_x.astype(jnp.float32))
    log_a = -LRU_C * r * jax.nn.softplus(-lam.astype(jnp.float32))
    a = jnp.exp(log_a)
    b = jnp.sqrt(-jnp.expm1(2.0 * log_a)) * (i * xf)
    first = -1 if reverse else 0
    b = b.at[:, first].add(a[:, first] * h0)
    _, h = lax.associative_scan(_lin_combine, (a, b), axis=1, reverse=reverse)
    return h


def hyena_kernel(L, fw1, fb1, freq, fw2, fb2, fw3):
    f32 = jnp.float32
    t_idx = jnp.arange(L, dtype=f32)
    t_lin = t_idx / max(L - 1, 1)
    bands = jnp.linspace(1e-4, HYENA_BANDS - 1, HYENA_BANDS, dtype=f32)
    ang = (2.0 * math.pi / L) * t_idx[:, None] * bands[None, :]
    z = jnp.concatenate([t_lin[:, None], jnp.cos(ang), -jnp.sin(ang)], axis=-1)
    fr = freq.astype(f32)
    h = jnp.sin(fr * (z @ fw1.astype(f32) + fb1.astype(f32)))
    h = jnp.sin(fr * (h @ fw2.astype(f32) + fb2.astype(f32)))
    h = (h @ fw3.astype(f32)).reshape(L, HYENA_ORDER, 2, W_MIX)
    deltas = jnp.linspace(math.log(HYENA_TARGET) / HYENA_SLOW_DECAY,
                          math.log(HYENA_TARGET) / HYENA_FAST_DECAY, W_MIX, dtype=f32)
    h = h * jnp.exp(-t_lin[:, None] * jnp.abs(deltas))[:, None, None, :]
    hf, hb = h[:, :, 0], h[:, :, 1]
    k = jnp.concatenate([hf[:1] + hb[:1], hf[1:], jnp.zeros_like(hf[:1]), hb[:0:-1]], axis=0)
    k = k * lax.rsqrt(jnp.sum(k * k, axis=0, keepdims=True) + EPS)
    return jnp.fft.rfft(k, axis=0)


def fft_long_conv(u, kf):
    L = u.shape[1]
    uf = jnp.fft.rfft(u, n=2 * L, axis=1)
    return jnp.fft.irfft(uf * kf[None], n=2 * L, axis=1)[:, :L]


def hyena_seq(pb, conv_w, kf, skip):
    u = dw_conv(pb, conv_w).astype(jnp.float32)
    v, x1, x2 = jnp.split(u, 3, axis=-1)
    sk = skip.astype(jnp.float32)
    z = v
    for o, gate in enumerate((x1, x2)):
        z = gate * (fft_long_conv(z, kf[:, o]) + sk[o] * z)
    return z.astype(pb.dtype)


def attend(q, k, v):
    bsz, Lq = q.shape[:2]
    nb = Lq // Q_BLOCK
    qb = q.reshape(bsz, nb, Q_BLOCK, N_KV_HEADS, GQA_GROUP, HEAD_DIM).transpose(1, 0, 2, 3, 4, 5)
    scale = HEAD_DIM ** -0.5

    def block(qi):
        s = jnp.einsum('bqkgd,btkd->bkgqt', qi, k, preferred_element_type=jnp.float32) * scale
        pr = jax.nn.softmax(s, axis=-1).astype(v.dtype)
        return jnp.einsum('bkgqt,btkd->bqkgd', pr, v)

    o = lax.map(block, qb)
    return o.transpose(1, 0, 2, 3, 4, 5).reshape(bsz, Lq, N_Q_HEADS * HEAD_DIM)


def heads(t, n):
    return t.reshape(*t.shape[:-1], n, HEAD_DIM)


def merge_branches(pj, ya, yb, yc, p):
    g = jax.nn.sigmoid(pj[..., COL_G:]).reshape(*pj.shape[:-1], N_BRANCH, D_MODEL)
    m = (g[..., 0, :] * (ya @ p['w_branch_a'])
         + g[..., 1, :] * (yb @ p['w_branch_b'])
         + g[..., 2, :] * (yc @ p['w_branch_c']))
    return m @ p['w_out']


def token_mixer(uc, ul, p, ctx_out, cos, sin):
    S = ul.shape[1]
    C = uc.shape[1]
    pl = ul @ p['w_in']
    pc = uc @ (p['w_in'] if ctx_out else p['w_in'][:, :COL_AG])

    xa_c = dw_conv(pc[..., COL_AX:COL_AX + W_MIX], p['lru_conv'])
    xa_l = dw_conv(pl[..., COL_AX:COL_AX + W_MIX], p['lru_conv'])
    h0 = jnp.zeros((uc.shape[0], W_MIX), jnp.float32)
    hs_c = []
    hs_l = []
    for d, rev in enumerate((False, True)):
        gp = (p['lru_w_a'][d], p['lru_b_a'][d], p['lru_w_x'][d], p['lru_b_x'][d], p['lru_lambda'][d])
        h_c = rglru(xa_c, *gp, h0, rev)
        h_l = rglru(xa_l, *gp, h_c[:, 0] if rev else h_c[:, -1], rev)
        hs_c.append(h_c)
        hs_l.append(h_l)
    ya_l = (hs_l[0] + hs_l[1]).astype(ul.dtype) * jax.nn.gelu(pl[..., COL_AG:COL_AG + W_MIX])

    kf_l = hyena_kernel(S, p['hy_fw1'], p['hy_fb1'], p['hy_freq'], p['hy_fw2'], p['hy_fb2'], p['hy_fw3'])
    yb_l = hyena_seq(pl[..., COL_B:COL_B + 3 * W_MIX], p['hy_conv'], kf_l, p['hy_skip'])

    kc = rms_norm(heads(pc[..., COL_CK:COL_CK + KV_W], N_KV_HEADS), p['k_norm'])
    vc = heads(pc[..., COL_CV:COL_CV + KV_W], N_KV_HEADS)
    ql = rope_2d(rms_norm(heads(pl[..., COL_CQ:COL_CQ + W_MIX], N_Q_HEADS), p['q_norm']), cos, sin)
    kl = rope_2d(rms_norm(heads(pl[..., COL_CK:COL_CK + KV_W], N_KV_HEADS), p['k_norm']), cos, sin)
    vl = heads(pl[..., COL_CV:COL_CV + KV_W], N_KV_HEADS)
    yc_l = attend(ql, jnp.concatenate([kc, kl], axis=1), jnp.concatenate([vc, vl], axis=1))

    out_l = merge_branches(pl, ya_l, yb_l, yc_l, p)
    if not ctx_out:
        return None, out_l

    ya_c = (hs_c[0] + hs_c[1]).astype(uc.dtype) * jax.nn.gelu(pc[..., COL_AG:COL_AG + W_MIX])
    kf_c = hyena_kernel(C, p['hy_fw1'], p['hy_fb1'], p['hy_freq'], p['hy_fw2'], p['hy_fb2'], p['hy_fw3'])
    yb_c = hyena_seq(pc[..., COL_B:COL_B + 3 * W_MIX], p['hy_conv'], kf_c, p['hy_skip'])
    qc = rms_norm(heads(pc[..., COL_CQ:COL_CQ + W_MIX], N_Q_HEADS), p['q_norm'])
    yc_c = attend(qc, kc, vc)
    out_c = merge_branches(pc, ya_c, yb_c, yc_c, p)
    return out_c, out_l


def setup_inputs(seed: int = 0) -> dict:
    key = jax.random.key(seed)
    keys = jax.random.split(key, 40)
    kit = iter(range(40))
    f32 = jnp.float32

    def nrm(shape, scale):
        return jax.random.normal(keys[next(kit)], shape, f32) * scale

    def gain(shape):
        return 1.0 + 0.01 * jax.random.normal(keys[next(kit)], shape, f32)

    x = nrm((BATCH, SEQ, D_MODEL), 1.0)
    c = nrm((BATCH, D_MODEL), 1.0)
    ctx = nrm((BATCH, CTX_LEN, D_MODEL), 1.0)
    c_ctx = nrm((D_MODEL,), 1.0)
    w_mod_down = nrm((DEPTH, D_MODEL, MOD_RANK), D_MODEL ** -0.5)
    w_mod_up = nrm((DEPTH, MOD_RANK, N_MOD * D_MODEL), 0.5 * MOD_RANK ** -0.5)
    b_mod = nrm((DEPTH, N_MOD * D_MODEL), 0.01)
    norm_ffn1 = gain((DEPTH, D_MODEL))
    norm_mix = gain((DEPTH, D_MODEL))
    norm_ffn2 = gain((DEPTH, D_MODEL))
    ffn1_w_in = nrm((DEPTH, D_MODEL, 2 * D_FF), D_MODEL ** -0.5)
    ffn1_w_out = nrm((DEPTH, D_FF, D_MODEL), D_FF ** -0.5)
    ffn2_w_in = nrm((DEPTH, D_MODEL, 2 * D_FF), D_MODEL ** -0.5)
    ffn2_w_out = nrm((DEPTH, D_FF, D_MODEL), D_FF ** -0.5)
    w_in = nrm((DEPTH, D_MODEL, N_IN), D_MODEL ** -0.5)
    lru_conv = nrm((DEPTH, CONV_A, W_MIX), CONV_A ** -0.5)
    lru_w_a = nrm((DEPTH, 2, LRU_BLOCKS, LRU_BLOCK_W, LRU_BLOCK_W), LRU_BLOCK_W ** -0.5)
    lru_b_a = nrm((DEPTH, 2, W_MIX), 0.01)
    lru_w_x = nrm((DEPTH, 2, LRU_BLOCKS, LRU_BLOCK_W, LRU_BLOCK_W), LRU_BLOCK_W ** -0.5)
    lru_b_x = nrm((DEPTH, 2, W_MIX), 0.01)
    u = jax.random.uniform(keys[next(kit)], (DEPTH, 2, W_MIX), f32, 0.9, 0.999)
    s = u ** (1.0 / LRU_C)
    lru_lambda = jnp.log(s) - jnp.log1p(-s)
    hy_conv = nrm((DEPTH, CONV_B, 3 * W_MIX), CONV_B ** -0.5)
    hy_fw1 = nrm((DEPTH, HYENA_EMB, HYENA_HIDDEN), HYENA_EMB ** -0.5)
    hy_fb1 = nrm((DEPTH, HYENA_HIDDEN), 0.01)
    hy_freq = gain((DEPTH, HYENA_HIDDEN))
    hy_fw2 = nrm((DEPTH, HYENA_HIDDEN, HYENA_HIDDEN), HYENA_HIDDEN ** -0.5)
    hy_fb2 = nrm((DEPTH, HYENA_HIDDEN), 0.01)
    hy_fw3 = nrm((DEPTH, HYENA_HIDDEN, HYENA_ORDER * 2 * W_MIX), HYENA_HIDDEN ** -0.5)
    hy_skip = nrm((DEPTH, HYENA_ORDER, W_MIX), 0.1)
    q_norm = gain((DEPTH, HEAD_DIM))
    k_norm = gain((DEPTH, HEAD_DIM))
    w_branch_a = nrm((DEPTH, W_MIX, D_MODEL), W_MIX ** -0.5)
    w_branch_b = nrm((DEPTH, W_MIX, D_MODEL), W_MIX ** -0.5)
    w_branch_c = nrm((DEPTH, W_MIX, D_MODEL), W_MIX ** -0.5)
    w_out = nrm((DEPTH, D_MODEL, D_MODEL), D_MODEL ** -0.5)
    final_norm = gain((D_MODEL,))
    return {'x': x, 'c': c, 'ctx': ctx, 'c_ctx': c_ctx,
            'w_mod_down': w_mod_down, 'w_mod_up': w_mod_up, 'b_mod': b_mod,
            'norm_ffn1': norm_ffn1, 'norm_mix': norm_mix, 'norm_ffn2': norm_ffn2,
            'ffn1_w_in': ffn1_w_in, 'ffn1_w_out': ffn1_w_out, 'ffn2_w_in': ffn2_w_in, 'ffn2_w_out': ffn2_w_out,
            'w_in': w_in, 'lru_conv': lru_conv, 'lru_w_a': lru_w_a, 'lru_b_a': lru_b_a,
            'lru_w_x': lru_w_x, 'lru_b_x': lru_b_x, 'lru_lambda': lru_lambda,
            'hy_conv': hy_conv, 'hy_fw1': hy_fw1, 'hy_fb1': hy_fb1, 'hy_freq': hy_freq,
            'hy_fw2': hy_fw2, 'hy_fb2': hy_fb2, 'hy_fw3': hy_fw3, 'hy_skip': hy_skip,
            'q_norm': q_norm, 'k_norm': k_norm,
            'w_branch_a': w_branch_a, 'w_branch_b': w_branch_b, 'w_branch_c': w_branch_c,
            'w_out': w_out, 'final_norm': final_norm}


def reference(x, c, ctx, c_ctx, w_mod_down, w_mod_up, b_mod, norm_ffn1, norm_mix, norm_ffn2,
              ffn1_w_in, ffn1_w_out, ffn2_w_in, ffn2_w_out, w_in, lru_conv, lru_w_a, lru_b_a,
              lru_w_x, lru_b_x, lru_lambda, hy_conv, hy_fw1, hy_fb1, hy_freq, hy_fw2, hy_fb2,
              hy_fw3, hy_skip, q_norm, k_norm, w_branch_a, w_branch_b, w_branch_c, w_out, final_norm):
    cos, sin = axial_rope_tables(x.shape[1])
    s_lat = jax.nn.silu(c)
    s_ctx = jax.nn.silu(c_ctx)[None, :]
    xl, xc = x, ctx
    for i in range(DEPTH):
        ctx_out = i < DEPTH - 1
        p = {'w_in': w_in[i], 'lru_conv': lru_conv[i], 'lru_w_a': lru_w_a[i], 'lru_b_a': lru_b_a[i],
             'lru_w_x': lru_w_x[i], 'lru_b_x': lru_b_x[i], 'lru_lambda': lru_lambda[i],
             'hy_conv': hy_conv[i], 'hy_fw1': hy_fw1[i], 'hy_fb1': hy_fb1[i], 'hy_freq': hy_freq[i],
             'hy_fw2': hy_fw2[i], 'hy_fb2': hy_fb2[i], 'hy_fw3': hy_fw3[i], 'hy_skip': hy_skip[i],
             'q_norm': q_norm[i], 'k_norm': k_norm[i], 'w_branch_a': w_branch_a[i],
             'w_branch_b': w_branch_b[i], 'w_branch_c': w_branch_c[i], 'w_out': w_out[i]}
        ml = ada_modulation(s_lat, w_mod_down[i], w_mod_up[i], b_mod[i])
        mc = ada_modulation(s_ctx, w_mod_down[i], w_mod_up[i], b_mod[i])
        xl = ffn_sublayer(xl, ml[:, 0], ml[:, 1], ml[:, 2], norm_ffn1[i], ffn1_w_in[i], ffn1_w_out[i])
        xc = ffn_sublayer(xc, mc[:, 0], mc[:, 1], mc[:, 2], norm_ffn1[i], ffn1_w_in[i], ffn1_w_out[i])
        ul = modulate(rms_norm(xl, norm_mix[i]), ml[:, 3], ml[:, 4])
        uc = modulate(rms_norm(xc, norm_mix[i]), mc[:, 3], mc[:, 4])
        yc, yl = token_mixer(uc, ul, p, ctx_out, cos, sin)
        xl = xl + ml[:, 5] * yl
        xl = ffn_sublayer(xl, ml[:, 6], ml[:, 7], ml[:, 8], norm_ffn2[i], ffn2_w_in[i], ffn2_w_out[i])
        if ctx_out:
            xc = xc + mc[:, 5] * yc
            xc = ffn_sublayer(xc, mc[:, 6], mc[:, 7], mc[:, 8], norm_ffn2[i], ffn2_w_in[i], ffn2_w_out[i])
    return rms_norm(xl, final_norm)
```

```cpp
#include <hip/hip_runtime.h>
#include <hip/hip_bf16.h>
#include <cstdio>
#include <cstdint>
namespace pg8 {
#define PG8_LAS __attribute__((address_space(3)))
typedef unsigned short bf16_t;
typedef short bf16x8 __attribute__((ext_vector_type(8)));
typedef float f32x4 __attribute__((ext_vector_type(4)));
typedef unsigned u32x4 __attribute__((ext_vector_type(4)));
constexpr int BM = 256, BK = 64, HALF = 128, HTB = HALF * BK * 2  , STAGE_BYTES = 8 * HTB, NXCD = 8, WGM = 8;

__host__ __device__ __forceinline__ int lds_byte(int r, int c) { const int st = (r >> 4) * 2 + (c >> 5), rr = r & 15, cc = c & 31, ob = rr * 64 + cc * 2; return st * 1024 + (ob ^ (((ob >> 9) & 1) << 5)); }
__host__ __device__ __forceinline__ void stage_rc(int b, int& R, int& C) { const int st = b / 1024, sb = b % 1024, swz = sb ^ (((sb >> 9) & 1) << 5); R = (st >> 1) * 16 + swz / 64; C = (st & 1) * 32 + (swz % 64) / 2; }
__host__ __device__ __forceinline__ int perm32(int rho) { const int n = rho >> 4, i = rho & 15; return 8 * (i >> 2) + 4 * n + (i & 3); }

struct Unit { int pm, pn; };
struct Gemm { const bf16_t* A; const bf16_t* Bt; int M, N, K; };

struct StaticOrder {
    int nM, nN, nwg, G, c, wgm = WGM;
    __host__ __device__ void init(int M, int N, int G_, int c_) { nM = M / BM; nN = N / BM; nwg = nM * nN; G = G_; c = c_; }
    __host__ __device__ bool next(int i, Unit& u) const {
        const long L = (long)i * G + c; if (L >= nwg) return false;
        int wgid = (int)L; { const int q = nwg / NXCD, r = nwg % NXCD, xcd = wgid % NXCD, off = wgid / NXCD; wgid = (xcd < r ? xcd * (q + 1) : r * (q + 1) + (xcd - r) * q) + off; }
        const int nig = wgm * nN, gid = wgid / nig, fm = gid * wgm, gsz = (nM - fm) < wgm ? (nM - fm) : wgm;
        u.pm = fm + ((wgid % nig) % gsz); u.pn = (wgid % nig) / gsz; return true;
    }
    __device__ __forceinline__ void a_ready(const Unit&) const {}
    __device__ __forceinline__ void done(const Unit&) const {}
};
struct SplitNOrder {
    int nM, nNs, ns, nwg, G, c, wgm;
    __host__ __device__ void init(int M, int N, int NS, int G_, int c_, int wgm_) { nM = M / BM; ns = NS; nNs = (N / BM) / NS; nwg = nM * nNs * NS; G = G_; c = c_; wgm = wgm_; }
    __host__ __device__ bool next(int i, Unit& u) const {
        const long L = (long)i * G + c; if (L >= nwg) return false;
        int wgid = (int)L; { const int q = nwg / NXCD, r = nwg % NXCD, xcd = wgid % NXCD, off = wgid / NXCD; wgid = (xcd < r ? xcd * (q + 1) : r * (q + 1) + (xcd - r) * q) + off; }
        const int nMv = nM * ns, nig = wgm * nNs, gid = wgid / nig, fm = gid * wgm, gsz = (nMv - fm) < wgm ? (nMv - fm) : wgm;
        const int pv = fm + ((wgid % nig) % gsz), pnl = (wgid % nig) / gsz, slab = pv / nM;
        u.pm = pv - slab * nM; u.pn = slab * nNs + pnl; return true;
    }
    __device__ __forceinline__ void a_ready(const Unit&) const {}
    __device__ __forceinline__ void done(const Unit&) const {}
};
__device__ __forceinline__ unsigned cvt_pk_bf16(float lo, float hi) { unsigned r; asm volatile("v_cvt_pk_bf16_f32 %0, %1, %2" : "=v"(r) : "v"(lo), "v"(hi)); return r; }
typedef float f32x2 __attribute__((ext_vector_type(2)));
template <int MASK> __device__ __forceinline__ float swz_xor(float v) { return __int_as_float(__builtin_amdgcn_ds_swizzle(__float_as_int(v), (MASK << 10) | 0x1f)); }
__device__ __forceinline__ float fast_sigmoid(float x) { return __builtin_amdgcn_rcpf(1.0f + __expf(-x)); }
__device__ __forceinline__ float gelu_tanh(float x) { const float u = 0.7978845608028654f * (x + 0.044715f * x * x * x); return x * fast_sigmoid(2.0f * u); }
__device__ __forceinline__ float bf_lo(unsigned w) { return __uint_as_float(w << 16); }
__device__ __forceinline__ float bf_hi(unsigned w) { return __uint_as_float(w & 0xffff0000u); }

struct EpiSwiglu {
    static constexpr bool PERM = true, AFTER_DRAIN = false;
    bf16_t* O; int ldo;
    __device__ __forceinline__ void operator()(const f32x4 (&acc)[2][2][4][2], const Unit& u, int wr, int wc, int fr, int fq) const {
        const int row0 = u.pm * BM + wr * 64 + fr, col0 = u.pn * HALF + wc * 32 + 8 * fq;
#pragma unroll
        for (int ai = 0; ai < 2; ++ai)
#pragma unroll
            for (int m = 0; m < 4; ++m) { bf16_t* rowp = O + (size_t)(row0 + ai * HALF + m * 16) * ldo + col0;
                float v[8];
#pragma unroll
                for (int n = 0; n < 2; ++n)
#pragma unroll
                    for (int j = 0; j < 4; ++j) { const float a = acc[ai][0][m][n][j], b = acc[ai][1][m][n][j]; v[n * 4 + j] = a * fast_sigmoid(a) * b; }
                u32x4 w; w.x = cvt_pk_bf16(v[0], v[1]); w.y = cvt_pk_bf16(v[2], v[3]); w.z = cvt_pk_bf16(v[4], v[5]); w.w = cvt_pk_bf16(v[6], v[7]);
                *(u32x4*)rowp = w; }
    }
};
struct EpiResid {
    static constexpr bool PERM = true, AFTER_DRAIN = false;
    bf16_t* Dd; int ldd; const float* gate_lat; const float* gate_ctx; float coef;
    __device__ __forceinline__ void operator()(const f32x4 (&acc)[2][2][4][2], const Unit& u, int wr, int wc, int fr, int fq) const {
        const int row0 = u.pm * BM + wr * 64 + fr, col0 = u.pn * BM + wc * 32 + 8 * fq;
        const float* gate = (u.pm == 0) ? gate_ctx : gate_lat;
        f32x4 gv[2][2];
#pragma unroll
        for (int bj = 0; bj < 2; ++bj)
#pragma unroll
            for (int n = 0; n < 2; ++n) gv[bj][n] = *(const f32x4*)(gate + col0 + bj * HALF + 4 * n) * coef;
#pragma unroll
        for (int ai = 0; ai < 2; ++ai)
#pragma unroll
            for (int m = 0; m < 4; ++m) { bf16_t* rowp = Dd + (size_t)(row0 + ai * HALF + m * 16) * ldd + col0;
#pragma unroll
                for (int bj = 0; bj < 2; ++bj) { const f32x4 v0 = gv[bj][0] * acc[ai][bj][m][0], v1 = gv[bj][1] * acc[ai][bj][m][1];
                    u32x4 w; w.x = cvt_pk_bf16(v0[0], v0[1]); w.y = cvt_pk_bf16(v0[2], v0[3]); w.z = cvt_pk_bf16(v1[0], v1[1]); w.w = cvt_pk_bf16(v1[2], v1[3]);
                    *(u32x4*)(rowp + bj * HALF) = w; } }
    }
};
struct EpiWin {
    static constexpr bool PERM = true, AFTER_DRAIN = false;
    bf16_t* O; int ldo; int pn0;
    __device__ __forceinline__ void operator()(const f32x4 (&acc)[2][2][4][2], const Unit& u, int wr, int wc, int fr, int fq) const {
        const int pn = u.pn + pn0, row0 = u.pm * BM + wr * 64 + fr, col0 = pn * BM + wc * 32 + 8 * fq;
        const bool sig = pn >= 40, gel = (pn >= 10 && pn < 16);
        const float kx = sig ? 1.0f : (gel ? 2.0f * 0.7978845608028654f : 0.0f), k3 = gel ? 2.0f * 0.7978845608028654f * 0.044715f : 0.0f, k0 = (sig || gel) ? 0.0f : 80.0f;
#pragma unroll
        for (int ai = 0; ai < 2; ++ai)
#pragma unroll
            for (int m = 0; m < 4; ++m) { bf16_t* rowp = O + (size_t)(row0 + ai * HALF + m * 16) * ldo + col0;
#pragma unroll
                for (int bj = 0; bj < 2; ++bj) { float v[8];
#pragma unroll
                    for (int n = 0; n < 2; ++n)
#pragma unroll
                        for (int j = 0; j < 4; ++j) { const float x = acc[ai][bj][m][n][j]; const float t = k0 + x * (kx + k3 * x * x);
                            const float r = __builtin_amdgcn_rcpf(1.0f + __expf(-t)); v[n * 4 + j] = sig ? r : x * r; }
                    u32x4 w; w.x = cvt_pk_bf16(v[0], v[1]); w.y = cvt_pk_bf16(v[2], v[3]); w.z = cvt_pk_bf16(v[4], v[5]); w.w = cvt_pk_bf16(v[6], v[7]);
                    *(u32x4*)(rowp + bj * HALF) = w; } }
    }
};
struct LruOrder {
    int G, c;
    __host__ __device__ void init(int G_, int c_) { G = G_; c = c_; }
    __host__ __device__ bool next(int i, Unit& u) const { const int L = i * G + c; if (L >= 6 * 33 * 4) return false; const int pmv = L >> 2; u.pm = pmv; u.pn = (pmv / 33) * 4 + (L & 3); return true; }
    __device__ __forceinline__ void a_ready(const Unit&) const {}
    __device__ __forceinline__ void done(const Unit&) const {}
};
struct EpiLru {
    static constexpr bool PERM = true, AFTER_DRAIN = false;
    float* LA; float* LB; const bf16_t* XA; const float* b_a; const float* b_x; const float* lam;
    int M; float* CA; float* CB;
    __device__ __forceinline__ void operator()(const f32x4 (&acc)[2][2][4][2], const Unit& u, int wr, int wc, int fr, int fq) const {
        const int jb = u.pm / 33, pmr = u.pm - jb * 33, pnn = u.pn & 3, d = pnn >> 1, blk = 2 * jb + (pnn & 1);
        const int row0 = pmr * BM + wr * 64 + fr, c0 = blk * HALF + wc * 32 + 8 * fq;
        const float* pba = b_a + d * 1536 + c0; const float* pbx = b_x + d * 1536 + c0; const float* psp = lam + d * 1536 + c0;
#pragma unroll
        for (int ai = 0; ai < 2; ++ai) { float RA[8], RB[8];
#pragma unroll
            for (int m = 0; m < 4; ++m) { const size_t row = (size_t)(row0 + ai * HALF + m * 16);
                const bf16_t* xp = XA + ((size_t)jb * M + row) * 256 + (c0 - 256 * jb);
                unsigned* pab = (unsigned*)LA + ((((size_t)d * (M >> 6) + (row >> 6)) * 6 + (c0 >> 8)) * 64 + (row & 63)) * 256 + (c0 & 255);
#pragma unroll
                for (int n = 0; n < 2; ++n) { const f32x4 ba = *(const f32x4*)(pba + 4 * n), bx = *(const f32x4*)(pbx + 4 * n), sp = *(const f32x4*)(psp + 4 * n);
                    const unsigned long long xw = *(const unsigned long long*)(xp + 4 * n); const unsigned x01 = (unsigned)xw, x23 = (unsigned)(xw >> 32);
                    const float xa[4] = {bf_lo(x01), bf_hi(x01), bf_lo(x23), bf_hi(x23)};
                    u32x4 ab;
#pragma unroll
                    for (int j = 0; j < 4; ++j) {
                        const float r = fast_sigmoid(acc[ai][0][m][n][j] + ba[j]), ig = fast_sigmoid(acc[ai][1][m][n][j] + bx[j]);
                        const float la = -sp[j] * r, x2 = 2.0f * la;
                        const float em = (x2 > -0.5f) ? -x2 * (1.0f + x2 * (0.5f + x2 * (0.16666667f + x2 * (0.041666668f + x2 * (0.0083333338f + x2 * 0.0013888889f))))) : 1.0f - __expf(x2);
                        ab[j] = cvt_pk_bf16(la, sqrtf(fmaxf(em, 0.0f)) * (ig * xa[j])); }
                    *(u32x4*)(pab + 4 * n) = ab;
#pragma unroll
                    for (int j = 0; j < 4; ++j) { float a = __expf(bf_lo(ab[j])), b = bf_hi(ab[j]);
#define LRU_STEP(S_) { const float pa = swz_xor<S_>(a), pb = swz_xor<S_>(b); const bool mine_first = (((fr & S_) == 0) != (d == 1)); b = mine_first ? (pa * b + pb) : (a * pb + b); a = a * pa; }
                        LRU_STEP(1) LRU_STEP(2) LRU_STEP(4) LRU_STEP(8)
#undef LRU_STEP
                        const int e = n * 4 + j;
                        if (m == 0) { RA[e] = a; RB[e] = b; } else { const float f0 = a * RB[e] + b, f1 = RA[e] * b + RB[e]; RB[e] = (d == 0) ? f0 : f1; RA[e] = RA[e] * a; } }
                    asm volatile("" ::: "memory"); }
                asm volatile("" ::: "memory"); }
            { const size_t ci = ((size_t)d * (M >> 6) + ((row0 + ai * HALF) >> 6)) * 1536 + c0;
                *(f32x4*)(CA + ci) = (f32x4){RA[0], RA[1], RA[2], RA[3]}; *(f32x4*)(CA + ci + 4) = (f32x4){RA[4], RA[5], RA[6], RA[7]};
                *(f32x4*)(CB + ci) = (f32x4){RB[0], RB[1], RB[2], RB[3]}; *(f32x4*)(CB + ci + 4) = (f32x4){RB[4], RB[5], RB[6], RB[7]}; } }
    }
};
template <int STEP> struct EpiMerge {
    static constexpr bool PERM = true, AFTER_DRAIN = false;
    float* M32; bf16_t* Mb; const bf16_t* G; int ldg;
    __device__ __forceinline__ void operator()(const f32x4 (&acc)[2][2][4][2], const Unit& u, int wr, int wc, int fr, int fq) const {
        const int row0 = u.pm * BM + wr * 64 + fr, col0 = u.pn * BM + wc * 32 + 8 * fq;
#pragma unroll
        for (int ai = 0; ai < 2; ++ai)
#pragma unroll
            for (int m = 0; m < 4; ++m) { const size_t row = (size_t)(row0 + ai * HALF + m * 16);
#pragma unroll
                for (int bj = 0; bj < 2; ++bj) { const int col = col0 + bj * HALF;
                    const u32x4 gw = *(const u32x4*)(G + row * ldg + col);
                    const float g[8] = {bf_lo(gw.x), bf_hi(gw.x), bf_lo(gw.y), bf_hi(gw.y), bf_lo(gw.z), bf_hi(gw.z), bf_lo(gw.w), bf_hi(gw.w)};
                    float v[8];
#pragma unroll
                    for (int n = 0; n < 2; ++n)
#pragma unroll
                        for (int j = 0; j < 4; ++j) v[n * 4 + j] = g[n * 4 + j] * acc[ai][bj][m][n][j];
                    bf16_t* mp = Mb + row * 4096 + col;
                    if (STEP >= 1) { const u32x4 o = *(const u32x4*)mp;
                        v[0] += bf_lo(o.x); v[1] += bf_hi(o.x); v[2] += bf_lo(o.y); v[3] += bf_hi(o.y); v[4] += bf_lo(o.z); v[5] += bf_hi(o.z); v[6] += bf_lo(o.w); v[7] += bf_hi(o.w); }
                    u32x4 w; w.x = cvt_pk_bf16(v[0], v[1]); w.y = cvt_pk_bf16(v[2], v[3]); w.z = cvt_pk_bf16(v[4], v[5]); w.w = cvt_pk_bf16(v[6], v[7]);
                    *(u32x4*)mp = w;
                    asm volatile("" ::: "memory"); } }
    }
};
template <class Epi, class Sched, bool ALIGN_EPI = false, bool SP2 = false>
__device__ __forceinline__ void gemm_phase(PG8_LAS unsigned char* lds, const Gemm g, const Sched& S, const Epi& E, int tid_in) {
    int tid_ = tid_in; asm volatile("" : "+v"(tid_));
    const int tid = tid_, wid = __builtin_amdgcn_readfirstlane(tid >> 6), lane = tid & 63, wr = wid >> 2, wc = wid & 3, fr = lane & 15, fq = lane >> 4;
    const int K = g.K, nt = K / BK;
    unsigned voffA[2], voffB[2];
#pragma unroll
    for (int i = 0; i < 2; ++i) { int R, C; stage_rc(tid * 16 + i * 8192, R, C); const int Rb = Epi::PERM ? ((R & ~31) + perm32(R & 31)) : R;
        voffA[i] = (unsigned)(R * K + C) * 2u; voffB[i] = (unsigned)(Rb * K + C) * 2u; }
    const size_t kstep = (size_t)(BK * 2);
    const size_t hstep = (size_t)HALF * K * 2;
    const size_t tstep = 2 * hstep;
    const unsigned ldsw = (unsigned)wid * 1024u;
    const int aoff = lds_byte(wr * 64 + fr, fq * 8), boff = lds_byte(wc * 32 + fr, fq * 8);
#define PG8_SA(b, h) (((b) * 2 + (h)) * HTB)
#define PG8_SB(b, h) ((4 + (b) * 2 + (h)) * HTB)
#define PG8_STAGE(bufoff, gbase, voff) do { _Pragma("unroll") for (int _i = 0; _i < 2; ++_i) \
        __builtin_amdgcn_global_load_lds((const unsigned*)((const char*)(gbase) + (voff)[_i]), (PG8_LAS unsigned*)(lds + (bufoff) + ldsw + _i * 8192), 16, 0, 0); } while (0)
#define PG8_LDA(dst, b, h) do { _Pragma("unroll") for (int m = 0; m < 4; ++m) _Pragma("unroll") for (int k = 0; k < 2; ++k) dst[m][k] = *(const PG8_LAS bf16x8*)(lds + PG8_SA(b, h) + aoff + m * 2048 + k * 1024); } while (0)
#define PG8_LDB(dst, b, h) do { _Pragma("unroll") for (int n = 0; n < 2; ++n) _Pragma("unroll") for (int k = 0; k < 2; ++k) dst[n][k] = *(const PG8_LAS bf16x8*)(lds + PG8_SB(b, h) + boff + n * 2048 + k * 1024); } while (0)
#define PG8_MMA(ai, bj, At, Bt) do { __builtin_amdgcn_s_setprio(1); _Pragma("unroll") for (int m = 0; m < 4; ++m) _Pragma("unroll") for (int n = 0; n < 2; ++n) _Pragma("unroll") for (int k = 0; k < 2; ++k) \
        acc[ai][bj][m][n] = __builtin_amdgcn_mfma_f32_16x16x32_bf16(Bt[n][k], At[m][k], acc[ai][bj][m][n], 0, 0, 0); __builtin_amdgcn_s_setprio(0); } while (0)
#define PG8_WAIT_V(n) asm volatile("s_waitcnt vmcnt(" #n ")" ::: "memory")
#define PG8_WAIT_L(n) asm volatile("s_waitcnt lgkmcnt(" #n ")" ::: "memory")
#define PG8_BAR __builtin_amdgcn_s_barrier()
#define PG8_SCHED __builtin_amdgcn_sched_barrier(0)
    Unit cur, nxt; int ui = 0;
    if (!S.next(0, cur)) return;
    f32x4 acc[2][2][4][2];
#pragma unroll
    for (int a = 0; a < 2; ++a)
#pragma unroll
        for (int b = 0; b < 2; ++b)
#pragma unroll
            for (int m = 0; m < 4; ++m)
#pragma unroll
                for (int n = 0; n < 2; ++n) acc[a][b][m][n] = (f32x4){0.f, 0.f, 0.f, 0.f};
    bf16x8 At[4][2], B0[2][2], B1[2][2];
    const char* cA = (const char*)g.A + (size_t)cur.pm * tstep; const char* cB = (const char*)g.Bt + (size_t)cur.pn * tstep;
    S.a_ready(cur);
    if constexpr (SP2) {
        PG8_STAGE(PG8_SB(0, 0), cB, voffB); PG8_STAGE(PG8_SB(0, 1), cB + hstep, voffB); PG8_STAGE(PG8_SA(0, 0), cA, voffA); PG8_STAGE(PG8_SA(0, 1), cA + hstep, voffA);
        if (wr == 1) PG8_BAR;
        PG8_WAIT_V(2); PG8_BAR;
        PG8_STAGE(PG8_SB(1, 0), cB + kstep, voffB); PG8_STAGE(PG8_SA(1, 0), cA + kstep, voffA); PG8_STAGE(PG8_SB(1, 1), cB + hstep + kstep, voffB);
        PG8_WAIT_V(6); PG8_BAR;
    } else {
        PG8_STAGE(PG8_SB(0, 0), cB, voffB); PG8_STAGE(PG8_SA(0, 0), cA, voffA); PG8_STAGE(PG8_SB(0, 1), cB + hstep, voffB); PG8_STAGE(PG8_SA(0, 1), cA + hstep, voffA);
        if (wr == 1) PG8_BAR;
        PG8_WAIT_V(4); PG8_BAR;
        PG8_STAGE(PG8_SB(1, 0), cB + kstep, voffB); PG8_STAGE(PG8_SA(1, 0), cA + kstep, voffA); PG8_STAGE(PG8_SB(1, 1), cB + hstep + kstep, voffB);
        PG8_WAIT_V(6); PG8_BAR;
    }
    for (;;) {
        const bool has_next = S.next(ui + 1, nxt);
        const char* nA = has_next ? (const char*)g.A + (size_t)nxt.pm * tstep : cA; const char* nB = has_next ? (const char*)g.Bt + (size_t)nxt.pn * tstep : cB;
        for (int t = 0; t < nt; t += 2) {
            const bool last = (t == nt - 2);
            const char* a1 = cA + (size_t)(t + 1) * kstep;
            const char* a2 = last ? nA : cA + (size_t)(t + 2) * kstep; const char* b2 = last ? nB : cB + (size_t)(t + 2) * kstep;
            const char* a3 = a2 + kstep; const char* b3 = b2 + kstep;
            if (last && has_next) S.a_ready(nxt);
            if constexpr (SP2) {
            PG8_LDB(B0, 0, 0); PG8_LDB(B1, 0, 1); PG8_SCHED; PG8_LDA(At, 0, 0); PG8_STAGE(PG8_SA(1, 1), a1 + hstep, voffA);
            PG8_WAIT_V(8); PG8_WAIT_L(0); PG8_BAR; PG8_MMA(0, 0, At, B0); PG8_MMA(0, 1, At, B1); PG8_BAR; PG8_SCHED;
            PG8_LDA(At, 0, 1); PG8_STAGE(PG8_SB(0, 0), b2, voffB); PG8_STAGE(PG8_SB(0, 1), b2 + hstep, voffB); PG8_STAGE(PG8_SA(0, 0), a2, voffA);
            PG8_WAIT_V(8); PG8_WAIT_L(0); PG8_BAR; PG8_MMA(1, 0, At, B0); PG8_MMA(1, 1, At, B1); PG8_BAR; PG8_SCHED;
            PG8_LDB(B0, 1, 0); PG8_LDB(B1, 1, 1); PG8_SCHED; PG8_LDA(At, 1, 0); PG8_STAGE(PG8_SA(0, 1), a2 + hstep, voffA);
            PG8_WAIT_V(8); PG8_WAIT_L(0); PG8_BAR; PG8_MMA(0, 0, At, B0); PG8_MMA(0, 1, At, B1); PG8_BAR; PG8_SCHED;
            PG8_LDA(At, 1, 1); PG8_STAGE(PG8_SB(1, 0), b3, voffB); PG8_STAGE(PG8_SB(1, 1), b3 + hstep, voffB); PG8_STAGE(PG8_SA(1, 0), a3, voffA);
            PG8_WAIT_V(8); PG8_WAIT_L(0); PG8_BAR; PG8_MMA(1, 0, At, B0); PG8_MMA(1, 1, At, B1); PG8_BAR; PG8_SCHED;
            } else {
            PG8_LDB(B0, 0, 0); PG8_SCHED; PG8_LDA(At, 0, 0); PG8_STAGE(PG8_SA(1, 1), a1 + hstep, voffA);
            PG8_WAIT_L(8); PG8_BAR; PG8_WAIT_L(0); PG8_MMA(0, 0, At, B0); PG8_BAR; PG8_SCHED;
            PG8_LDB(B1, 0, 1); PG8_STAGE(PG8_SB(0, 0), b2, voffB);
            PG8_BAR; PG8_WAIT_L(0); PG8_MMA(0, 1, At, B1); PG8_BAR;
            PG8_LDA(At, 0, 1); PG8_STAGE(PG8_SA(0, 0), a2, voffA);
            PG8_BAR; PG8_WAIT_L(0); PG8_MMA(1, 0, At, B0); PG8_BAR; PG8_SCHED;
            PG8_STAGE(PG8_SB(0, 1), b2 + hstep, voffB);
            PG8_WAIT_V(6); PG8_BAR; PG8_MMA(1, 1, At, B1); PG8_BAR;
            PG8_LDB(B0, 1, 0); PG8_SCHED; PG8_LDA(At, 1, 0); PG8_STAGE(PG8_SA(0, 1), a2 + hstep, voffA);
            PG8_WAIT_L(8); PG8_BAR; PG8_WAIT_L(0); PG8_MMA(0, 0, At, B0); PG8_BAR; PG8_SCHED;
            PG8_LDB(B1, 1, 1); PG8_STAGE(PG8_SB(1, 0), b3, voffB);
            PG8_BAR; PG8_WAIT_L(0); PG8_MMA(0, 1, At, B1); PG8_BAR;
            PG8_LDA(At, 1, 1); PG8_STAGE(PG8_SA(1, 0), a3, voffA);
            PG8_BAR; PG8_WAIT_L(0); PG8_MMA(1, 0, At, B0); PG8_BAR; PG8_SCHED;
            PG8_STAGE(PG8_SB(1, 1), b3 + hstep, voffB);
            PG8_WAIT_V(6); PG8_BAR; PG8_MMA(1, 1, At, B1); PG8_BAR;
            }
        }
        if constexpr (ALIGN_EPI) { if (wr == 0) PG8_BAR; }
        if constexpr (!Epi::AFTER_DRAIN) { E(acc, cur, wr, wc, fr, fq); S.done(cur); }
        if (!has_next) break;
#pragma unroll
        for (int a = 0; a < 2; ++a)
#pragma unroll
            for (int b = 0; b < 2; ++b)
#pragma unroll
                for (int m = 0; m < 4; ++m)
#pragma unroll
                    for (int n = 0; n < 2; ++n) acc[a][b][m][n] = (f32x4){0.f, 0.f, 0.f, 0.f};
        cur = nxt; cA = nA; cB = nB; ++ui;
        if constexpr (ALIGN_EPI) { if (wr == 1) PG8_BAR; }
    }
    PG8_WAIT_V(0);
    if constexpr (!ALIGN_EPI) { if (wr == 0) PG8_BAR; }
    PG8_BAR;
    if constexpr (Epi::AFTER_DRAIN) { E.fused(acc, cur, wr, wc, fr, fq, lds, wid, lane); S.done(cur); }
#undef PG8_SA
#undef PG8_SB
#undef PG8_STAGE
#undef PG8_LDA
#undef PG8_LDB
#undef PG8_MMA
#undef PG8_WAIT_V
#undef PG8_WAIT_L
#undef PG8_BAR
#undef PG8_SCHED
}
}
namespace att {
using bf16 = __hip_bfloat16;
constexpr int   D = 128, NW = 8, QBLK = 32, KVBLK = 64;
constexpr float SCALE = 0.088388347648318440f;
constexpr float THR = 8.f;
constexpr int SDEPTH = 2;
constexpr int LDQ = 1536, LDK = 512, LDO = 1536;
constexpr size_t SHM_V = KVBLK * D * 2, SHM_K = KVBLK * D * 2, SHM_ATTN = 2 * SHM_V + 2 * SHM_K + NW * 64 * 4;
__device__ __forceinline__ unsigned short f2bf_att(float f) { unsigned u = __builtin_bit_cast(unsigned, f); return (unsigned short)((u + 0x7fffu + ((u >> 16) & 1u)) >> 16); }
using bf16x8 = __attribute__((ext_vector_type(8))) short;
using s16x4  = __attribute__((ext_vector_type(4))) short;
using f32x16 = __attribute__((ext_vector_type(16))) float;
using f32x8  = __attribute__((ext_vector_type(8))) float;
using u32x4  = __attribute__((ext_vector_type(4))) unsigned;
#define KSWZ(row, colB) ((row) * 256 + ((colB) ^ (((row) & 7) << 4)))
#define SBAR() __builtin_amdgcn_sched_barrier(0)
__device__ __forceinline__ int crow(int r, int hi) { return (r & 3) + 8 * (r >> 2) + 4 * hi; }
__device__ __forceinline__ unsigned cvtpk(float lo, float hi) {
  unsigned r; asm volatile("v_cvt_pk_bf16_f32 %0, %1, %2" : "=v"(r) : "v"(lo), "v"(hi)); return r;
}
template <typename TIn> struct Stage;
template <> struct Stage<bf16>  { using T = bf16x8;
  __device__ static __forceinline__ T ld8(const bf16* p) { return *reinterpret_cast<const bf16x8*>(p); }
  __device__ static __forceinline__ bf16x8 tobf(T x) { return x; } };
template <> struct Stage<float> { using T = f32x8;
  __device__ static __forceinline__ T ld8(const float* p) { return *reinterpret_cast<const f32x8*>(p); }
  __device__ static __forceinline__ bf16x8 tobf(T x) {
    u32x4 w = {cvtpk(x[0], x[1]), cvtpk(x[2], x[3]), cvtpk(x[4], x[5]), cvtpk(x[6], x[7])}; return *reinterpret_cast<bf16x8*>(&w); } };

__device__ __forceinline__ void partialSM(f32x16& p0, f32x16& p1, float& m_reg, float& mn, float& alpha) {
  constexpr float C = SCALE * 1.4426950408889634f;
  float pmax = p0[0]; for (int r = 1; r < 16; ++r) pmax = fmaxf(pmax, p0[r]); for (int r = 0; r < 16; ++r) pmax = fmaxf(pmax, p1[r]);
  { auto rr = __builtin_amdgcn_permlane32_swap(__float_as_uint(pmax), __float_as_uint(pmax), false, false);
    pmax = fmaxf(__uint_as_float(rr[0]), __uint_as_float(rr[1])); }
  if (__builtin_expect(__all(pmax - m_reg <= THR / SCALE), 1)) { mn = m_reg; alpha = 1.f; }
  else { mn = fmaxf(m_reg, pmax); alpha = __builtin_amdgcn_exp2f((m_reg - mn) * C); m_reg = mn; }
  float mnC = -mn * C;
  for (int r = 0; r < 16; ++r) p0[r] = fmaf(p0[r], C, mnC); for (int r = 0; r < 16; ++r) p1[r] = fmaf(p1[r], C, mnC);
  for (int r = 0; r < 16; ++r) p0[r] = __builtin_amdgcn_exp2f(p0[r]);
}
__device__ __forceinline__ void finishSM(f32x16& p0, f32x16& p1, float alpha, float& l_reg, bf16x8& pa0, bf16x8& pa1, bf16x8& pa2, bf16x8& pa3) {
  for (int r = 0; r < 16; ++r) p1[r] = __builtin_amdgcn_exp2f(p1[r]);
  float ps = 0; for (int r = 0; r < 16; ++r) ps += p0[r]; for (int r = 0; r < 16; ++r) ps += p1[r];
  { auto rr = __builtin_amdgcn_permlane32_swap(__float_as_uint(ps), __float_as_uint(ps), false, false);
    ps = __uint_as_float(rr[0]) + __uint_as_float(rr[1]); }
  l_reg = l_reg * alpha + ps;
#define PK4(P, BASE, OUT) do { unsigned a0 = cvtpk(P[BASE + 0], P[BASE + 1]), a1 = cvtpk(P[BASE + 2], P[BASE + 3]);   \
    unsigned b0 = cvtpk(P[BASE + 4], P[BASE + 5]), b1 = cvtpk(P[BASE + 6], P[BASE + 7]);                              \
    auto r0 = __builtin_amdgcn_permlane32_swap(a0, b0, false, false); auto r1 = __builtin_amdgcn_permlane32_swap(a1, b1, false, false); \
    u32x4 w = {r0[0], r1[0], r0[1], r1[1]}; OUT = *reinterpret_cast<bf16x8*>(&w); } while (0)
  PK4(p0, 0, pa0); PK4(p0, 8, pa1); PK4(p1, 0, pa2); PK4(p1, 8, pa3);
#undef PK4
}
__device__ __forceinline__ void qkt(f32x16& p0, f32x16& p1, const bf16* Ks, const bf16x8* qr, int r32, int hi) {
  p0 = f32x16{}; p1 = f32x16{};
  for (int d0 = 0; d0 < 8; ++d0) { int cb = (d0 * 16 + hi * 8) * 2;
    bf16x8 b0 = *reinterpret_cast<const bf16x8*>((const char*)Ks + KSWZ(r32, cb));
    bf16x8 b1 = *reinterpret_cast<const bf16x8*>((const char*)Ks + KSWZ(32 + r32, cb));
    p0 = __builtin_amdgcn_mfma_f32_32x32x16_bf16(b0, qr[d0], p0, 0, 0, 0);
    p1 = __builtin_amdgcn_mfma_f32_32x32x16_bf16(b1, qr[d0], p1, 0, 0, 0); }
}
__device__ __forceinline__ int v_st(int k, int c) { const int kk = (k & ~0xC) | ((k & 4) << 1) | ((k & 8) >> 1); return ((kk >> 3) * 4 + (c >> 5)) * 512 + ((kk & 7) * 32 + (c & 31)) * 2; }
__device__ __forceinline__ int v_rd_base(int lane) { return ((lane & 3) << 3) | (((lane >> 2) & 3) << 6) | (((lane >> 4) & 1) << 5) | (((lane >> 5) & 1) << 8); }
constexpr int v_rd_off(int d0, int ks, int half) { return d0 * 512 + ks * 4096 + half * 2048; }
template <int OFF> __device__ __forceinline__ s16x4 tr_read(int vb) {
  s16x4 r; asm volatile("ds_read_b64_tr_b16 %0, %1 offset:%2" : "=&v"(r) : "v"(vb), "i"(OFF) : "memory"); return r;
}
template <int D0> __device__ __forceinline__ void pv_one(f32x16& od, int vb, bf16x8 pa0, bf16x8 pa1, bf16x8 pa2, bf16x8 pa3) {
  const s16x4 l0 = tr_read<v_rd_off(D0, 0, 0)>(vb), h0 = tr_read<v_rd_off(D0, 0, 1)>(vb), l1 = tr_read<v_rd_off(D0, 1, 0)>(vb), h1 = tr_read<v_rd_off(D0, 1, 1)>(vb);
  const s16x4 l2 = tr_read<v_rd_off(D0, 2, 0)>(vb), h2 = tr_read<v_rd_off(D0, 2, 1)>(vb), l3 = tr_read<v_rd_off(D0, 3, 0)>(vb), h3 = tr_read<v_rd_off(D0, 3, 1)>(vb);
  asm volatile("s_waitcnt lgkmcnt(0)" ::: "memory"); SBAR();
#define PK(L, H) (bf16x8){L[0], L[1], L[2], L[3], H[0], H[1], H[2], H[3]}
  od = __builtin_amdgcn_mfma_f32_32x32x16_bf16(pa0, PK(l0, h0), od, 0, 0, 0);
  od = __builtin_amdgcn_mfma_f32_32x32x16_bf16(pa1, PK(l1, h1), od, 0, 0, 0);
  od = __builtin_amdgcn_mfma_f32_32x32x16_bf16(pa2, PK(l2, h2), od, 0, 0, 0);
  od = __builtin_amdgcn_mfma_f32_32x32x16_bf16(pa3, PK(l3, h3), od, 0, 0, 0);
#undef PK
}
__device__ __forceinline__ void pv_d0(f32x16* o, int vb, bf16x8 pa0, bf16x8 pa1, bf16x8 pa2, bf16x8 pa3) {
  pv_one<0>(o[0], vb, pa0, pa1, pa2, pa3); pv_one<1>(o[1], vb, pa0, pa1, pa2, pa3); pv_one<2>(o[2], vb, pa0, pa1, pa2, pa3); pv_one<3>(o[3], vb, pa0, pa1, pa2, pa3);
}

template <typename TQ>
__device__ __forceinline__ void attn_dense_body(const TQ* __restrict__ Qb, const bf16* __restrict__ Kh, const bf16* __restrict__ Vh,
                                                unsigned short* __restrict__ Ob, int seq, char* lds, int tid_in) {
  using St = Stage<bf16>; using SQ = Stage<TQ>;
  int tid_ = tid_in; asm volatile("" : "+v"(tid_));
  const int tid = tid_, wid = tid >> 6, lane = tid & 63, r32 = lane & 31, hi = lane >> 5;
  bf16* V_lds = (bf16*)lds; bf16* K_lds = (bf16*)(lds + 2 * SHM_V);
  float* ws = (float*)(lds + 2 * SHM_V + 2 * SHM_K) + wid * 64; float* li_l = ws; float* al_l = ws + 32;
  float m_reg = -1e30f, l_reg = 0; f32x16 o[4] = {}; bf16x8 qr[8];
  const TQ* Qw = Qb + (long)(wid * QBLK + r32) * LDQ + hi * 8;
#pragma unroll
  for (int d0 = 0; d0 < 8; ++d0) qr[d0] = SQ::tobf(SQ::ld8(Qw + d0 * 16));
  const int sr = tid >> 4, sc = (tid & 15) * 8, vst0 = v_st(sr, sc), vst1 = v_st(32 + sr, sc);
  const int vb0 = (int)(uintptr_t)V_lds + v_rd_base(lane);
  struct { typename St::T vs0, vs1, ks0, ks1; } sr_[SDEPTH];
  const unsigned lo0 = (unsigned)(sr * LDK + sc) * 2u, lo1 = lo0 + 32u * LDK * 2u;
#define SLOAD(i, k0) do { const char* vt_ = (const char*)Vh + (size_t)(k0) * (LDK * 2); const char* kt_ = (const char*)Kh + (size_t)(k0) * (LDK * 2); \
    sr_[i].vs0 = *(const bf16x8*)(vt_ + lo0); sr_[i].vs1 = *(const bf16x8*)(vt_ + lo1); \
    sr_[i].ks0 = *(const bf16x8*)(kt_ + lo0); sr_[i].ks1 = *(const bf16x8*)(kt_ + lo1); } while (0)
#define SWRITE(b, i) do { *(bf16x8*)((char*)V_lds + (b) * SHM_V + vst0) = St::tobf(sr_[i].vs0);          \
    *(bf16x8*)((char*)V_lds + (b) * SHM_V + vst1) = St::tobf(sr_[i].vs1); int kc = sc * 2;               \
    *(bf16x8*)((char*)K_lds + (b) * SHM_K + KSWZ(sr, kc)) = St::tobf(sr_[i].ks0);                       \
    *(bf16x8*)((char*)K_lds + (b) * SHM_K + KSWZ(32 + sr, kc)) = St::tobf(sr_[i].ks1); } while (0)
#define SWAIT() do { if constexpr (SDEPTH == 2) asm volatile("s_waitcnt vmcnt(4)" ::: "memory"); else asm volatile("s_waitcnt vmcnt(0)" ::: "memory"); } while (0)
#define RESC(a) do { if (__any((a) < 1.f)) { if (hi == 0) al_l[r32] = (a); asm volatile("s_waitcnt lgkmcnt(0)" ::: "memory"); \
    for (int d = 0; d < 4; ++d) for (int r = 0; r < 16; ++r) o[d][r] *= al_l[crow(r, hi)]; } } while (0)
  f32x16 pA0, pA1, pB0, pB1; float mnA, mnB, alA, alB; bf16x8 pa0, pa1, pa2, pa3; const int NT = seq / KVBLK;
  constexpr int SE = 0, SO = SDEPTH - 1;
  SLOAD(SE, 0); asm volatile("s_waitcnt vmcnt(0)" ::: "memory"); SWRITE(0, SE); __syncthreads();
  qkt(pA0, pA1, K_lds, qr, r32, hi); partialSM(pA0, pA1, m_reg, mnA, alA);
  SLOAD(SO, KVBLK); if constexpr (SDEPTH == 2) { if (2 < NT) SLOAD(SE, 2 * KVBLK); }
  SWAIT(); SWRITE(1, SO); __syncthreads();
  for (int j = 1; j + 1 < NT; j += 2) {
    SBAR(); qkt(pB0, pB1, (bf16*)((char*)K_lds + SHM_K), qr, r32, hi);
    finishSM(pA0, pA1, alA, l_reg, pa0, pa1, pa2, pa3); SBAR();
    SLOAD(SO, (j + SDEPTH) * KVBLK); SBAR();
    pv_d0(o, vb0, pa0, pa1, pa2, pa3); partialSM(pB0, pB1, m_reg, mnB, alB);
    __syncthreads(); SWAIT(); SWRITE(0, SE);
    RESC(alB); __syncthreads();
    SBAR(); qkt(pA0, pA1, K_lds, qr, r32, hi);
    finishSM(pB0, pB1, alB, l_reg, pa0, pa1, pa2, pa3); SBAR();
    if (SDEPTH == 1 || j + 3 < NT) SLOAD(SE, (j + 1 + SDEPTH) * KVBLK); SBAR();
    pv_d0(o, vb0 + (int)SHM_V, pa0, pa1, pa2, pa3); partialSM(pA0, pA1, m_reg, mnA, alA);
    __syncthreads(); SWAIT(); SWRITE(1, SO);
    RESC(alA); __syncthreads();
  }
  SBAR(); qkt(pB0, pB1, (bf16*)((char*)K_lds + SHM_K), qr, r32, hi);
  finishSM(pA0, pA1, alA, l_reg, pa0, pa1, pa2, pa3); SBAR();
  pv_d0(o, vb0, pa0, pa1, pa2, pa3); partialSM(pB0, pB1, m_reg, mnB, alB);
  __syncthreads(); RESC(alB);
  finishSM(pB0, pB1, alB, l_reg, pa0, pa1, pa2, pa3); SBAR();
  pv_d0(o, vb0 + (int)SHM_V, pa0, pa1, pa2, pa3);
  if (hi == 0) li_l[r32] = l_reg; asm volatile("s_waitcnt lgkmcnt(0)" ::: "memory");
  float rli[16];
#pragma unroll
  for (int r = 0; r < 16; ++r) rli[r] = __builtin_amdgcn_rcpf(li_l[crow(r, hi)]);
  unsigned short* Ow = Ob + (long)(wid * QBLK) * LDO;
#pragma unroll
  for (int r = 0; r < 16; ++r) { int orow = crow(r, hi);
    for (int d0 = 0; d0 < 4; ++d0) Ow[(long)orow * LDO + d0 * 32 + r32] = f2bf_att(o[d0][r] * rli[r]); }
#undef SLOAD
#undef SWRITE
#undef SWAIT
#undef RESC
}

#undef KSWZ
#undef SBAR
}
constexpr int NWAVES = 8;
constexpr int DM = 4096, SEQ = 8192, CTXL = 256, MROWS = SEQ + CTXL, DEPTH = 4;
constexpr int WMIX = 1536, KVW = 512, NIN = 22528, DFF = 4096, MODR = 256, NMOD = 9;
constexpr int COL_AX = 0, COL_CK = 1536, COL_CV = 2048, COL_AG = 2560, COL_B = 4096, COL_CQ = 8704, COL_G = 10240;
constexpr int NCHUNK = MROWS / 64;
constexpr int FFTN = 16384;
constexpr float EPSN = 1e-6f;
constexpr int N_IN_TENSORS = 36;
enum { I_X = 0, I_C, I_CTX, I_CCTX, I_WMD, I_WMU, I_BMOD, I_NF1, I_NMIX, I_NF2, I_F1IN, I_F1OUT, I_F2IN, I_F2OUT, I_WIN, I_LCONV, I_LWA, I_LBA, I_LWX, I_LBX, I_LLAM,
       I_HCONV, I_HFW1, I_HFB1, I_HFREQ, I_HFW2, I_HFB2, I_HFW3, I_HSKIP, I_QN, I_KN, I_WBA, I_WBB, I_WBC, I_WOUT, I_FNORM };

constexpr size_t MiB = 1u << 20;
constexpr size_t WS_CTL = 0, CTL_ZERO_BYTES = 1 * MiB;
constexpr size_t WS_MOD = 2 * MiB;
constexpr size_t WS_W = 4 * MiB;
constexpr size_t WO_GU1 = 0, WO_D1 = 64 * MiB, WO_GU2 = 96 * MiB, WO_D2 = 160 * MiB, WO_IN = 192 * MiB, WO_BR = 368 * MiB, WO_OUT = 404 * MiB, WO_LRU = 436 * MiB, W_LAYER = 454 * MiB;
constexpr size_t WS_X = WS_W + DEPTH * W_LAYER;
constexpr size_t WS_U = WS_X + 132 * MiB;
constexpr size_t WS_H = WS_U + 66 * MiB;
constexpr size_t WS_P = WS_H + 66 * MiB;
constexpr size_t WS_XA = WS_P + 363 * MiB;
constexpr size_t WS_LA = WS_XA + 25 * MiB;
constexpr size_t WS_LB = WS_LA + 99 * MiB;
constexpr size_t WS_CA = WS_LB + 99 * MiB;
constexpr size_t WS_CB = WS_CA + 2 * MiB;
constexpr size_t WS_CIN = WS_CB + 2 * MiB;
constexpr size_t WS_QN = WS_CIN + 2 * MiB;
constexpr size_t WS_KN = WS_QN + 25 * MiB;
constexpr size_t WS_VN = WS_KN + 9 * MiB;
constexpr size_t WS_YA = WS_VN + 9 * MiB;
constexpr size_t WS_YB = WS_YA + 25 * MiB;
constexpr size_t WS_YC = WS_YB + 25 * MiB;
constexpr size_t WS_M32 = WS_YC + 25 * MiB;
constexpr size_t WS_VT = WS_M32 + 132 * MiB;
constexpr size_t WS_YBT = WS_VT + 144 * MiB;
constexpr size_t WS_KT = WS_YBT + 48 * MiB;
constexpr size_t WS_PM = WS_KT + 192 * MiB;
constexpr size_t WS_H2 = WS_PM + 384 * MiB;
constexpr size_t WS_H2C = WS_H2 + 2 * MiB;
constexpr size_t WS_KC = WS_H2C + 1 * MiB;
constexpr size_t WS_KCN = WS_KC + 6 * MiB;
constexpr size_t WS_UC = WS_KCN + 1 * MiB;
constexpr size_t WS_END = WS_UC + 5 * MiB;
constexpr int CW_TMO = 0, CW_CODE = 1;
constexpr int CW_BAR = 4096;
constexpr int CW_T1 = 16384;

constexpr int RING_OFF = 0, RING_BYTES = 131072;
constexpr int FFT_BYTES = (FFTN + FFTN / 32) * 8;
constexpr int RED_OFF = FFT_BYTES;
constexpr int WSCR_BYTES = 66 * 65 * 4;
constexpr int LDSCTL_OFF = 143360, MISC_OFF = LDSCTL_OFF + 320;
constexpr int LDS_BYTES = 147456;
static_assert(RED_OFF + 1024 <= LDSCTL_OFF && NWAVES * WSCR_BYTES <= LDSCTL_OFF && MISC_OFF + 128 <= LDS_BYTES, "LDS map");

#define GAS __attribute__((address_space(1)))
#define LAS __attribute__((address_space(3)))
typedef unsigned short bf16;
typedef unsigned v4u __attribute__((ext_vector_type(4)));
typedef unsigned v2u __attribute__((ext_vector_type(2)));
typedef float f32x4 __attribute__((ext_vector_type(4)));
typedef float f32x2 __attribute__((ext_vector_type(2)));
typedef GAS unsigned gu32;
#define RLX_AGENT __ATOMIC_RELAXED, __HIP_MEMORY_SCOPE_AGENT
#define LDS_WAIT() asm volatile("s_waitcnt lgkmcnt(0)" ::: "memory")
#define VM_WAIT() asm volatile("s_waitcnt vmcnt(0)" ::: "memory")
__device__ __forceinline__ unsigned f2bf(float f) { unsigned u = __builtin_bit_cast(unsigned, f); return (u + 0x7fffu + ((u >> 16) & 1u)) >> 16; }
__device__ __forceinline__ unsigned pk2(float lo, float hi) { return f2bf(lo) | (f2bf(hi) << 16); }
__device__ __forceinline__ float bflo(unsigned w) { return __uint_as_float(w << 16); }
__device__ __forceinline__ float bfhi(unsigned w) { return __uint_as_float(w & 0xffff0000u); }
__device__ __forceinline__ float bf1(bf16 h) { return __uint_as_float(((unsigned)h) << 16); }
template <int MASK> __device__ __forceinline__ float swz_xor(float v) { return __int_as_float(__builtin_amdgcn_ds_swizzle(__float_as_int(v), (MASK << 10) | 0x1f)); }
__device__ __forceinline__ float lane_bcast(float v, int l) { return __int_as_float(__builtin_amdgcn_readlane(__float_as_int(v), l)); }
__device__ __forceinline__ float wave_sum(float v) {
    v += swz_xor<1>(v); v += swz_xor<2>(v); v += swz_xor<4>(v); v += swz_xor<8>(v); v += swz_xor<16>(v);
    const auto rr = __builtin_amdgcn_permlane32_swap(__float_as_uint(v), __float_as_uint(v), false, false);
    return __uint_as_float(rr[0]) + __uint_as_float(rr[1]);
}
__device__ __forceinline__ float sigmoidf_(float x) { return 1.0f / (1.0f + __expf(-x)); }
#define XB_TMO      128
#define XB_XCNT(j)  (256  + 64 * (j))
#define XB_XSUB(j)  (1280 + 64 * (j))
#define XB_XGEN(j)  (2304 + 64 * (j))
#define XB_TOP      3328
#define XB_TOPGEN   3392
#define XCD_BAR_WORDS 3456
#define XB_SPIN_CAP (1u << 18)

__device__ __forceinline__ unsigned xb_ld(unsigned* p)              { return __hip_atomic_load(p, __ATOMIC_RELAXED, __HIP_MEMORY_SCOPE_AGENT); }
__device__ __forceinline__ unsigned xb_add(unsigned* p, unsigned v) { return __hip_atomic_fetch_add(p, v, __ATOMIC_RELAXED, __HIP_MEMORY_SCOPE_AGENT); }
__device__ __forceinline__ unsigned xb_xcc_id() { return (unsigned)__builtin_amdgcn_s_getreg((3 << 11) | 20) & 0xFu; }
#define XB_SPIN(cond, bar) do { unsigned _sp = 0; while (cond) { __builtin_amdgcn_s_sleep(1); \
    if ((++_sp & 255u) == 0u) { if (xb_ld(&(bar)[XB_TMO])) break; if (_sp > XB_SPIN_CAP) { atomicAdd(&(bar)[XB_TMO], 1u); break; } } } } while (0)

struct XcdBarrier {
    unsigned* bar; unsigned x;
    volatile LAS unsigned* st;
};

__device__ __forceinline__ XcdBarrier xcd_barrier_post(unsigned* bar, volatile LAS unsigned* st) {
    XcdBarrier b; b.bar = bar; b.x = xb_xcc_id(); b.st = st;
    if (threadIdx.x == 0) (void)xb_add(&bar[XB_XCNT(b.x)], 1u);
    return b;
}
__device__ __forceinline__ void xcd_barrier_complete(unsigned* bar, unsigned x, unsigned& nloc, unsigned& nx) {
    const unsigned G = gridDim.x * gridDim.y * gridDim.z;
    unsigned sum, cnt, mine, sp = 0u;
    for (;;) {
        sum = 0u; cnt = 0u; mine = 0u;
#pragma unroll
        for (unsigned j = 0; j < 16; ++j) { const unsigned c = xb_ld(&bar[XB_XCNT(j)]); sum += c; cnt += (c > 0u) ? 1u : 0u; mine = (j == x) ? c : mine; }
        if (sum == G) break;
        __builtin_amdgcn_s_sleep(1);
        if ((++sp & 255u) == 0u) { if (xb_ld(&bar[XB_TMO])) break; if (sp > XB_SPIN_CAP) { atomicAdd(&bar[XB_TMO], 1u); break; } }
    }
    nloc = mine > 0u ? mine : 1u; nx = cnt > 0u ? cnt : 1u;
}

__device__ __forceinline__ void xcd_barrier(const XcdBarrier& b) {
    asm volatile("s_waitcnt vmcnt(0)" ::: "memory");
    __syncthreads();
    if (threadIdx.x == 0) {
        unsigned* bar = b.bar;
        __builtin_amdgcn_s_waitcnt(0);
        unsigned nloc = b.st[0], nx = b.st[1];
        if (nloc == 0u) { xcd_barrier_complete(bar, b.x, nloc, nx); b.st[0] = nloc; b.st[1] = nx; }
        const unsigned old = xb_add(&bar[XB_XSUB(b.x)], 1u);
        const unsigned gen = old / nloc;
        if (old + 1u == (gen + 1u) * nloc) {
            __builtin_amdgcn_fence(__ATOMIC_RELEASE, "agent");
            asm volatile("s_waitcnt vmcnt(0)" ::: "memory");
            const unsigned og = xb_add(&bar[XB_TOP], 1u);
            const unsigned tg = og / nx;
            if (og + 1u == (tg + 1u) * nx) xb_add(&bar[XB_TOPGEN], 1u);
            else XB_SPIN(xb_ld(&bar[XB_TOPGEN]) == tg, bar);
            __builtin_amdgcn_fence(__ATOMIC_ACQUIRE, "agent");
            xb_add(&bar[XB_XGEN(b.x)], 1u);
            asm volatile("s_waitcnt vmcnt(0)" ::: "memory");
        } else {
            XB_SPIN(xb_ld(&bar[XB_XGEN(b.x)]) == gen, bar);
            __builtin_amdgcn_fence(__ATOMIC_ACQUIRE, "agent");
            asm volatile("s_waitcnt vmcnt(0)" ::: "memory");
        }
    }
    __syncthreads();
}
struct Args { const float* in[N_IN_TENSORS]; float* out; unsigned char* ws; int ph_lo, ph_hi; };
static_assert(sizeof(Args) == N_IN_TENSORS * 8 + 8 + 8 + 8, "Args has no padding");
__device__ __forceinline__ const float* inp(const Args& A, int i) { asm volatile("" : "+s"(i)); return (const float*)(const GAS float*)A.in[i]; }
struct Frame {
    LAS unsigned char* lds;
    unsigned char* ws;
    float* out;
    int tid, lane, wave, G, gw, ngw, bid;
};
__device__ __forceinline__ Frame fresh(const Frame& F) { Frame L = F; unsigned z = 0u; asm volatile("" : "+v"(z)); int wv = F.wave; asm volatile("" : "+s"(wv)); int b = F.bid; asm volatile("" : "+s"(b));
    unsigned long long w = (unsigned long long)F.ws; asm volatile("" : "+s"(w)); L.ws = (unsigned char*)(GAS unsigned char*)w;
    L.lane = (int)__builtin_amdgcn_mbcnt_hi(~0u, __builtin_amdgcn_mbcnt_lo(~0u, z));
    L.wave = wv; L.tid = wv * 64 + L.lane; L.bid = b; L.gw = b * NWAVES + wv; return L; }
#define WSP(T, off) ((T*)(F.ws + (off)))

__device__ __forceinline__ void transpose_item(const float* W, int K, int N, bf16* WT, int k0, int n0, int drow0, LAS float* scr, int lane) {
    const float* src = W + (size_t)k0 * N + n0 + lane;
#pragma unroll 16
    for (int kk = 0; kk < 64; ++kk) scr[kk * 65 + lane] = src[(size_t)kk * N];
    LDS_WAIT(); asm volatile("" ::: "memory");
    const int c = lane & 7;
#pragma unroll
    for (int j = 0; j < 8; ++j) { const int n = (lane >> 3) + 8 * j; const LAS float* s = scr + (8 * c) * 65 + n;
        v4u o; o.x = pk2(s[0 * 65], s[1 * 65]); o.y = pk2(s[2 * 65], s[3 * 65]); o.z = pk2(s[4 * 65], s[5 * 65]); o.w = pk2(s[6 * 65], s[7 * 65]);
        *(GAS v4u*)(WT + (size_t)(drow0 + n) * K + k0 + 8 * c) = o; }
    LDS_WAIT(); asm volatile("" ::: "memory");
}
template <int SWI> __device__ __forceinline__ void transpose_matrix(const Frame& F_, const Args& A, const float* W, int K, int N, bf16* WT, LAS float* scr) {
    const Frame F = fresh(F_);
    const int nblk = N / 64, nitems = (K / 64) * nblk;
    for (int it = F.gw; it < nitems; it += F.ngw) { const int kb = it / nblk, nb = it - kb * nblk, n0 = 64 * nb; int drow0 = n0;
        if (SWI) { const int h = n0 / 4096, c = n0 - h * 4096; drow0 = 256 * (c / 128) + 128 * h + (c & 127); }
        transpose_item(W, K, N, WT, 64 * kb, n0, drow0, scr, F.lane); }
}
__device__ __forceinline__ void prologue_a(const Frame& F_, const Args& A) {
    const Frame F = fresh(F_);
    LAS float* scr = (LAS float*)(F.lds + F.wave * 16640);
    { float* T1 = WSP(float, WS_CTL) + CW_T1; const float* cl = inp(A, I_C); const float* cc = inp(A, I_CCTX);
      for (int u = F.gw; u < DEPTH * 64; u += F.ngw) { const int layer = u >> 6, jg = u & 63;
          f32x4 al = {0.f, 0.f, 0.f, 0.f}, ac = {0.f, 0.f, 0.f, 0.f};
#pragma unroll 8
          for (int i = 0; i < 64; ++i) { const int d = F.lane + 64 * i; const float xl = cl[d], xc = cc[d]; const float sl = xl * sigmoidf_(xl), sc = xc * sigmoidf_(xc);
              const f32x4 w = *(const f32x4*)(inp(A, I_WMD) + ((size_t)layer * DM + d) * MODR + 4 * jg); al += w * sl; ac += w * sc; }
#pragma unroll
          for (int e = 0; e < 4; ++e) { const float tl = wave_sum(al[e]), tc = wave_sum(ac[e]);
              if (F.lane == 0) { T1[(layer * 2 + 0) * MODR + 4 * jg + e] = tl; T1[(layer * 2 + 1) * MODR + 4 * jg + e] = tc; } } } }
    { float* SPT = WSP(float, WS_MOD + 1536 * 1024); const float* lam = inp(A, I_LLAM);
      for (int i = F.bid * 512 + F.tid; i < DEPTH * 2 * WMIX; i += F.G * 512) SPT[i] = 8.0f * log1pf(__expf(-lam[i])); }
    { f32x4* X = WSP(f32x4, WS_X); const f32x4* xc = (const f32x4*)inp(A, I_CTX); const f32x4* xl = (const f32x4*)inp(A, I_X); const size_t nc = (size_t)CTXL * DM / 4, nt = (size_t)MROWS * DM / 4;
      for (size_t i = (size_t)F.bid * 512 + F.tid; i < nt; i += (size_t)F.G * 512) X[i] = (i < nc) ? xc[i] : xl[i - nc]; }
    for (int layer = 0; layer < DEPTH; ++layer) { unsigned char* wb = F.ws + WS_W + (size_t)layer * W_LAYER;
        transpose_matrix<1>(F, A, inp(A, I_F1IN) + (size_t)layer * DM * 2 * DFF, DM, 2 * DFF, (bf16*)(wb + WO_GU1), scr);
        transpose_matrix<0>(F, A, inp(A, I_F1OUT) + (size_t)layer * DFF * DM, DFF, DM, (bf16*)(wb + WO_D1), scr);
        transpose_matrix<1>(F, A, inp(A, I_F2IN) + (size_t)layer * DM * 2 * DFF, DM, 2 * DFF, (bf16*)(wb + WO_GU2), scr);
        transpose_matrix<0>(F, A, inp(A, I_F2OUT) + (size_t)layer * DFF * DM, DFF, DM, (bf16*)(wb + WO_D2), scr);
        transpose_matrix<0>(F, A, inp(A, I_WIN) + (size_t)layer * DM * NIN, DM, NIN, (bf16*)(wb + WO_IN), scr);
        transpose_matrix<0>(F, A, inp(A, I_WBA) + (size_t)layer * WMIX * DM, WMIX, DM, (bf16*)(wb + WO_BR), scr);
        transpose_matrix<0>(F, A, inp(A, I_WBB) + (size_t)layer * WMIX * DM, WMIX, DM, (bf16*)(wb + WO_BR) + (size_t)DM * WMIX, scr);
        transpose_matrix<0>(F, A, inp(A, I_WBC) + (size_t)layer * WMIX * DM, WMIX, DM, (bf16*)(wb + WO_BR) + (size_t)2 * DM * WMIX, scr);
        transpose_matrix<0>(F, A, inp(A, I_WOUT) + (size_t)layer * DM * DM, DM, DM, (bf16*)(wb + WO_OUT), scr);
        { bf16* WL = (bf16*)(wb + WO_LRU); const float* wa = inp(A, I_LWA) + (size_t)layer * 2 * 12 * 128 * 128; const float* wx = inp(A, I_LWX) + (size_t)layer * 2 * 12 * 128 * 128;
          for (int row = F.gw; row < 6144; row += F.ngw) { const int jb = row >> 10, pnn = (row >> 8) & 3, h = (row >> 7) & 1, e = row & 127, dir = pnn >> 1, blk = 2 * jb + (pnn & 1);
              const float* src = (h ? wx : wa) + ((size_t)(dir * 12 + blk) * 128) * 128 + e;
              if (F.lane < 32) { const int k0 = F.lane * 8; v4u o = {0u, 0u, 0u, 0u};
                  if ((k0 >> 7) == (pnn & 1)) { const int dd = k0 & 127; float v[8];
#pragma unroll
                      for (int j = 0; j < 8; ++j) v[j] = src[(size_t)(dd + j) * 128];
                      o.x = pk2(v[0], v[1]); o.y = pk2(v[2], v[3]); o.z = pk2(v[4], v[5]); o.w = pk2(v[6], v[7]); }
                  *(GAS v4u*)(WL + (size_t)row * 256 + k0) = o; } } }
    }
}
__device__ __forceinline__ void prologue_b(const Frame& F_, const Args& A) {
    const Frame F = fresh(F_);
    const float* T1 = WSP(float, WS_CTL) + CW_T1; float* MOD = WSP(float, WS_MOD); constexpr int NM = NMOD * DM;
    for (int u = F.gw; u < DEPTH * 2 * (NM / 256); u += F.ngw) { const int lw = u / (NM / 256), nc = u - lw * (NM / 256), layer = lw >> 1, n0 = nc * 256 + 4 * F.lane;
        f32x4 acc = *(const f32x4*)(inp(A, I_BMOD) + (size_t)layer * NM + n0); const float* t1 = T1 + lw * MODR; const float* wu = inp(A, I_WMU) + (size_t)layer * MODR * NM + n0;
#pragma unroll 8
        for (int j = 0; j < MODR; ++j) acc += *(const f32x4*)(wu + (size_t)j * NM) * t1[j];
        *(f32x4*)(MOD + (size_t)lw * NM + n0) = acc; }
}
__device__ __forceinline__ void norm_phase(const Frame& F_, const Args& A, const float* g, const float* modL, const float* modC, int ishift, int iscale, int dfrom) {
    const Frame F = fresh(F_);
    float* X = WSP(float, WS_X); bf16* U = WSP(bf16, WS_U); const bf16* Dd = WSP(bf16, WS_M32); LAS f32x4* L4 = (LAS f32x4*)F.lds;
    __syncthreads();
    for (int i = F.tid; i < DM / 4; i += NWAVES * 64) { L4[i] = *(const f32x4*)(g + 4 * i);
        L4[1024 + i] = *(const f32x4*)(modL + ishift * DM + 4 * i); L4[2048 + i] = *(const f32x4*)(modL + iscale * DM + 4 * i) + 1.0f;
        L4[3072 + i] = *(const f32x4*)(modC + ishift * DM + 4 * i); L4[4096 + i] = *(const f32x4*)(modC + iscale * DM + 4 * i) + 1.0f; }
    __syncthreads();
    for (int r = F.gw; r < MROWS; r += F.ngw) { const int mo = (r < CTXL) ? 3072 : 1024; f32x4* xr = (f32x4*)(X + (size_t)r * DM) + F.lane;
        f32x4 v[16]; float s = 0.f;
#pragma unroll
        for (int i = 0; i < 16; ++i) v[i] = xr[64 * i];
        if (r >= dfrom) { const v2u* dr = (const v2u*)(Dd + (size_t)r * DM) + F.lane;
#pragma unroll
            for (int i = 0; i < 16; ++i) { const v2u d = dr[64 * i]; v[i] += (f32x4){bflo(d.x), bfhi(d.x), bflo(d.y), bfhi(d.y)}; xr[64 * i] = v[i]; } }
#pragma unroll
        for (int i = 0; i < 16; ++i) s += (v[i].x * v[i].x + v[i].y * v[i].y) + (v[i].z * v[i].z + v[i].w * v[i].w);
        const float rms = rsqrtf(wave_sum(s) * (1.0f / DM) + EPSN);
        unsigned long long* o8 = (unsigned long long*)(U + (size_t)r * DM) + F.lane;
#pragma unroll
        for (int i = 0; i < 16; ++i) { const int c4 = F.lane + 64 * i; const f32x4 gg = L4[c4], sh = L4[mo + c4], sc1 = L4[mo + 1024 + c4];
            const f32x4 y = (v[i] * rms * gg) * sc1 + sh;
            o8[64 * i] = (unsigned long long)pk2(y.x, y.y) | ((unsigned long long)pk2(y.z, y.w) << 32); } }
    __syncthreads();
}
__device__ __forceinline__ void final_norm_phase(const Frame& F_, const Args& A) {
    const Frame F = fresh(F_);
    const float* X = WSP(float, WS_X); const bf16* Dd = WSP(bf16, WS_M32); const float* g = inp(A, I_FNORM);
    for (int r = F.gw; r < SEQ; r += F.ngw) { const f32x4* xr = (const f32x4*)(X + (size_t)(r + CTXL) * DM) + F.lane; const v2u* dr = (const v2u*)(Dd + (size_t)(r + CTXL) * DM) + F.lane; f32x4 v[16]; float s = 0.f;
#pragma unroll
        for (int i = 0; i < 16; ++i) { const v2u d = dr[64 * i]; v[i] = xr[64 * i] + (f32x4){bflo(d.x), bfhi(d.x), bflo(d.y), bfhi(d.y)}; s += (v[i].x * v[i].x + v[i].y * v[i].y) + (v[i].z * v[i].z + v[i].w * v[i].w); }
        const float rms = rsqrtf(wave_sum(s) * (1.0f / DM) + EPSN); f32x4* o = (f32x4*)(F.out + (size_t)r * DM) + F.lane;
#pragma unroll
        for (int i = 0; i < 16; ++i) o[64 * i] = v[i] * rms * *(const f32x4*)(g + 4 * F.lane + 256 * i); }
}

#ifdef DUMP
__device__ __forceinline__ void dump_phase(const Frame& F_, const Args& A) {
    const Frame F = fresh(F_);
    const bf16* YC = WSP(bf16, WS_YC); const bf16* YA = WSP(bf16, WS_YA); const bf16* YB = WSP(bf16, WS_YB);
#if DUMP >= 8
    { const bf16* P = WSP(bf16, WS_P); const size_t nctx = (size_t)CTXL * NIN;
      for (size_t i = (size_t)F.bid * 512 + F.tid; i < (size_t)SEQ * DM; i += (size_t)F.G * 512) { float v = 0.f;
          if (i < nctx) { if (DUMP & 8) v = bf1(P[i]); } else { const size_t k = i - nctx; const size_t r = k / DM, c = k % DM; if (DUMP & 16) v = bf1(P[(size_t)(r + CTXL) * NIN + c]); }
          F.out[i] = v; } return; }
#endif
    for (size_t i = (size_t)F.bid * 512 + F.tid; i < (size_t)SEQ * DM; i += (size_t)F.G * 512) { const int r = (int)(i / DM), c = (int)(i % DM); float v = 0.f;
        if (c < 1536) { if (DUMP & 1) v = bf1(YC[(size_t)(r + CTXL) * WMIX + c]); }
        else if (c < 3072) { if (DUMP & 2) v = bf1(YA[(size_t)(r + CTXL) * WMIX + c - 1536]); }
        else { if (DUMP & 4) v = bf1(YB[(size_t)(r + CTXL) * WMIX + c - 3072]); }
        F.out[i] = v; }
}
#endif
__device__ __forceinline__ bool same_seq(int r, int r2) { return r2 >= 0 && r2 < MROWS && ((r < CTXL) == (r2 < CTXL)); }
__device__ __forceinline__ void prep_lru_conv(const Frame& F_, const Args& A, int layer) {
    const Frame F = fresh(F_);
    const bf16* P = WSP(bf16, WS_P); bf16* XA = WSP(bf16, WS_XA); const float* w = inp(A, I_LCONV) + (size_t)layer * 4 * WMIX;
    const int nitems = (MROWS / 16) * (WMIX / 8);
    for (int it = F.bid * 512 + F.tid; it < nitems; it += F.G * 512) { const int run = it / (WMIX / 8), c0 = (it - run * (WMIX / 8)) * 8, r0 = run * 16;
        float wk[4][8];
#pragma unroll
        for (int k = 0; k < 4; ++k) { const f32x4 w0 = *(const f32x4*)(w + k * WMIX + c0), w1 = *(const f32x4*)(w + k * WMIX + c0 + 4);
            wk[k][0] = w0.x; wk[k][1] = w0.y; wk[k][2] = w0.z; wk[k][3] = w0.w; wk[k][4] = w1.x; wk[k][5] = w1.y; wk[k][6] = w1.z; wk[k][7] = w1.w; }
        v4u rows[19];
#pragma unroll
        for (int q = 0; q < 19; ++q) { const int r2 = r0 - 1 + q; rows[q] = same_seq(r0, r2) ? *(const v4u*)(P + (size_t)r2 * NIN + COL_AX + c0) : (v4u){0u, 0u, 0u, 0u}; }
#pragma unroll
        for (int t = 0; t < 16; ++t) { float acc[8] = {0.f, 0.f, 0.f, 0.f, 0.f, 0.f, 0.f, 0.f};
#pragma unroll
            for (int k = 0; k < 4; ++k) { const v4u pw = rows[t + k];
                acc[0] += wk[k][0] * bflo(pw.x); acc[1] += wk[k][1] * bfhi(pw.x); acc[2] += wk[k][2] * bflo(pw.y); acc[3] += wk[k][3] * bfhi(pw.y);
                acc[4] += wk[k][4] * bflo(pw.z); acc[5] += wk[k][5] * bfhi(pw.z); acc[6] += wk[k][6] * bflo(pw.w); acc[7] += wk[k][7] * bfhi(pw.w); }
            v4u o; o.x = pk2(acc[0], acc[1]); o.y = pk2(acc[2], acc[3]); o.z = pk2(acc[4], acc[5]); o.w = pk2(acc[6], acc[7]);
            *(v4u*)(XA + ((size_t)(c0 >> 8) * MROWS + r0 + t) * 256 + (c0 & 255)) = o; } }
}
__device__ __forceinline__ void prep_qkv(const Frame& F_, const Args& A, int layer) {
    const Frame F = fresh(F_);
    const bf16* P = WSP(bf16, WS_P); bf16* QN = WSP(bf16, WS_QN); bf16* KN = WSP(bf16, WS_KN); bf16* VN = WSP(bf16, WS_VN);
    const float* qg = inp(A, I_QN) + layer * 128; const float* kg = inp(A, I_KN) + layer * 128;
    const int d0 = (F.lane & 15) * 8, hl = F.lane >> 4;
    float gq[8], gk[8];
#pragma unroll
    for (int j = 0; j < 8; ++j) { gq[j] = qg[d0 + j]; gk[j] = kg[d0 + j]; }
    for (int r = F.gw; r < MROWS; r += F.ngw) { const bf16* pr = P + (size_t)r * NIN;
        float cs[4], sn[4]; const bool lat = r >= CTXL;
        if (lat) { const int s = r - CTXL, prow = s >> 6, pcol = s & 63;
#pragma unroll
            for (int j = 0; j < 4; ++j) { const int p = (d0 >> 1) + j;
                const float inv = exp2f(-(float)(p & 31) * (13.287712379549449f / 32.0f));
                const float ang = (float)((p < 32) ? prow : pcol) * inv; sincosf(ang, &sn[j], &cs[j]); } }
#pragma unroll
        for (int i = 0; i < 4; ++i) { const bool isq = i < 3; const int head = isq ? (hl + 4 * i) : hl;
            const bf16* src = pr + (isq ? (COL_CQ + head * 128) : (COL_CK + head * 128)) + d0;
            const v4u w = *(const v4u*)src; float v[8] = {bflo(w.x), bfhi(w.x), bflo(w.y), bfhi(w.y), bflo(w.z), bfhi(w.z), bflo(w.w), bfhi(w.w)};
            float ss = 0.f;
#pragma unroll
            for (int j = 0; j < 8; ++j) ss += v[j] * v[j];
            ss += swz_xor<1>(ss); ss += swz_xor<2>(ss); ss += swz_xor<4>(ss); ss += swz_xor<8>(ss);
            const float rms = rsqrtf(ss * (1.0f / 128.0f) + EPSN);
#pragma unroll
            for (int j = 0; j < 8; ++j) v[j] = v[j] * rms * (isq ? gq[j] : gk[j]);
            if (lat) {
#pragma unroll
                for (int j = 0; j < 4; ++j) { const float t0 = v[2 * j], t1 = v[2 * j + 1]; v[2 * j] = t0 * cs[j] - t1 * sn[j]; v[2 * j + 1] = t0 * sn[j] + t1 * cs[j]; } }
            v4u o; o.x = pk2(v[0], v[1]); o.y = pk2(v[2], v[3]); o.z = pk2(v[4], v[5]); o.w = pk2(v[6], v[7]);
            if (isq) *(v4u*)(QN + (size_t)r * WMIX + head * 128 + d0) = o; else *(v4u*)(KN + (size_t)r * KVW + head * 128 + d0) = o; }
        *(v4u*)(VN + (size_t)r * KVW + F.lane * 8) = *(const v4u*)(pr + COL_CV + F.lane * 8); }
}
__device__ __forceinline__ void prep_hyena_t(const Frame& F_, const Args& A, int layer) {
    const Frame F = fresh(F_);
    const bf16* P = WSP(bf16, WS_P); float* VT = WSP(float, WS_VT); const float* w = inp(A, I_HCONV) + (size_t)layer * 3 * (3 * WMIX);
    LAS float* scr = (LAS float*)(F.lds + F.wave * WSCR_BYTES);
    constexpr int NCB = 3 * WMIX / 64;
    for (int u = F.gw; u < (SEQ / 64) * NCB; u += F.ngw) { const int tb = u / NCB, cb = u - tb * NCB, t0 = tb * 64, c0 = cb * 64;
#pragma unroll
        for (int ps = 0; ps < 9; ++ps) { const int rr = ps * 8 + (F.lane >> 3), cc = (F.lane & 7) * 8; if (rr < 66) { const int t = t0 - 1 + rr; v4u pw = {0u, 0u, 0u, 0u};
                if (t >= 0 && t < SEQ) pw = *(const v4u*)(P + (size_t)(t + CTXL) * NIN + COL_B + c0 + cc);
                LAS float* d = scr + rr * 65 + cc; d[0] = bflo(pw.x); d[1] = bfhi(pw.x); d[2] = bflo(pw.y); d[3] = bfhi(pw.y); d[4] = bflo(pw.z); d[5] = bfhi(pw.z); d[6] = bflo(pw.w); d[7] = bfhi(pw.w); } }
        LDS_WAIT(); asm volatile("" ::: "memory");
        { const int part = c0 / WMIX, pr0 = (c0 - part * WMIX) >> 1; unsigned* dst = (unsigned*)VT + ((size_t)part * (WMIX / 2) + pr0) * SEQ + t0 + F.lane;
          for (int c = 0; c < 64; c += 2) { const int ch = c0 + c; f32x2 o;
              o.x = w[ch] * scr[F.lane * 65 + c] + w[3 * WMIX + ch] * scr[(F.lane + 1) * 65 + c] + w[2 * 3 * WMIX + ch] * scr[(F.lane + 2) * 65 + c];
              o.y = w[ch + 1] * scr[F.lane * 65 + c + 1] + w[3 * WMIX + ch + 1] * scr[(F.lane + 1) * 65 + c + 1] + w[2 * 3 * WMIX + ch + 1] * scr[(F.lane + 2) * 65 + c + 1];
              dst[(size_t)(c >> 1) * SEQ] = pk2(o.x, o.y); } }
        LDS_WAIT(); asm volatile("" ::: "memory"); }
}
__device__ __forceinline__ void prep_hyena_ctx(const Frame& F_, const Args& A, int layer) {
    const Frame F = fresh(F_);
    const bf16* P = WSP(bf16, WS_P); float* UC = WSP(float, WS_UC); const float* w = inp(A, I_HCONV) + (size_t)layer * 3 * (3 * WMIX);
    for (int it = F.bid * 512 + F.tid; it < CTXL * 3 * WMIX; it += F.G * 512) { const int t = it / (3 * WMIX), ch = it - t * (3 * WMIX);
        float v = w[3 * WMIX + ch] * bf1(P[(size_t)t * NIN + COL_B + ch]);
        if (t > 0) v += w[ch] * bf1(P[(size_t)(t - 1) * NIN + COL_B + ch]);
        if (t < CTXL - 1) v += w[2 * 3 * WMIX + ch] * bf1(P[(size_t)(t + 1) * NIN + COL_B + ch]);
        const int part = ch / WMIX, c = ch - part * WMIX; UC[((size_t)part * CTXL + t) * WMIX + c] = v; }
}
__device__ __forceinline__ void filt_mlp(const Frame& F_, const Args& A, int layer, bool with_ctx) {
    const Frame F = fresh(F_);
    float* H2 = WSP(float, WS_H2); float* H2C = WSP(float, WS_H2C);
    const float* fw1 = inp(A, I_HFW1) + (size_t)layer * 33 * 64; const float* fb1 = inp(A, I_HFB1) + layer * 64; const float* fr = inp(A, I_HFREQ) + layer * 64;
    const float* fw2 = inp(A, I_HFW2) + (size_t)layer * 64 * 64; const float* fb2 = inp(A, I_HFB2) + layer * 64;
    const int j = F.lane; const float frj = fr[j], b1 = fb1[j], b2 = fb2[j];
    const int total = SEQ + (with_ctx ? CTXL : 0);
    for (int u = F.gw; u < total; u += F.ngw) { const bool isc = u >= SEQ; const int t = isc ? u - SEQ : u, L = isc ? CTXL : SEQ;
        const float tl = (float)t / (float)(L - 1);
        const int b = j & 15; const float band = 1e-4f + (float)b * ((15.0f - 1e-4f) / 15.0f);
        const float ang = (6.283185307179586f / (float)L) * (float)t * band; float sn, cs; sincosf(ang, &sn, &cs); const float zc = cs, zs = -sn;
        float pre = b1 + tl * fw1[j];
#pragma unroll
        for (int i = 0; i < 16; ++i) { pre += lane_bcast(zc, i) * fw1[(1 + i) * 64 + j]; pre += lane_bcast(zs, i) * fw1[(17 + i) * 64 + j]; }
        const float h1 = sinf(frj * pre);
        float pre2 = b2;
#pragma unroll 16
        for (int i = 0; i < 64; ++i) pre2 += lane_bcast(h1, i) * fw2[i * 64 + j];
        const float h2 = sinf(frj * pre2);
        (isc ? H2C : H2)[(size_t)t * 64 + j] = h2; }
}
__device__ __forceinline__ float hy_delta(int c) {
    const float d0 = -4.605170185988091f / 1.5f, d1 = -4.605170185988091f / 0.3f; return d0 + (float)c * ((d1 - d0) / 1535.0f);
}
__device__ __forceinline__ void filt_taps_unit(const Frame& F_, const Args& A, int layer, int u) {
    const Frame F = fresh(F_);
    const float* H2 = WSP(float, WS_H2); float* KT = WSP(float, WS_KT); const float* fw3 = inp(A, I_HFW3) + (size_t)layer * 64 * 6144;
    LAS float* Wl = (LAS float*)F.lds;
    { const int cg = u >> 4, tsb = u & 15, t = tsb * 512 + F.tid;
        __syncthreads();
#pragma unroll 1
        for (int i = 0; i < 12; ++i) { const int e = F.tid + 512 * i, j = e / 96, rem = e - j * 96, od = rem / 24, cl = rem - od * 24;
            Wl[(cl * 4 + od) * 64 + j] = fw3[(size_t)j * 6144 + od * WMIX + cg * 24 + cl]; }
        f32x4 h2[16];
#pragma unroll
        for (int i = 0; i < 16; ++i) h2[i] = *(const f32x4*)(H2 + (size_t)t * 64 + 4 * i);
        __syncthreads();
        const float tl = (float)t / (float)(SEQ - 1);
#pragma unroll 1
        for (int cp = 0; cp < 12; ++cp) { float acc[8];
#pragma unroll
            for (int q = 0; q < 8; ++q) { const LAS f32x4* wp = (const LAS f32x4*)(Wl + (cp * 8 + q) * 64); f32x4 a = {0.f, 0.f, 0.f, 0.f};
#pragma unroll
                for (int i = 0; i < 16; ++i) { a += h2[i] * wp[i]; if ((i & 3) == 3) asm volatile("" ::: "memory"); }
                acc[q] = (a.x + a.y) + (a.z + a.w); asm volatile("" : "+v"(acc[q]) :: "memory"); }
            const int c = cg * 24 + 2 * cp; const float d0 = __expf(tl * hy_delta(c)), d1 = __expf(tl * hy_delta(c + 1));
#pragma unroll
            for (int o = 0; o < 2; ++o) { f32x2* kt = (f32x2*)KT + ((size_t)o * (WMIX / 2) + (c >> 1)) * FFTN;
                const f32x2 hf = {acc[o * 2] * d0, acc[4 + o * 2] * d1}, hb = {acc[o * 2 + 1] * d0, acc[4 + o * 2 + 1] * d1};
                if (t == 0) { kt[0] = hf + hb; kt[SEQ] = (f32x2){0.f, 0.f}; } else { kt[t] = hf; kt[FFTN - t] = hb; } } }
    }
    __syncthreads();
}
__device__ __forceinline__ void filt_taps_ctx(const Frame& F_, const Args& A, int layer) {
    const Frame F = fresh(F_);
    const float* H2C = WSP(float, WS_H2C); float* KC = WSP(float, WS_KC); const float* fw3 = inp(A, I_HFW3) + (size_t)layer * 64 * 6144;
    for (int u = F.gw; u < CTXL * 48; u += F.ngw) { const int t = u / 48, oc = (u - t * 48) * 64 + F.lane, o = oc / WMIX, c = oc - o * WMIX;
        const float hrow = H2C[t * 64 + F.lane];
        const float* wf = fw3 + o * 2 * WMIX + c; float hf = 0.f, hb = 0.f;
#pragma unroll 32
        for (int j = 0; j < 64; ++j) { const float h = lane_bcast(hrow, j); hf += h * wf[(size_t)j * 6144]; hb += h * wf[(size_t)j * 6144 + WMIX]; }
        const float dec = __expf(((float)t / (float)(CTXL - 1)) * hy_delta(c)); hf *= dec; hb *= dec;
        float* kc = KC + (size_t)o * 512 * WMIX + c;
        if (t == 0) kc[(size_t)255 * WMIX] = hf + hb; else { kc[(size_t)(255 + t) * WMIX] = hf; kc[(size_t)(255 - t) * WMIX] = hb; } }
}
__device__ __forceinline__ void filt_norm_ctx(const Frame& F_, const Args& A) {
    const Frame F = fresh(F_);
    const float* KC = WSP(float, WS_KC); float* KCN = WSP(float, WS_KCN); LAS float* red = (LAS float*)F.lds;
    for (int u = F.bid; u < 48; u += F.G) { const int o = u / 24, c = (u - o * 24) * 64 + F.lane; const float* kc = KC + (size_t)o * 512 * WMIX + c; float s = 0.f;
#pragma unroll 16
        for (int i = 0; i < 64; ++i) { const int l = F.wave + 8 * i; const float k = (l < 511) ? kc[(size_t)l * WMIX] : 0.f; s += k * k; }
        __syncthreads(); red[F.wave * 64 + F.lane] = s; __syncthreads();
        if (F.wave == 0) { float t = 0.f;
#pragma unroll
            for (int w = 0; w < 8; ++w) t += red[w * 64 + F.lane];
            KCN[o * WMIX + c] = rsqrtf(t + EPSN); }
    }
    __syncthreads();
}

#define DFT_BF0(A_, B_) do { const f32x2 a_ = (A_), t_ = (B_); (A_) = a_ + t_; (B_) = a_ - t_; } while (0)
#define DFT_BF8(A_, B_) do { const f32x2 a_ = (A_), b_ = (B_); const f32x2 t_ = {b_.y, -b_.x}; (A_) = a_ + t_; (B_) = a_ - t_; } while (0)
#define DFT_BFW(A_, B_, C_, S_) do { const f32x2 a_ = (A_), b_ = (B_); const f32x2 t_ = {b_.x * (C_) - b_.y * (S_), b_.x * (S_) + b_.y * (C_)}; (A_) = a_ + t_; (B_) = a_ - t_; } while (0)
template <int OFF> __device__ __forceinline__ void dft32(f32x2 (&v)[32]) {
    { const f32x2 t = v[OFF + 1]; v[OFF + 1] = v[OFF + 16]; v[OFF + 16] = t; }
    { const f32x2 t = v[OFF + 2]; v[OFF + 2] = v[OFF + 8]; v[OFF + 8] = t; }
    { const f32x2 t = v[OFF + 3]; v[OFF + 3] = v[OFF + 24]; v[OFF + 24] = t; }
    { const f32x2 t = v[OFF + 5]; v[OFF + 5] = v[OFF + 20]; v[OFF + 20] = t; }
    { const f32x2 t = v[OFF + 6]; v[OFF + 6] = v[OFF + 12]; v[OFF + 12] = t; }
    { const f32x2 t = v[OFF + 7]; v[OFF + 7] = v[OFF + 28]; v[OFF + 28] = t; }
    { const f32x2 t = v[OFF + 9]; v[OFF + 9] = v[OFF + 18]; v[OFF + 18] = t; }
    { const f32x2 t = v[OFF + 11]; v[OFF + 11] = v[OFF + 26]; v[OFF + 26] = t; }
    { const f32x2 t = v[OFF + 13]; v[OFF + 13] = v[OFF + 22]; v[OFF + 22] = t; }
    { const f32x2 t = v[OFF + 15]; v[OFF + 15] = v[OFF + 30]; v[OFF + 30] = t; }
    { const f32x2 t = v[OFF + 19]; v[OFF + 19] = v[OFF + 25]; v[OFF + 25] = t; }
    { const f32x2 t = v[OFF + 23]; v[OFF + 23] = v[OFF + 29]; v[OFF + 29] = t; }
    DFT_BF0(v[OFF + 0], v[OFF + 1]);
    DFT_BF0(v[OFF + 2], v[OFF + 3]);
    DFT_BF0(v[OFF + 4], v[OFF + 5]);
    DFT_BF0(v[OFF + 6], v[OFF + 7]);
    DFT_BF0(v[OFF + 8], v[OFF + 9]);
    DFT_BF0(v[OFF + 10], v[OFF + 11]);
    DFT_BF0(v[OFF + 12], v[OFF + 13]);
    DFT_BF0(v[OFF + 14], v[OFF + 15]);
    DFT_BF0(v[OFF + 16], v[OFF + 17]);
    DFT_BF0(v[OFF + 18], v[OFF + 19]);
    DFT_BF0(v[OFF + 20], v[OFF + 21]);
    DFT_BF0(v[OFF + 22], v[OFF + 23]);
    DFT_BF0(v[OFF + 24], v[OFF + 25]);
    DFT_BF0(v[OFF + 26], v[OFF + 27]);
    DFT_BF0(v[OFF + 28], v[OFF + 29]);
    DFT_BF0(v[OFF + 30], v[OFF + 31]);
    DFT_BF0(v[OFF + 0], v[OFF + 2]);
    DFT_BF8(v[OFF + 1], v[OFF + 3]);
    DFT_BF0(v[OFF + 4], v[OFF + 6]);
    DFT_BF8(v[OFF + 5], v[OFF + 7]);
    DFT_BF0(v[OFF + 8], v[OFF + 10]);
    DFT_BF8(v[OFF + 9], v[OFF + 11]);
    DFT_BF0(v[OFF + 12], v[OFF + 14]);
    DFT_BF8(v[OFF + 13], v[OFF + 15]);
    DFT_BF0(v[OFF + 16], v[OFF + 18]);
    DFT_BF8(v[OFF + 17], v[OFF + 19]);
    DFT_BF0(v[OFF + 20], v[OFF + 22]);
    DFT_BF8(v[OFF + 21], v[OFF + 23]);
    DFT_BF0(v[OFF + 24], v[OFF + 26]);
    DFT_BF8(v[OFF + 25], v[OFF + 27]);
    DFT_BF0(v[OFF + 28], v[OFF + 30]);
    DFT_BF8(v[OFF + 29], v[OFF + 31]);
    DFT_BF0(v[OFF + 0], v[OFF + 4]);
    DFT_BFW(v[OFF + 1], v[OFF + 5], 0.70710678118654757f, -0.70710678118654746f);
    DFT_BF8(v[OFF + 2], v[OFF + 6]);
    DFT_BFW(v[OFF + 3], v[OFF + 7], -0.70710678118654746f, -0.70710678118654757f);
    DFT_BF0(v[OFF + 8], v[OFF + 12]);
    DFT_BFW(v[OFF + 9], v[OFF + 13], 0.70710678118654757f, -0.70710678118654746f);
    DFT_BF8(v[OFF + 10], v[OFF + 14]);
    DFT_BFW(v[OFF + 11], v[OFF + 15], -0.70710678118654746f, -0.70710678118654757f);
    DFT_BF0(v[OFF + 16], v[OFF + 20]);
    DFT_BFW(v[OFF + 17], v[OFF + 21], 0.70710678118654757f, -0.70710678118654746f);
    DFT_BF8(v[OFF + 18], v[OFF + 22]);
    DFT_BFW(v[OFF + 19], v[OFF + 23], -0.70710678118654746f, -0.70710678118654757f);
    DFT_BF0(v[OFF + 24], v[OFF + 28]);
    DFT_BFW(v[OFF + 25], v[OFF + 29], 0.70710678118654757f, -0.70710678118654746f);
    DFT_BF8(v[OFF + 26], v[OFF + 30]);
    DFT_BFW(v[OFF + 27], v[OFF + 31], -0.70710678118654746f, -0.70710678118654757f);
    DFT_BF0(v[OFF + 0], v[OFF + 8]);
    DFT_BFW(v[OFF + 1], v[OFF + 9], 0.92387953251128674f, -0.38268343236508978f);
    DFT_BFW(v[OFF + 2], v[OFF + 10], 0.70710678118654757f, -0.70710678118654746f);
    DFT_BFW(v[OFF + 3], v[OFF + 11], 0.38268343236508984f, -0.92387953251128674f);
    DFT_BF8(v[OFF + 4], v[OFF + 12]);
    DFT_BFW(v[OFF + 5], v[OFF + 13], -0.38268343236508973f, -0.92387953251128674f);
    DFT_BFW(v[OFF + 6], v[OFF + 14], -0.70710678118654746f, -0.70710678118654757f);
    DFT_BFW(v[OFF + 7], v[OFF + 15], -0.92387953251128674f, -0.38268343236508989f);
    DFT_BF0(v[OFF + 16], v[OFF + 24]);
    DFT_BFW(v[OFF + 17], v[OFF + 25], 0.92387953251128674f, -0.38268343236508978f);
    DFT_BFW(v[OFF + 18], v[OFF + 26], 0.70710678118654757f, -0.70710678118654746f);
    DFT_BFW(v[OFF + 19], v[OFF + 27], 0.38268343236508984f, -0.92387953251128674f);
    DFT_BF8(v[OFF + 20], v[OFF + 28]);
    DFT_BFW(v[OFF + 21], v[OFF + 29], -0.38268343236508973f, -0.92387953251128674f);
    DFT_BFW(v[OFF + 22], v[OFF + 30], -0.70710678118654746f, -0.70710678118654757f);
    DFT_BFW(v[OFF + 23], v[OFF + 31], -0.92387953251128674f, -0.38268343236508989f);
    DFT_BF0(v[OFF + 0], v[OFF + 16]);
    DFT_BFW(v[OFF + 1], v[OFF + 17], 0.98078528040323043f, -0.19509032201612825f);
    DFT_BFW(v[OFF + 2], v[OFF + 18], 0.92387953251128674f, -0.38268343236508978f);
    DFT_BFW(v[OFF + 3], v[OFF + 19], 0.83146961230254524f, -0.55557023301960218f);
    DFT_BFW(v[OFF + 4], v[OFF + 20], 0.70710678118654757f, -0.70710678118654746f);
    DFT_BFW(v[OFF + 5], v[OFF + 21], 0.55557023301960229f, -0.83146961230254524f);
    DFT_BFW(v[OFF + 6], v[OFF + 22], 0.38268343236508984f, -0.92387953251128674f);
    DFT_BFW(v[OFF + 7], v[OFF + 23], 0.19509032201612833f, -0.98078528040323043f);
    DFT_BF8(v[OFF + 8], v[OFF + 24]);
    DFT_BFW(v[OFF + 9], v[OFF + 25], -0.19509032201612819f, -0.98078528040323043f);
    DFT_BFW(v[OFF + 10], v[OFF + 26], -0.38268343236508973f, -0.92387953251128674f);
    DFT_BFW(v[OFF + 11], v[OFF + 27], -0.55557023301960196f, -0.83146961230254546f);
    DFT_BFW(v[OFF + 12], v[OFF + 28], -0.70710678118654746f, -0.70710678118654757f);
    DFT_BFW(v[OFF + 13], v[OFF + 29], -0.83146961230254535f, -0.55557023301960218f);
    DFT_BFW(v[OFF + 14], v[OFF + 30], -0.92387953251128674f, -0.38268343236508989f);
    DFT_BFW(v[OFF + 15], v[OFF + 31], -0.98078528040323043f, -0.19509032201612861f);
}
template <int OFF> __device__ __forceinline__ void dft16(f32x2 (&v)[32]) {
    { const f32x2 t = v[OFF + 1]; v[OFF + 1] = v[OFF + 8]; v[OFF + 8] = t; }
    { const f32x2 t = v[OFF + 2]; v[OFF + 2] = v[OFF + 4]; v[OFF + 4] = t; }
    { const f32x2 t = v[OFF + 3]; v[OFF + 3] = v[OFF + 12]; v[OFF + 12] = t; }
    { const f32x2 t = v[OFF + 5]; v[OFF + 5] = v[OFF + 10]; v[OFF + 10] = t; }
    { const f32x2 t = v[OFF + 7]; v[OFF + 7] = v[OFF + 14]; v[OFF + 14] = t; }
    { const f32x2 t = v[OFF + 11]; v[OFF + 11] = v[OFF + 13]; v[OFF + 13] = t; }
    DFT_BF0(v[OFF + 0], v[OFF + 1]);
    DFT_BF0(v[OFF + 2], v[OFF + 3]);
    DFT_BF0(v[OFF + 4], v[OFF + 5]);
    DFT_BF0(v[OFF + 6], v[OFF + 7]);
    DFT_BF0(v[OFF + 8], v[OFF + 9]);
    DFT_BF0(v[OFF + 10], v[OFF + 11]);
    DFT_BF0(v[OFF + 12], v[OFF + 13]);
    DFT_BF0(v[OFF + 14], v[OFF + 15]);
    DFT_BF0(v[OFF + 0], v[OFF + 2]);
    DFT_BF8(v[OFF + 1], v[OFF + 3]);
    DFT_BF0(v[OFF + 4], v[OFF + 6]);
    DFT_BF8(v[OFF + 5], v[OFF + 7]);
    DFT_BF0(v[OFF + 8], v[OFF + 10]);
    DFT_BF8(v[OFF + 9], v[OFF + 11]);
    DFT_BF0(v[OFF + 12], v[OFF + 14]);
    DFT_BF8(v[OFF + 13], v[OFF + 15]);
    DFT_BF0(v[OFF + 0], v[OFF + 4]);
    DFT_BFW(v[OFF + 1], v[OFF + 5], 0.70710678118654757f, -0.70710678118654746f);
    DFT_BF8(v[OFF + 2], v[OFF + 6]);
    DFT_BFW(v[OFF + 3], v[OFF + 7], -0.70710678118654746f, -0.70710678118654757f);
    DFT_BF0(v[OFF + 8], v[OFF + 12]);
    DFT_BFW(v[OFF + 9], v[OFF + 13], 0.70710678118654757f, -0.70710678118654746f);
    DFT_BF8(v[OFF + 10], v[OFF + 14]);
    DFT_BFW(v[OFF + 11], v[OFF + 15], -0.70710678118654746f, -0.70710678118654757f);
    DFT_BF0(v[OFF + 0], v[OFF + 8]);
    DFT_BFW(v[OFF + 1], v[OFF + 9], 0.92387953251128674f, -0.38268343236508978f);
    DFT_BFW(v[OFF + 2], v[OFF + 10], 0.70710678118654757f, -0.70710678118654746f);
    DFT_BFW(v[OFF + 3], v[OFF + 11], 0.38268343236508984f, -0.92387953251128674f);
    DFT_BF8(v[OFF + 4], v[OFF + 12]);
    DFT_BFW(v[OFF + 5], v[OFF + 13], -0.38268343236508973f, -0.92387953251128674f);
    DFT_BFW(v[OFF + 6], v[OFF + 14], -0.70710678118654746f, -0.70710678118654757f);
    DFT_BFW(v[OFF + 7], v[OFF + 15], -0.92387953251128674f, -0.38268343236508989f);
}

__device__ __forceinline__ f32x2 cmul(f32x2 a, f32x2 b) { return (f32x2){a.x * b.x - a.y * b.y, a.x * b.y + a.y * b.x}; }
__device__ __forceinline__ int pidx(int i) { return i + (i >> 5); }
template <int R, int OFF> __device__ __forceinline__ void twiddle_reg(f32x2 (&v)[32], int num, float inv_den) {
    float s, c; __sincosf(-6.283185307179586f * (float)num * inv_den, &s, &c); const f32x2 w = {c, s}; f32x2 wr = w;
#pragma unroll
    for (int r = 1; r < R; ++r) { v[OFF + r] = cmul(v[OFF + r], wr); wr = cmul(wr, w); }
}
template <bool IN_REGS, bool HALF_ZERO, bool OUT_REGS> __device__ __forceinline__ void fft16k(LAS f32x2* Z, f32x2 (&v)[32], int tid) {
    asm volatile("" : "+v"(tid));
    LAS f32x2* Zt = Z + pidx(tid);
    if (!IN_REGS) {
#pragma unroll
        for (int r = 0; r < 32; ++r) v[r] = (HALF_ZERO && r >= 16) ? (f32x2){0.f, 0.f} : Zt[528 * r];
        __syncthreads(); }
    dft32<0>(v);
    { LAS f32x2* Zw = Z + 33 * tid;
#pragma unroll
      for (int q = 0; q < 32; ++q) Zw[q] = v[q]; }
    __syncthreads();
#pragma unroll
    for (int r = 0; r < 32; ++r) v[r] = Zt[528 * r];
    __syncthreads();
    twiddle_reg<32, 0>(v, tid & 31, 1.0f / 1024.0f); dft32<0>(v);
    { LAS f32x2* Zw = Z + (tid >> 5) * 1056 + (tid & 31);
#pragma unroll
      for (int q = 0; q < 32; ++q) Zw[33 * q] = v[q]; }
    __syncthreads();
#pragma unroll
    for (int h = 0; h < 2; ++h)
#pragma unroll
        for (int r = 0; r < 16; ++r) v[h * 16 + r] = Zt[528 * h + 1056 * r];
    __syncthreads();
    twiddle_reg<16, 0>(v, tid, 1.0f / 16384.0f); twiddle_reg<16, 16>(v, tid + 512, 1.0f / 16384.0f); dft16<0>(v); dft16<16>(v);
    if (!OUT_REGS) {
#pragma unroll
        for (int h = 0; h < 2; ++h)
#pragma unroll
            for (int q = 0; q < 16; ++q) Zt[528 * h + 1056 * q] = v[h * 16 + q];
        __syncthreads(); }
}
__device__ __forceinline__ void filt_spectra_unit(const Frame& F_, const Args& A, int u) {
    const Frame F = fresh(F_);
    const float* KT = WSP(float, WS_KT); f32x2* PM = WSP(f32x2, WS_PM); LAS f32x2* Z = (LAS f32x2*)F.lds; LAS float* red = (LAS float*)(F.lds + RED_OFF); constexpr int PMS = 8704;
    { const int o = u / 768, p = u - o * 768;
        const f32x2* kab = (const f32x2*)KT + ((size_t)o * (WMIX / 2) + p) * FFTN + F.tid;
        f32x2 v[32]; float sa = 0.f, sb = 0.f;
#pragma unroll
        for (int r = 0; r < 32; ++r) { v[r] = kab[512 * r]; sa += v[r].x * v[r].x; sb += v[r].y * v[r].y; }
        sa = wave_sum(sa); sb = wave_sum(sb);
        __syncthreads();
        if (F.lane == 0) { red[F.wave * 2] = sa; red[F.wave * 2 + 1] = sb; }
        __syncthreads();
        float ta = 0.f, tb = 0.f;
#pragma unroll
        for (int w = 0; w < 8; ++w) { ta += red[w * 2]; tb += red[w * 2 + 1]; }
        const float na = rsqrtf(ta + EPSN) * 0.5f, nb = rsqrtf(tb + EPSN) * 0.5f;
#pragma unroll
        for (int r = 0; r < 32; ++r) { const float a = v[r].x * na, b = v[r].y * nb; v[r] = (f32x2){a + b, a - b}; }
        fft16k<true, false, false>(Z, v, F.tid);
        f32x4* pm4 = (f32x4*)PM + (size_t)(o * 768 + p) * PMS;
#pragma unroll 4
        for (int i = 0; i < 16; ++i) { const int k = F.tid + 512 * i, km = (FFTN - k) & (FFTN - 1); const f32x2 wk = Z[pidx(k)], wm = Z[pidx(km)];
            pm4[k] = (f32x4){0.5f * (wk.x + wm.x), 0.5f * (wk.y - wm.y), 0.5f * (wk.y + wm.y), -0.5f * (wk.x - wm.x)}; }
        if (F.tid == 0) { const f32x2 wk = Z[pidx(FFTN / 2)]; pm4[FFTN / 2] = (f32x4){wk.x, 0.f, wk.y, 0.f}; }
    }
    __syncthreads();
}
__device__ __forceinline__ void filler(const Frame& F, const Args& A, int kind, int flayer, int base, int j, int nidle, int quota) {
    if (j < 0) return;
    const int total = (kind == 1) ? 1024 : 1536;
#pragma unroll 1
    for (int m = 0; m < quota; ++m) { const int u = base + j + nidle * m; if (u >= total || u >= base + nidle * quota) break;
        if (kind == 1) filt_taps_unit(F, A, flayer, u); else filt_spectra_unit(F, A, u); }
}
__device__ __forceinline__ void hyena_conv_unit(const Frame& F_, const Args& A, int layer, int p) {
    const Frame F = fresh(F_);
    const unsigned* VT2 = WSP(unsigned, WS_VT)  ; unsigned* YBT2 = WSP(unsigned, WS_YBT)  ; const f32x4* PM4 = WSP(f32x4, WS_PM); LAS f32x2* Z = (LAS f32x2*)F.lds; constexpr int PMS = 8704;
    const int tid = F.tid; const float* skip = inp(A, I_HSKIP) + (size_t)layer * 2 * WMIX;
    LAS f32x2* Zt = Z + pidx(tid);
    f32x2 v[32];
    __syncthreads();
    { const unsigned* v0 = VT2 + (size_t)p * SEQ + tid;
#pragma unroll
      for (int r = 0; r < 16; ++r) { const unsigned w = v0[512 * r]; Zt[528 * r] = (f32x2){bflo(w), bfhi(w)}; } }
    __syncthreads();
#pragma unroll 1
    for (int o = 0; o < 2; ++o) {
        const f32x4* pmp = PM4 + (size_t)(o * 768 + p) * PMS;
        f32x4 pm[16];
#pragma unroll
        for (int i = 0; i < 16; ++i) pm[i] = pmp[tid + 512 * i];
        const f32x4 pmh = pmp[FFTN / 2];
        fft16k<false, true, false>(Z, v, tid);
#pragma unroll
        for (int i = 0; i < 16; ++i) { const int k = tid + 512 * i, km = (FFTN - k) & (FFTN - 1); const f32x2 zk = Zt[528 * i], zm = Z[pidx(km)];
            const f32x2 pk = {pm[i].x, pm[i].y}, mk = {pm[i].z, pm[i].w};
            const f32x2 cyk = cmul((f32x2){zk.x, -zk.y}, (f32x2){pk.x, -pk.y}) + cmul(zm, (f32x2){mk.x, -mk.y});
            const f32x2 cym = cmul((f32x2){zm.x, -zm.y}, pk) + cmul(zk, mk);
            Zt[528 * i] = cyk; if (km != k) Z[pidx(km)] = cym; }
        if (tid == 0) { const int k = FFTN / 2; const f32x2 zk = Z[pidx(k)]; const f32x2 pk = {pmh.x, pmh.y}, mk = {pmh.z, pmh.w};
            Z[pidx(k)] = cmul((f32x2){zk.x, -zk.y}, (f32x2){pk.x, -pk.y}) + cmul(zk, (f32x2){mk.x, -mk.y}); }
        __syncthreads();
        const unsigned* gp = VT2 + ((size_t)(o + 1) * (WMIX / 2) + p) * SEQ + tid;
        const unsigned* zp = ((o == 0) ? VT2 : (const unsigned*)YBT2) + (size_t)p * SEQ + tid;
        unsigned gg[16], zz[16];
#pragma unroll
        for (int h = 0; h < 2; ++h)
#pragma unroll
            for (int q = 0; q < 8; ++q) { const int dt = 512 * h + 1024 * q; gg[h * 8 + q] = gp[dt]; zz[h * 8 + q] = zp[dt]; }
        fft16k<false, false, true>(Z, v, tid);
        const float ska = skip[o * WMIX + 2 * p], skb = skip[o * WMIX + 2 * p + 1];
        unsigned* yo = YBT2 + (size_t)p * SEQ + tid;
#pragma unroll
        for (int h = 0; h < 2; ++h)
#pragma unroll
            for (int q = 0; q < 8; ++q) { const f32x2 R = v[h * 16 + q], g = {bflo(gg[h * 8 + q]), bfhi(gg[h * 8 + q])}, z = {bflo(zz[h * 8 + q]), bfhi(zz[h * 8 + q])};
                const f32x2 zn = {g.x * (R.x * (1.0f / FFTN) + ska * z.x), g.y * (-R.y * (1.0f / FFTN) + skb * z.y)};
                const unsigned zw = pk2(zn.x, zn.y); yo[512 * h + 1024 * q] = zw; if (o == 0) Zt[528 * h + 1056 * q] = (f32x2){bflo(zw), bfhi(zw)}; }
        __syncthreads();
    }
}
#ifdef PROBE_FFT
__device__ __forceinline__ void hyena_fft_dummy(const Frame& F_) {
    const Frame F = fresh(F_); LAS f32x2* Z = (LAS f32x2*)F.lds; f32x2 v[32];
    __syncthreads();
#pragma unroll 1
    for (int o = 0; o < 2; ++o) { fft16k<false, true, false>(Z, v, F.tid); fft16k<false, false, true>(Z, v, F.tid);
        if (v[0].x == 123456.789f) Z[0] = v[5];
        __syncthreads(); }
}
#endif
__device__ __forceinline__ void hyena_ctx_unit(const Frame& F_, const Args& A, int layer, int u) {
    const Frame F = fresh(F_);
    const float* UC = WSP(float, WS_UC); const float* KC = WSP(float, WS_KC); const float* KCN = WSP(float, WS_KCN); bf16* YB = WSP(bf16, WS_YB);
    LAS float* zb0 = (LAS float*)F.lds; LAS float* zb1 = zb0 + 256 * 32;
    const int cl = F.tid & 31, tb = F.tid >> 5, c = u * 32 + cl, t0 = tb * 16; const float* skip = inp(A, I_HSKIP) + (size_t)layer * 2 * WMIX;
    float zc[16], g1[16], g2[16];
    __syncthreads();
#pragma unroll
    for (int i = 0; i < 16; ++i) { zc[i] = UC[((size_t)0 * CTXL + t0 + i) * WMIX + c]; g1[i] = UC[((size_t)1 * CTXL + t0 + i) * WMIX + c]; g2[i] = UC[((size_t)2 * CTXL + t0 + i) * WMIX + c]; zb0[(t0 + i) * 32 + cl] = zc[i]; }
    __syncthreads();
#pragma unroll
    for (int o = 0; o < 2; ++o) { const LAS float* zb = o ? zb1 : zb0; const float* kc = KC + (size_t)o * 512 * WMIX + c; float acc[16];
#pragma unroll
        for (int i = 0; i < 16; ++i) acc[i] = 0.f;
#pragma unroll 1
        for (int s0 = 0; s0 < CTXL; s0 += 16) { float w[31]; const float* kb = kc + (size_t)(255 + t0 - s0 - 15) * WMIX;
#pragma unroll
            for (int q = 0; q < 31; ++q) w[q] = kb[(size_t)q * WMIX];
#pragma unroll
            for (int j = 0; j < 16; ++j) { const float zs = zb[(s0 + j) * 32 + cl];
#pragma unroll
                for (int i = 0; i < 16; ++i) acc[i] += w[15 + i - j] * zs; } }
        const float kn = KCN[o * WMIX + c], sk = skip[o * WMIX + c];
#pragma unroll
        for (int i = 0; i < 16; ++i) { const float zn = (o ? g2[i] : g1[i]) * (acc[i] * kn + sk * zc[i]);
            if (o == 0) { zc[i] = zn; zb1[(t0 + i) * 32 + cl] = zn; } else YB[(size_t)(t0 + i) * WMIX + c] = (bf16)f2bf(zn); }
        __syncthreads(); }
}
__device__ __forceinline__ void lru_chunk_agg(const Frame& F_, const Args& A) {
    const Frame F = fresh(F_);
    const unsigned* LAB = WSP(unsigned, WS_LA); float* CA = WSP(float, WS_CA); float* CB = WSP(float, WS_CB);
    for (int u = F.gw; u < NCHUNK * 12; u += F.ngw) { const int chunk = u / 12, rem = u - chunk * 12, dir = rem / 6, c = (rem - dir * 6) * 256 + 4 * F.lane;
        const unsigned* pab = LAB + (((size_t)dir * NCHUNK + chunk) * 6 + (c >> 8)) * 64 * 256 + (c & 255);
        f32x4 Aa = {1.f, 1.f, 1.f, 1.f}, B = {0.f, 0.f, 0.f, 0.f};
#pragma unroll 32
        for (int i = 0; i < 64; ++i) { const int rr = dir ? 63 - i : i; const v4u w = *(const v4u*)(pab + rr * 256);
            const f32x4 a = {__expf(bflo(w.x)), __expf(bflo(w.y)), __expf(bflo(w.z)), __expf(bflo(w.w))}, b = {bfhi(w.x), bfhi(w.y), bfhi(w.z), bfhi(w.w)}; B = a * B + b; Aa = Aa * a; }
        *(f32x4*)(CA + ((size_t)dir * NCHUNK + chunk) * WMIX + c) = Aa; *(f32x4*)(CB + ((size_t)dir * NCHUNK + chunk) * WMIX + c) = B; }
}
__device__ __forceinline__ void lru_carries(const Frame& F_, const Args& A) {
    const Frame F = fresh(F_);
    const float* CA = WSP(float, WS_CA); const float* CB = WSP(float, WS_CB); float* CIN = WSP(float, WS_CIN);
    const int slot = F.bid >> 3; if ((F.bid & 7) != 1 || slot < 4 || slot >= 10) return;
    { const int u = (slot - 4) * 8 + F.wave; const int dir = u / 24, c = (u - dir * 24) * 64 + F.lane; float H = 0.f;
#pragma unroll 1
        for (int i0 = 0; i0 < NCHUNK; i0 += 22) { float ca[22], cb[22];
#pragma unroll
            for (int j = 0; j < 22; ++j) { const int i = i0 + j, chunk = dir ? ((i < 4) ? 3 - i : NCHUNK + 3 - i) : i; const size_t ix = ((size_t)dir * NCHUNK + chunk) * WMIX + c; ca[j] = CA[ix]; cb[j] = CB[ix]; }
#pragma unroll
            for (int j = 0; j < 22; ++j) { const int i = i0 + j, chunk = dir ? ((i < 4) ? 3 - i : NCHUNK + 3 - i) : i; const size_t ix = ((size_t)dir * NCHUNK + chunk) * WMIX + c; CIN[ix] = H; H = ca[j] * H + cb[j]; } } }
}
__device__ __forceinline__ void lru_out(const Frame& F_, const Args& A) {
    const Frame F = fresh(F_);
    const unsigned* LAB = WSP(unsigned, WS_LA); const float* CIN = WSP(float, WS_CIN); const bf16* P = WSP(bf16, WS_P); bf16* YA = WSP(bf16, WS_YA);
    for (int u = F.gw; u < NCHUNK * 12; u += F.ngw) { const int chunk = u / 12, c = (u - chunk * 12) * 128 + 2 * F.lane, base = chunk * 64;
        const unsigned* pf = LAB + (((size_t)chunk) * 6 + (c >> 8)) * 64 * 256 + (c & 255); const unsigned* pr = pf + (size_t)NCHUNK * 6 * 64 * 256;
        f32x2 hf[64]; f32x2 H = *(const f32x2*)(CIN + ((size_t)chunk) * WMIX + c);
#pragma unroll
        for (int i = 0; i < 64; ++i) { const v2u w = *(const v2u*)(pf + i * 256); H = (f32x2){__expf(bflo(w.x)), __expf(bflo(w.y))} * H + (f32x2){bfhi(w.x), bfhi(w.y)}; hf[i] = H; }
        H = *(const f32x2*)(CIN + ((size_t)NCHUNK + chunk) * WMIX + c);
#pragma unroll
        for (int i = 63; i >= 0; --i) { const v2u w = *(const v2u*)(pr + i * 256); H = (f32x2){__expf(bflo(w.x)), __expf(bflo(w.y))} * H + (f32x2){bfhi(w.x), bfhi(w.y)};
            const unsigned gw = *(const unsigned*)(P + (size_t)(base + i) * NIN + COL_AG + c); const f32x2 y = (hf[i] + H) * (f32x2){bflo(gw), bfhi(gw)};
            *(unsigned*)(YA + (size_t)(base + i) * WMIX + c) = pk2(y.x, y.y); } }
}
__device__ __forceinline__ void yb_transpose(const Frame& F_, const Args& A) {
    const Frame F = fresh(F_);
    const float* YBT = WSP(float, WS_YBT); bf16* YB = WSP(bf16, WS_YB); LAS float* scr = (LAS float*)(F.lds + F.wave * WSCR_BYTES);
    for (int u = F.gw; u < (SEQ / 64) * 24; u += F.ngw) { const int tb = u / 24, c0 = (u - tb * 24) * 64, t0 = tb * 64;
#pragma unroll
        for (int i = 0; i < 32; ++i) { const unsigned y = ((const unsigned*)YBT)[(size_t)((c0 >> 1) + i) * SEQ + t0 + F.lane]; scr[(2 * i) * 65 + F.lane] = bflo(y); scr[(2 * i + 1) * 65 + F.lane] = bfhi(y); }
        LDS_WAIT(); asm volatile("" ::: "memory");
#pragma unroll 8
        for (int tt = 0; tt < 64; ++tt) YB[(size_t)(CTXL + t0 + tt) * WMIX + c0 + F.lane] = (bf16)f2bf(scr[F.lane * 65 + tt]);
        LDS_WAIT(); asm volatile("" ::: "memory"); }
}
__device__ __forceinline__ void attn_phase(const Frame& F_, const Args& A, bool with_ctx, char* lds) {
    const Frame F = fresh(F_);
    const att::bf16* QN = WSP(att::bf16, WS_QN); const att::bf16* KN = WSP(att::bf16, WS_KN); const att::bf16* VN = WSP(att::bf16, WS_VN); bf16* YC = WSP(bf16, WS_YC);
    const int x = F.bid & 7, slot = F.bid >> 3, kvh = x >> 1, per = F.G >> 2;
    const int nunits = 3 * (with_ctx ? 33 : 32);
    for (int idx = (x & 1) * (F.G >> 3) + slot; idx < nunits; idx += per) { const int qh = kvh * 3 + idx % 3, qb = idx / 3;
        const int row0 = (qb < 32) ? CTXL + qb * 256 : 0, seq = (qb < 32) ? MROWS : CTXL;
        __syncthreads();
        att::attn_dense_body<att::bf16>(QN + (size_t)row0 * WMIX + qh * 128, KN + kvh * 128, VN + kvh * 128, YC + (size_t)row0 * WMIX + qh * 128, seq, lds, F.tid);
    }
    __syncthreads();
}
#ifndef GEMM_SP2
#define GEMM_SP2 true
#endif
#ifndef GEMM_ALIGN
#define GEMM_ALIGN true
#endif
#ifndef WIN_WGM
#define WIN_WGM 4
#endif
#ifndef KH_CTX
#define KH_CTX 1
#endif
#ifndef KH_LAST
#define KH_LAST 0
#endif
#ifndef WIN_NS
#define WIN_NS 1
#endif
#ifndef UP1_QUOTA
#define UP1_QUOTA 2
#endif
#ifndef WIN_SLABS
#define WIN_SLABS 2
#endif
#ifndef MERGE_ALIGN
#define MERGE_ALIGN GEMM_ALIGN
#endif
#ifndef RESID_ALIGN
#define RESID_ALIGN GEMM_ALIGN
#endif
#ifndef MK_PER_PHASE
#define MK_PER_PHASE 0
#endif
constexpr int PH_PER_LAYER = 15, PH_LAYER0 = 2, PH_FINAL = PH_LAYER0 + DEPTH * PH_PER_LAYER, N_PHASES = PH_FINAL + 1;

__global__ void __launch_bounds__(NWAVES * 64, 2) mk_fwd(Args A) {
    extern __shared__ __attribute__((aligned(16))) unsigned char lds[];
    Frame F;
    F.lds = (LAS unsigned char*)lds; F.ws = (unsigned char*)(GAS unsigned char*)A.ws; F.out = (float*)(GAS float*)A.out;
    F.tid = threadIdx.x; F.lane = F.tid & 63; F.wave = __builtin_amdgcn_readfirstlane((int)threadIdx.x >> 6);
    F.G = gridDim.x; F.bid = blockIdx.x; F.gw = blockIdx.x * NWAVES + F.wave; F.ngw = F.G * NWAVES;
    volatile LAS unsigned* MISC = (volatile LAS unsigned*)(F.lds + MISC_OFF);
    for (int u = F.tid; u < (LDS_BYTES - LDSCTL_OFF) / 4; u += NWAVES * 64) ((LAS unsigned*)(F.lds + LDSCTL_OFF))[u] = 0u;
    __syncthreads();
    gu32* ctl = (gu32*)(F.ws + WS_CTL);
    XcdBarrier bar = xcd_barrier_post((unsigned*)(ctl + CW_BAR), MISC + 8);
    const int lo = A.ph_lo, hi = A.ph_hi;
#define IN(k) (lo <= (k) && (k) < hi)
#ifndef EN_MASK
#define EN_MASK 0xffffffffu
#endif
#define EN(b) ((EN_MASK >> (b)) & 1u)
#ifndef REP_MASK
#define REP_MASK 0u
#endif
#define REPS(b) (((REP_MASK >> (b)) & 1u) ? 2 : 1)
#ifdef PROBE_BAR
#define SEAM(k) do { if (IN(k) && IN((k) + 1)) { xcd_barrier(bar); xcd_barrier(bar); } } while (0)
#else
#define SEAM(k) do { if (IN(k) && IN((k) + 1)) xcd_barrier(bar); } while (0)
#endif
    LAS unsigned char* ring = F.lds + RING_OFF;

    if (EN(0) && IN(0)) { for (int rep_ = 0; rep_ < REPS(0); ++rep_) prologue_a(F, A); filt_mlp(F, A, 0, true); }
    SEAM(0);
    if (EN(1) && IN(1)) { prologue_b(F, A); { const Frame L = fresh(F); for (int u = L.bid; u < 1024; u += L.G) filt_taps_unit(F, A, 0, u); } filt_taps_ctx(F, A, 0); }
    SEAM(1);

    for (int layer = 0; layer < DEPTH; ++layer) {
        const int pb = PH_LAYER0 + layer * PH_PER_LAYER;
        if (!(lo < pb + PH_PER_LAYER && pb < hi)) continue;
        const bool ctx_out = layer < DEPTH - 1;
        const int roff = ctx_out ? 0 : CTXL;
        unsigned char* wb = F.ws + WS_W + (size_t)layer * W_LAYER;
        const float* modL = WSP(float, WS_MOD) + (size_t)(layer * 2 + 0) * NMOD * DM; const float* modC = modL + (size_t)NMOD * DM;
        bf16* U = WSP(bf16, WS_U); bf16* H = WSP(bf16, WS_H); float* X = WSP(float, WS_X); bf16* P = WSP(bf16, WS_P);
        for (int half = 0; half < 2; ++half) {
            const int p0 = pb + (half ? 12 : 0), im = half ? 6 : 0;
            if (EN(2) && IN(p0)) { for (int rep_ = 0; rep_ < REPS(2); ++rep_) { __syncthreads(); norm_phase(F, A, inp(A, half ? I_NF2 : I_NF1) + (size_t)layer * DM, modL, modC, im + 0, im + 1, half ? roff : (layer == 0 ? MROWS : 0));
                if (!half && layer == 0) { const Frame L = fresh(F); for (int u = L.bid; u < 480; u += L.G) filt_spectra_unit(F, A, u); }
                if (half && layer + 1 < DEPTH - 1) filt_taps_ctx(F, A, layer + 1); } }
            SEAM(p0);
            const int hro = half ? roff : 0; const size_t hoff = (size_t)hro * DM;
            if (EN(3) && IN(p0 + 1)) { for (int rep_ = 0; rep_ < REPS(3); ++rep_) { __syncthreads(); pg8::Gemm g{U + hoff, (const bf16*)(wb + (half ? WO_GU2 : WO_GU1)), MROWS - hro, 2 * DFF, DM}; pg8::StaticOrder S; S.init(MROWS - hro, 2 * DFF, F.G, fresh(F).bid);
                pg8::EpiSwiglu E{H + hoff, DFF}; pg8::gemm_phase<pg8::EpiSwiglu, pg8::StaticOrder, GEMM_ALIGN, GEMM_SP2>(ring, g, S, E, fresh(F).tid);
                if (!half) filler(F, A, 2, layer, 480, fresh(F).bid - 32, 224, UP1_QUOTA); else if (layer + 1 < DEPTH) filler(F, A, 1, layer + 1, 960, fresh(F).bid - 32, 224, 1); } }
            SEAM(p0 + 1);
            if (EN(4) && IN(p0 + 2)) { pg8::Gemm g{H + hoff, (const bf16*)(wb + (half ? WO_D2 : WO_D1)), MROWS - hro, DM, DFF}; pg8::StaticOrder S; S.init(MROWS - hro, DM, F.G, fresh(F).bid);
                pg8::EpiResid E{WSP(bf16, WS_M32) + hoff, DM, modL + (im + 2) * DM, (hro ? modL : modC) + (im + 2) * DM, 0.5f}; pg8::gemm_phase<pg8::EpiResid, pg8::StaticOrder, RESID_ALIGN, GEMM_SP2>(ring, g, S, E, fresh(F).tid);
                if (!half) filler(F, A, 2, layer, 928, fresh(F).bid - 16, 240, 2); else if (layer + 1 < DEPTH) filler(F, A, 2, layer + 1, 0, fresh(F).bid - 16, 240, 2); }
            if (half) { SEAM(p0 + 2); continue; }
            SEAM(p0 + 2);
            if (EN(5) && IN(pb + 3)) { for (int rep_ = 0; rep_ < REPS(5); ++rep_) { __syncthreads(); norm_phase(F, A, inp(A, I_NMIX) + (size_t)layer * DM, modL, modC, 3, 4, 0); } }
            SEAM(pb + 3);
            if (EN(6) && IN(pb + 4)) { for (int rep_ = 0; rep_ < REPS(6); ++rep_) { __syncthreads();
                constexpr int NSL = WIN_SLABS, NT_SL = (NIN / 256) / NSL, R_SL = (33 * NT_SL) % 256;
#pragma unroll 1
                for (int sl = 0; sl < NSL; ++sl) { pg8::Gemm g{U, (const bf16*)(wb + WO_IN) + (size_t)sl * (NT_SL * 256) * DM, MROWS, NT_SL * 256, DM}; pg8::StaticOrder S; S.init(MROWS, NT_SL * 256, F.G, fresh(F).bid); S.wgm = WIN_WGM;
                    pg8::EpiWin E{P, NIN, sl * NT_SL}; pg8::gemm_phase<pg8::EpiWin, pg8::StaticOrder, GEMM_ALIGN, GEMM_SP2>(ring, g, S, E, fresh(F).tid); }
                filler(F, A, 2, layer, 1408, fresh(F).bid - R_SL, 256 - R_SL, (168 + 255 - R_SL) / (256 - R_SL)); } }
            SEAM(pb + 4);
            if (EN(7) && IN(pb + 5)) { for (int rep_ = 0; rep_ < REPS(7); ++rep_) { __syncthreads(); prep_lru_conv(F, A, layer); prep_qkv(F, A, layer); prep_hyena_t(F, A, layer); if (ctx_out) { prep_hyena_ctx(F, A, layer); filt_norm_ctx(F, A); } } }
            SEAM(pb + 5);
            if (EN(8) && IN(pb + 6)) { for (int rep_ = 0; rep_ < REPS(8); ++rep_) { __syncthreads(); int klru = 256; asm volatile("" : "+s"(klru));
                pg8::Gemm g{WSP(bf16, WS_XA), (const bf16*)(wb + WO_LRU), 6 * MROWS, 6 * 1024, klru}; pg8::LruOrder S; S.init(F.G, fresh(F).bid);
                pg8::EpiLru E{WSP(float, WS_LA), WSP(float, WS_LB), WSP(bf16, WS_XA), inp(A, I_LBA) + (size_t)layer * 2 * WMIX, inp(A, I_LBX) + (size_t)layer * 2 * WMIX, WSP(float, WS_MOD + 1536 * 1024) + (size_t)layer * 2 * WMIX, MROWS, WSP(float, WS_CA), WSP(float, WS_CB)};
                pg8::gemm_phase<pg8::EpiLru, pg8::LruOrder, GEMM_ALIGN, GEMM_SP2>(ring, g, S, E, fresh(F).tid); } }
            SEAM(pb + 6);
            if (EN(9) && IN(pb + 7)) {   }
            if (EN(10) && IN(pb + 8)) { for (int rep_ = 0; rep_ < REPS(10); ++rep_) { __syncthreads();
                lru_carries(F, A);
                if (EN(17)) for (int r2_ = 0; r2_ < REPS(17); ++r2_) attn_phase(F, A, ctx_out, (char*)lds);
                { const Frame L = fresh(F); const int x = L.bid & 7, slot = L.bid >> 3, nunits = 3 * (ctx_out ? 33 : 32), thr = nunits - 96, KH = ctx_out ? KH_CTX : KH_LAST;
                  const bool light = (x & 1) && slot >= thr; const int nh = 128 + 4 * thr, nl = 4 * (32 - thr), total = 768 + (ctx_out ? 48 : 0);
                  const int hi_ = (x & 1) ? 128 + (x >> 1) * thr + slot : (x >> 1) * 32 + slot, li = (x >> 1) * (32 - thr) + (slot - thr);
                  for (int r2_ = 0; r2_ < REPS(18); ++r2_)
                  for (int m = 0; ; ++m) { int u; if (light) { u = KH * nh + li + nl * m; if (u >= total) break; } else { if (m >= KH) break; u = hi_ + nh * m; if (u >= total) break; }
                      if (u < 768) { if (EN(18)) hyena_conv_unit(F, A, layer, u);
#ifdef PROBE_FFT
                          hyena_fft_dummy(F);
#endif
                      } else { if (EN(19)) hyena_ctx_unit(F, A, layer, u - 768); } } }
            } }
            SEAM(pb + 8);
            if (EN(11) && IN(pb + 9)) { for (int rep_ = 0; rep_ < REPS(11); ++rep_) { __syncthreads(); lru_out(F, A); yb_transpose(F, A); if (layer + 1 < DEPTH) filt_mlp(F, A, layer + 1, layer + 1 < DEPTH - 1); } }
            SEAM(pb + 9);
            if (EN(12) && IN(pb + 10)) { for (int rep_ = 0; rep_ < REPS(12); ++rep_) { __syncthreads(); const bf16* WB = (const bf16*)(wb + WO_BR); float* M32 = WSP(float, WS_M32) + (size_t)roff * DM; pg8::StaticOrder S; S.init(MROWS - roff, DM, F.G, fresh(F).bid);
                const size_t yo = (size_t)roff * WMIX; bf16* Hm = H + (size_t)roff * DM; const bf16* Pg = P + (size_t)roff * NIN + COL_G; const int Mm = MROWS - roff;
                { pg8::Gemm g{WSP(bf16, WS_YA) + yo, WB, Mm, DM, WMIX}; pg8::EpiMerge<0> E{M32, Hm, Pg, NIN}; pg8::gemm_phase<pg8::EpiMerge<0>, pg8::StaticOrder, MERGE_ALIGN, GEMM_SP2>(ring, g, S, E, fresh(F).tid); }
                { pg8::Gemm g{WSP(bf16, WS_YB) + yo, WB + (size_t)DM * WMIX, Mm, DM, WMIX}; pg8::EpiMerge<1> E{M32, Hm, Pg + DM, NIN}; pg8::gemm_phase<pg8::EpiMerge<1>, pg8::StaticOrder, MERGE_ALIGN, GEMM_SP2>(ring, g, S, E, fresh(F).tid); }
                { pg8::Gemm g{WSP(bf16, WS_YC) + yo, WB + (size_t)2 * DM * WMIX, Mm, DM, WMIX}; pg8::EpiMerge<2> E{M32, Hm, Pg + 2 * DM, NIN}; pg8::gemm_phase<pg8::EpiMerge<2>, pg8::StaticOrder, MERGE_ALIGN, GEMM_SP2>(ring, g, S, E, fresh(F).tid); }
                if (layer + 1 < DEPTH) filler(F, A, 1, layer + 1, 0, fresh(F).bid - 16, 240, 2); } }
            SEAM(pb + 10);
            if (EN(13) && IN(pb + 11)) { pg8::Gemm g{H + (size_t)roff * DM, (const bf16*)(wb + WO_OUT), MROWS - roff, DM, DM}; pg8::StaticOrder S; S.init(MROWS - roff, DM, F.G, fresh(F).bid);
                pg8::EpiResid E{WSP(bf16, WS_M32) + (size_t)roff * DM, DM, modL + 5 * DM, (roff ? modL : modC) + 5 * DM, 1.0f}; pg8::gemm_phase<pg8::EpiResid, pg8::StaticOrder, RESID_ALIGN, GEMM_SP2>(ring, g, S, E, fresh(F).tid);
                if (layer + 1 < DEPTH) filler(F, A, 1, layer + 1, 480, fresh(F).bid - 16, 240, 2); }
            SEAM(pb + 11);
        }
    }
#ifdef DUMP
    if (IN(PH_FINAL)) dump_phase(F, A);
#else
    if (EN(14) && IN(PH_FINAL)) final_norm_phase(F, A);
#endif
#undef IN
#undef SEAM
}

extern "C" void kernel_launch(void* const* d_in, const int* in_sizes, int n_in, void* d_out, int out_size, void* d_ws, size_t ws_size, hipStream_t stream) {
    static int grid = 0;
    if (grid == 0) {
        if (n_in != N_IN_TENSORS || in_sizes[0] != SEQ * DM || out_size != SEQ * DM || ws_size < WS_END) {
            fprintf(stderr, "kernel_launch: shape mismatch: n_in %d in0 %d out %d ws %zu (need %zu)\n", n_in, n_in > 0 ? in_sizes[0] : -1, out_size, ws_size, (size_t)WS_END); grid = -1; return; }
        int dev = 0, cus = 0, per_cu = 0;
        if (hipGetDevice(&dev) != hipSuccess || hipDeviceGetAttribute(&cus, hipDeviceAttributeMultiprocessorCount, dev) != hipSuccess) { fprintf(stderr, "kernel_launch: device query failed\n"); grid = -1; return; }
        if (hipFuncSetAttribute((const void*)mk_fwd, hipFuncAttributeMaxDynamicSharedMemorySize, LDS_BYTES) != hipSuccess) { fprintf(stderr, "kernel_launch: hipFuncSetAttribute failed\n"); grid = -1; return; }
        if (hipOccupancyMaxActiveBlocksPerMultiprocessor(&per_cu, (const void*)mk_fwd, NWAVES * 64, LDS_BYTES) != hipSuccess || per_cu < 1)
            fprintf(stderr, "kernel_launch: note: occupancy query reports %d workgroups per CU\n", per_cu);
        (void)hipGetLastError();
        grid = cus;
        if (grid != 256) { fprintf(stderr, "kernel_launch: built for 256 CUs, found %d\n", cus); grid = -1; return; }
    }
    if (grid < 0) return;
    if (hipMemsetAsync((char*)d_ws + WS_CTL, 0, CTL_ZERO_BYTES, stream) != hipSuccess) { fprintf(stderr, "kernel_launch: memset failed\n"); return; }
    Args a{};
    for (int i = 0; i < N_IN_TENSORS; ++i) a.in[i] = (const float*)d_in[i];
    a.out = (float*)d_out; a.ws = (unsigned char*)d_ws;
#if MK_PER_PHASE
#ifndef STOP_PHASE
#define STOP_PHASE PH_FINAL
#endif
    for (int ph = 0; ph < N_PHASES; ++ph) { if (ph >= STOP_PHASE && ph != PH_FINAL) continue; a.ph_lo = ph; a.ph_hi = ph + 1; hipLaunchKernelGGL(mk_fwd, dim3(grid), dim3(NWAVES * 64), LDS_BYTES, stream, a); }
#else
    a.ph_lo = 0; a.ph_hi = N_PHASES; hipLaunchKernelGGL(mk_fwd, dim3(grid), dim3(NWAVES * 64), LDS_BYTES, stream, a);
#endif
    const hipError_t le = hipPeekAtLastError();
    if (le != hipSuccess) fprintf(stderr, "kernel_launch: launch failed: %s\n", hipGetErrorName(le));
}
```

```cpp
#include <hip/hip_runtime.h>
#include <hip/hip_bf16.h>
#include <cstdio>
#include <cstdint>
namespace pg8 {
#define PG8_LAS __attribute__((address_space(3)))
typedef unsigned short bf16_t;
typedef short bf16x8 __attribute__((ext_vector_type(8)));
typedef float f32x4 __attribute__((ext_vector_type(4)));
typedef unsigned u32x4 __attribute__((ext_vector_type(4)));
constexpr int BM = 256, BK = 64, HALF = 128, HTB = HALF * BK * 2  , STAGE_BYTES = 8 * HTB, NXCD = 8, WGM = 8;

__host__ __device__ __forceinline__ int lds_byte(int r, int c) { const int st = (r >> 4) * 2 + (c >> 5), rr = r & 15, cc = c & 31, ob = rr * 64 + cc * 2; return st * 1024 + (ob ^ (((ob >> 9) & 1) << 5)); }
__host__ __device__ __forceinline__ void stage_rc(int b, int& R, int& C) { const int st = b / 1024, sb = b % 1024, swz = sb ^ (((sb >> 9) & 1) << 5); R = (st >> 1) * 16 + swz / 64; C = (st & 1) * 32 + (swz % 64) / 2; }
__host__ __device__ __forceinline__ int perm32(int rho) { const int n = rho >> 4, i = rho & 15; return 8 * (i >> 2) + 4 * n + (i & 3); }

struct Unit { int pm, pn; };
struct Gemm { const bf16_t* A; const bf16_t* Bt; int M, N, K; };

struct StaticOrder {
    int nM, nN, nwg, G, c, wgm = WGM;
    __host__ __device__ void init(int M, int N, int G_, int c_) { nM = M / BM; nN = N / BM; nwg = nM * nN; G = G_; c = c_; }
    __host__ __device__ bool next(int i, Unit& u) const {
        const long L = (long)i * G + c; if (L >= nwg) return false;
        int wgid = (int)L; { const int q = nwg / NXCD, r = nwg % NXCD, xcd = wgid % NXCD, off = wgid / NXCD; wgid = (xcd < r ? xcd * (q + 1) : r * (q + 1) + (xcd - r) * q) + off; }
        const int nig = wgm * nN, gid = wgid / nig, fm = gid * wgm, gsz = (nM - fm) < wgm ? (nM - fm) : wgm;
        u.pm = fm + ((wgid % nig) % gsz); u.pn = (wgid % nig) / gsz; return true;
    }
    __device__ __forceinline__ void a_ready(const Unit&) const {}
    __device__ __forceinline__ void done(const Unit&) const {}
};
struct SplitNOrder {
    int nM, nNs, ns, nwg, G, c, wgm;
    __host__ __device__ void init(int M, int N, int NS, int G_, int c_, int wgm_) { nM = M / BM; ns = NS; nNs = (N / BM) / NS; nwg = nM * nNs * NS; G = G_; c = c_; wgm = wgm_; }
    __host__ __device__ bool next(int i, Unit& u) const {
        const long L = (long)i * G + c; if (L >= nwg) return false;
        int wgid = (int)L; { const int q = nwg / NXCD, r = nwg % NXCD, xcd = wgid % NXCD, off = wgid / NXCD; wgid = (xcd < r ? xcd * (q + 1) : r * (q + 1) + (xcd - r) * q) + off; }
        const int nMv = nM * ns, nig = wgm * nNs, gid = wgid / nig, fm = gid * wgm, gsz = (nMv - fm) < wgm ? (nMv - fm) : wgm;
        const int pv = fm + ((wgid % nig) % gsz), pnl = (wgid % nig) / gsz, slab = pv / nM;
        u.pm = pv - slab * nM; u.pn = slab * nNs + pnl; return true;
    }
    __device__ __forceinline__ void a_ready(const Unit&) const {}
    __device__ __forceinline__ void done(const Unit&) const {}
};
__device__ __forceinline__ unsigned cvt_pk_bf16(float lo, float hi) { unsigned r; asm volatile("v_cvt_pk_bf16_f32 %0, %1, %2" : "=v"(r) : "v"(lo), "v"(hi)); return r; }
typedef float f32x2 __attribute__((ext_vector_type(2)));
template <int MASK> __device__ __forceinline__ float swz_xor(float v) { return __int_as_float(__builtin_amdgcn_ds_swizzle(__float_as_int(v), (MASK << 10) | 0x1f)); }
__device__ __forceinline__ float fast_sigmoid(float x) { return __builtin_amdgcn_rcpf(1.0f + __expf(-x)); }
__device__ __forceinline__ float gelu_tanh(float x) { const float u = 0.7978845608028654f * (x + 0.044715f * x * x * x); return x * fast_sigmoid(2.0f * u); }
__device__ __forceinline__ float bf_lo(unsigned w) { return __uint_as_float(w << 16); }
__device__ __forceinline__ float bf_hi(unsigned w) { return __uint_as_float(w & 0xffff0000u); }

struct EpiSwiglu {
    static constexpr bool PERM = true, AFTER_DRAIN = false;
    bf16_t* O; int ldo;
    __device__ __forceinline__ void operator()(const f32x4 (&acc)[2][2][4][2], const Unit& u, int wr, int wc, int fr, int fq) const {
        const int row0 = u.pm * BM + wr * 64 + fr, col0 = u.pn * HALF + wc * 32 + 8 * fq;
#pragma unroll
        for (int ai = 0; ai < 2; ++ai)
#pragma unroll
            for (int m = 0; m < 4; ++m) { bf16_t* rowp = O + (size_t)(row0 + ai * HALF + m * 16) * ldo + col0;
                float v[8];
#pragma unroll
                for (int n = 0; n < 2; ++n)
#pragma unroll
                    for (int j = 0; j < 4; ++j) { const float a = acc[ai][0][m][n][j], b = acc[ai][1][m][n][j]; v[n * 4 + j] = a * fast_sigmoid(a) * b; }
                u32x4 w; w.x = cvt_pk_bf16(v[0], v[1]); w.y = cvt_pk_bf16(v[2], v[3]); w.z = cvt_pk_bf16(v[4], v[5]); w.w = cvt_pk_bf16(v[6], v[7]);
                *(u32x4*)rowp = w; }
    }
};
struct EpiResid {
    static constexpr bool PERM = true, AFTER_DRAIN = false;
    bf16_t* Dd; int ldd; const float* gate_lat; const float* gate_ctx; float coef;
    __device__ __forceinline__ void operator()(const f32x4 (&acc)[2][2][4][2], const Unit& u, int wr, int wc, int fr, int fq) const {
        const int row0 = u.pm * BM + wr * 64 + fr, col0 = u.pn * BM + wc * 32 + 8 * fq;
        const float* gate = (u.pm == 0) ? gate_ctx : gate_lat;
        f32x4 gv[2][2];
#pragma unroll
        for (int bj = 0; bj < 2; ++bj)
#pragma unroll
            for (int n = 0; n < 2; ++n) gv[bj][n] = *(const f32x4*)(gate + col0 + bj * HALF + 4 * n) * coef;
#pragma unroll
        for (int ai = 0; ai < 2; ++ai)
#pragma unroll
            for (int m = 0; m < 4; ++m) { bf16_t* rowp = Dd + (size_t)(row0 + ai * HALF + m * 16) * ldd + col0;
#pragma unroll
                for (int bj = 0; bj < 2; ++bj) { const f32x4 v0 = gv[bj][0] * acc[ai][bj][m][0], v1 = gv[bj][1] * acc[ai][bj][m][1];
                    u32x4 w; w.x = cvt_pk_bf16(v0[0], v0[1]); w.y = cvt_pk_bf16(v0[2], v0[3]); w.z = cvt_pk_bf16(v1[0], v1[1]); w.w = cvt_pk_bf16(v1[2], v1[3]);
                    *(u32x4*)(rowp + bj * HALF) = w; } }
    }
};
struct EpiWin {
    static constexpr bool PERM = true, AFTER_DRAIN = false;
    bf16_t* O; int ldo; int pn0;
    __device__ __forceinline__ void operator()(const f32x4 (&acc)[2][2][4][2], const Unit& u, int wr, int wc, int fr, int fq) const {
        const int pn = u.pn + pn0, row0 = u.pm * BM + wr * 64 + fr, col0 = pn * BM + wc * 32 + 8 * fq;
        const bool sig = pn >= 40, gel = (pn >= 10 && pn < 16);
        const float kx = sig ? 1.0f : (gel ? 2.0f * 0.7978845608028654f : 0.0f), k3 = gel ? 2.0f * 0.7978845608028654f * 0.044715f : 0.0f, k0 = (sig || gel) ? 0.0f : 80.0f;
#pragma unroll
        for (int ai = 0; ai < 2; ++ai)
#pragma unroll
            for (int m = 0; m < 4; ++m) { bf16_t* rowp = O + (size_t)(row0 + ai * HALF + m * 16) * ldo + col0;
#pragma unroll
                for (int bj = 0; bj < 2; ++bj) { float v[8];
#pragma unroll
                    for (int n = 0; n < 2; ++n)
#pragma unroll
                        for (int j = 0; j < 4; ++j) { const float x = acc[ai][bj][m][n][j]; const float t = k0 + x * (kx + k3 * x * x);
                            const float r = __builtin_amdgcn_rcpf(1.0f + __expf(-t)); v[n * 4 + j] = sig ? r : x * r; }
                    u32x4 w; w.x = cvt_pk_bf16(v[0], v[1]); w.y = cvt_pk_bf16(v[2], v[3]); w.z = cvt_pk_bf16(v[4], v[5]); w.w = cvt_pk_bf16(v[6], v[7]);
                    *(u32x4*)(rowp + bj * HALF) = w; } }
    }
};
struct LruOrder {
    int G, c;
    __host__ __device__ void init(int G_, int c_) { G = G_; c = c_; }
    __host__ __device__ bool next(int i, Unit& u) const { const int L = i * G + c; if (L >= 6 * 33 * 4) return false; const int pmv = L >> 2; u.pm = pmv; u.pn = (pmv / 33) * 4 + (L & 3); return true; }
    __device__ __forceinline__ void a_ready(const Unit&) const {}
    __device__ __forceinline__ void done(const Unit&) const {}
};
struct EpiLru {
    static constexpr bool PERM = true, AFTER_DRAIN = false;
    float* LA; float* LB; const bf16_t* XA; const float* b_a; const float* b_x; const float* lam;
    int M; float* CA; float* CB;
    __device__ __forceinline__ void operator()(const f32x4 (&acc)[2][2][4][2], const Unit& u, int wr, int wc, int fr, int fq) const {
        const int jb = u.pm / 33, pmr = u.pm - jb * 33, pnn = u.pn & 3, d = pnn >> 1, blk = 2 * jb + (pnn & 1);
        const int row0 = pmr * BM + wr * 64 + fr, c0 = blk * HALF + wc * 32 + 8 * fq;
        const float* pba = b_a + d * 1536 + c0; const float* pbx = b_x + d * 1536 + c0; const float* psp = lam + d * 1536 + c0;
#pragma unroll
        for (int ai = 0; ai < 2; ++ai) { float RA[8], RB[8];
#pragma unroll
            for (int m = 0; m < 4; ++m) { const size_t row = (size_t)(row0 + ai * HALF + m * 16);
                const bf16_t* xp = XA + ((size_t)jb * M + row) * 256 + (c0 - 256 * jb);
                unsigned* pab = (unsigned*)LA + ((((size_t)d * (M >> 6) + (row >> 6)) * 6 + (c0 >> 8)) * 64 + (row & 63)) * 256 + (c0 & 255);
#pragma unroll
                for (int n = 0; n < 2; ++n) { const f32x4 ba = *(const f32x4*)(pba + 4 * n), bx = *(const f32x4*)(pbx + 4 * n), sp = *(const f32x4*)(psp + 4 * n);
                    const unsigned long long xw = *(const unsigned long long*)(xp + 4 * n); const unsigned x01 = (unsigned)xw, x23 = (unsigned)(xw >> 32);
                    const float xa[4] = {bf_lo(x01), bf_hi(x01), bf_lo(x23), bf_hi(x23)};
                    u32x4 ab;
#pragma unroll
                    for (int j = 0; j < 4; ++j) {
                        const float r = fast_sigmoid(acc[ai][0][m][n][j] + ba[j]), ig = fast_sigmoid(acc[ai][1][m][n][j] + bx[j]);
                        const float la = -sp[j] * r, x2 = 2.0f * la;
                        const float em = (x2 > -0.5f) ? -x2 * (1.0f + x2 * (0.5f + x2 * (0.16666667f + x2 * (0.041666668f + x2 * (0.0083333338f + x2 * 0.0013888889f))))) : 1.0f - __expf(x2);
                        ab[j] = cvt_pk_bf16(la, sqrtf(fmaxf(em, 0.0f)) * (ig * xa[j])); }
                    *(u32x4*)(pab + 4 * n) = ab;
#pragma unroll
                    for (int j = 0; j < 4; ++j) { float a = __expf(bf_lo(ab[j])), b = bf_hi(ab[j]);
#define LRU_STEP(S_) { const float pa = swz_xor<S_>(a), pb = swz_xor<S_>(b); const bool mine_first = (((fr & S_) == 0) != (d == 1)); b = mine_first ? (pa * b + pb) : (a * pb + b); a = a * pa; }
                        LRU_STEP(1) LRU_STEP(2) LRU_STEP(4) LRU_STEP(8)
#undef LRU_STEP
                        const int e = n * 4 + j;
                        if (m == 0) { RA[e] = a; RB[e] = b; } else { const float f0 = a * RB[e] + b, f1 = RA[e] * b + RB[e]; RB[e] = (d == 0) ? f0 : f1; RA[e] = RA[e] * a; } }
                    asm volatile("" ::: "memory"); }
                asm volatile("" ::: "memory"); }
            { const size_t ci = ((size_t)d * (M >> 6) + ((row0 + ai * HALF) >> 6)) * 1536 + c0;
                *(f32x4*)(CA + ci) = (f32x4){RA[0], RA[1], RA[2], RA[3]}; *(f32x4*)(CA + ci + 4) = (f32x4){RA[4], RA[5], RA[6], RA[7]};
                *(f32x4*)(CB + ci) = (f32x4){RB[0], RB[1], RB[2], RB[3]}; *(f32x4*)(CB + ci + 4) = (f32x4){RB[4], RB[5], RB[6], RB[7]}; } }
    }
};
template <int STEP> struct EpiMerge {
    static constexpr bool PERM = true, AFTER_DRAIN = false;
    float* M32; bf16_t* Mb; const bf16_t* G; int ldg;
    __device__ __forceinline__ void operator()(const f32x4 (&acc)[2][2][4][2], const Unit& u, int wr, int wc, int fr, int fq) const {
        const int row0 = u.pm * BM + wr * 64 + fr, col0 = u.pn * BM + wc * 32 + 8 * fq;
#pragma unroll
        for (int ai = 0; ai < 2; ++ai)
#pragma unroll
            for (int m = 0; m < 4; ++m) { const size_t row = (size_t)(row0 + ai * HALF + m * 16);
#pragma unroll
                for (int bj = 0; bj < 2; ++bj) { const int col = col0 + bj * HALF;
                    const u32x4 gw = *(const u32x4*)(G + row * ldg + col);
                    const float g[8] = {bf_lo(gw.x), bf_hi(gw.x), bf_lo(gw.y), bf_hi(gw.y), bf_lo(gw.z), bf_hi(gw.z), bf_lo(gw.w), bf_hi(gw.w)};
                    float v[8];
#pragma unroll
                    for (int n = 0; n < 2; ++n)
#pragma unroll
                        for (int j = 0; j < 4; ++j) v[n * 4 + j] = g[n * 4 + j] * acc[ai][bj][m][n][j];
                    bf16_t* mp = Mb + row * 4096 + col;
                    if (STEP >= 1) { const u32x4 o = *(const u32x4*)mp;
                        v[0] += bf_lo(o.x); v[1] += bf_hi(o.x); v[2] += bf_lo(o.y); v[3] += bf_hi(o.y); v[4] += bf_lo(o.z); v[5] += bf_hi(o.z); v[6] += bf_lo(o.w); v[7] += bf_hi(o.w); }
                    u32x4 w; w.x = cvt_pk_bf16(v[0], v[1]); w.y = cvt_pk_bf16(v[2], v[3]); w.z = cvt_pk_bf16(v[4], v[5]); w.w = cvt_pk_bf16(v[6], v[7]);
                    *(u32x4*)mp = w;
                    asm volatile("" ::: "memory"); } }
    }
};
template <class Epi, class Sched, bool ALIGN_EPI = false, bool SP2 = false>
__device__ __forceinline__ void gemm_phase(PG8_LAS unsigned char* lds, const Gemm g, const Sched& S, const Epi& E, int tid_in) {
    int tid_ = tid_in; asm volatile("" : "+v"(tid_));
    const int tid = tid_, wid = __builtin_amdgcn_readfirstlane(tid >> 6), lane = tid & 63, wr = wid >> 2, wc = wid & 3, fr = lane & 15, fq = lane >> 4;
    const int K = g.K, nt = K / BK;
    unsigned voffA[2], voffB[2];
#pragma unroll
    for (int i = 0; i < 2; ++i) { int R, C; stage_rc(tid * 16 + i * 8192, R, C); const int Rb = Epi::PERM ? ((R & ~31) + perm32(R & 31)) : R;
        voffA[i] = (unsigned)(R * K + C) * 2u; voffB[i] = (unsigned)(Rb * K + C) * 2u; }
    const size_t kstep = (size_t)(BK * 2);
    const size_t hstep = (size_t)HALF * K * 2;
    const size_t tstep = 2 * hstep;
    const unsigned ldsw = (unsigned)wid * 1024u;
    const int aoff = lds_byte(wr * 64 + fr, fq * 8), boff = lds_byte(wc * 32 + fr, fq * 8);
#define PG8_SA(b, h) (((b) * 2 + (h)) * HTB)
#define PG8_SB(b, h) ((4 + (b) * 2 + (h)) * HTB)
#define PG8_STAGE(bufoff, gbase, voff) do { _Pragma("unroll") for (int _i = 0; _i < 2; ++_i) \
        __builtin_amdgcn_global_load_lds((const unsigned*)((const char*)(gbase) + (voff)[_i]), (PG8_LAS unsigned*)(lds + (bufoff) + ldsw + _i * 8192), 16, 0, 0); } while (0)
#define PG8_LDA(dst, b, h) do { _Pragma("unroll") for (int m = 0; m < 4; ++m) _Pragma("unroll") for (int k = 0; k < 2; ++k) dst[m][k] = *(const PG8_LAS bf16x8*)(lds + PG8_SA(b, h) + aoff + m * 2048 + k * 1024); } while (0)
#define PG8_LDB(dst, b, h) do { _Pragma("unroll") for (int n = 0; n < 2; ++n) _Pragma("unroll") for (int k = 0; k < 2; ++k) dst[n][k] = *(const PG8_LAS bf16x8*)(lds + PG8_SB(b, h) + boff + n * 2048 + k * 1024); } while (0)
#define PG8_MMA(ai, bj, At, Bt) do { __builtin_amdgcn_s_setprio(1); _Pragma("unroll") for (int m = 0; m < 4; ++m) _Pragma("unroll") for (int n = 0; n < 2; ++n) _Pragma("unroll") for (int k = 0; k < 2; ++k) \
        acc[ai][bj][m][n] = __builtin_amdgcn_mfma_f32_16x16x32_bf16(Bt[n][k], At[m][k], acc[ai][bj][m][n], 0, 0, 0); __builtin_amdgcn_s_setprio(0); } while (0)
#define PG8_WAIT_V(n) asm volatile("s_waitcnt vmcnt(" #n ")" ::: "memory")
#define PG8_WAIT_L(n) asm volatile("s_waitcnt lgkmcnt(" #n ")" ::: "memory")
#define PG8_BAR __builtin_amdgcn_s_barrier()
#define PG8_SCHED __builtin_amdgcn_sched_barrier(0)
    Unit cur, nxt; int ui = 0;
    if (!S.next(0, cur)) return;
    f32x4 acc[2][2][4][2];
#pragma unroll
    for (int a = 0; a < 2; ++a)
#pragma unroll
        for (int b = 0; b < 2; ++b)
#pragma unroll
            for (int m = 0; m < 4; ++m)
#pragma unroll
                for (int n = 0; n < 2; ++n) acc[a][b][m][n] = (f32x4){0.f, 0.f, 0.f, 0.f};
    bf16x8 At[4][2], B0[2][2], B1[2][2];
    const char* cA = (const char*)g.A + (size_t)cur.pm * tstep; const char* cB = (const char*)g.Bt + (size_t)cur.pn * tstep;
    S.a_ready(cur);
    if constexpr (SP2) {
        PG8_STAGE(PG8_SB(0, 0), cB, voffB); PG8_STAGE(PG8_SB(0, 1), cB + hstep, voffB); PG8_STAGE(PG8_SA(0, 0), cA, voffA); PG8_STAGE(PG8_SA(0, 1), cA + hstep, voffA);
        if (wr == 1) PG8_BAR;
        PG8_WAIT_V(2); PG8_BAR;
        PG8_STAGE(PG8_SB(1, 0), cB + kstep, voffB); PG8_STAGE(PG8_SA(1, 0), cA + kstep, voffA); PG8_STAGE(PG8_SB(1, 1), cB + hstep + kstep, voffB);
        PG8_WAIT_V(6); PG8_BAR;
    } else {
        PG8_STAGE(PG8_SB(0, 0), cB, voffB); PG8_STAGE(PG8_SA(0, 0), cA, voffA); PG8_STAGE(PG8_SB(0, 1), cB + hstep, voffB); PG8_STAGE(PG8_SA(0, 1), cA + hstep, voffA);
        if (wr == 1) PG8_BAR;
        PG8_WAIT_V(4); PG8_BAR;
        PG8_STAGE(PG8_SB(1, 0), cB + kstep, voffB); PG8_STAGE(PG8_SA(1, 0), cA + kstep, voffA); PG8_STAGE(PG8_SB(1, 1), cB + hstep + kstep, voffB);
        PG8_WAIT_V(6); PG8_BAR;
    }
    for (;;) {
        const bool has_next = S.next(ui + 1, nxt);
        const char* nA = has_next ? (const char*)g.A + (size_t)nxt.pm * tstep : cA; const char* nB = has_next ? (const char*)g.Bt + (size_t)nxt.pn * tstep : cB;
        for (int t = 0; t < nt; t += 2) {
            const bool last = (t == nt - 2);
            const char* a1 = cA + (size_t)(t + 1) * kstep;
            const char* a2 = last ? nA : cA + (size_t)(t + 2) * kstep; const char* b2 = last ? nB : cB + (size_t)(t + 2) * kstep;
            const char* a3 = a2 + kstep; const char* b3 = b2 + kstep;
            if (last && has_next) S.a_ready(nxt);
            if constexpr (SP2) {
            PG8_LDB(B0, 0, 0); PG8_LDB(B1, 0, 1); PG8_SCHED; PG8_LDA(At, 0, 0); PG8_STAGE(PG8_SA(1, 1), a1 + hstep, voffA);
            PG8_WAIT_V(8); PG8_WAIT_L(0); PG8_BAR; PG8_MMA(0, 0, At, B0); PG8_MMA(0, 1, At, B1); PG8_BAR; PG8_SCHED;
            PG8_LDA(At, 0, 1); PG8_STAGE(PG8_SB(0, 0), b2, voffB); PG8_STAGE(PG8_SB(0, 1), b2 + hstep, voffB); PG8_STAGE(PG8_SA(0, 0), a2, voffA);
            PG8_WAIT_V(8); PG8_WAIT_L(0); PG8_BAR; PG8_MMA(1, 0, At, B0); PG8_MMA(1, 1, At, B1); PG8_BAR; PG8_SCHED;
            PG8_LDB(B0, 1, 0); PG8_LDB(B1, 1, 1); PG8_SCHED; PG8_LDA(At, 1, 0); PG8_STAGE(PG8_SA(0, 1), a2 + hstep, voffA);
            PG8_WAIT_V(8); PG8_WAIT_L(0); PG8_BAR; PG8_MMA(0, 0, At, B0); PG8_MMA(0, 1, At, B1); PG8_BAR; PG8_SCHED;
            PG8_LDA(At, 1, 1); PG8_STAGE(PG8_SB(1, 0), b3, voffB); PG8_STAGE(PG8_SB(1, 1), b3 + hstep, voffB); PG8_STAGE(PG8_SA(1, 0), a3, voffA);
            PG8_WAIT_V(8); PG8_WAIT_L(0); PG8_BAR; PG8_MMA(1, 0, At, B0); PG8_MMA(1, 1, At, B1); PG8_BAR; PG8_SCHED;
            } else {
            PG8_LDB(B0, 0, 0); PG8_SCHED; PG8_LDA(At, 0, 0); PG8_STAGE(PG8_SA(1, 1), a1 + hstep, voffA);
            PG8_WAIT_L(8); PG8_BAR; PG8_WAIT_L(0); PG8_MMA(0, 0, At, B0); PG8_BAR; PG8_SCHED;
            PG8_LDB(B1, 0, 1); PG8_STAGE(PG8_SB(0, 0), b2, voffB);
            PG8_BAR; PG8_WAIT_L(0); PG8_MMA(0, 1, At, B1); PG8_BAR;
            PG8_LDA(At, 0, 1); PG8_STAGE(PG8_SA(0, 0), a2, voffA);
            PG8_BAR; PG8_WAIT_L(0); PG8_MMA(1, 0, At, B0); PG8_BAR; PG8_SCHED;
            PG8_STAGE(PG8_SB(0, 1), b2 + hstep, voffB);
            PG8_WAIT_V(6); PG8_BAR; PG8_MMA(1, 1, At, B1); PG8_BAR;
            PG8_LDB(B0, 1, 0); PG8_SCHED; PG8_LDA(At, 1, 0); PG8_STAGE(PG8_SA(0, 1), a2 + hstep, voffA);
            PG8_WAIT_L(8); PG8_BAR; PG8_WAIT_L(0); PG8_MMA(0, 0, At, B0); PG8_BAR; PG8_SCHED;
            PG8_LDB(B1, 1, 1); PG8_STAGE(PG8_SB(1, 0), b3, voffB);
            PG8_BAR; PG8_WAIT_L(0); PG8_MMA(0, 1, At, B1); PG8_BAR;
            PG8_LDA(At, 1, 1); PG8_STAGE(PG8_SA(1, 0), a3, voffA);
            PG8_BAR; PG8_WAIT_L(0); PG8_MMA(1, 0, At, B0); PG8_BAR; PG8_SCHED;
            PG8_STAGE(PG8_SB(1, 1), b3 + hstep, voffB);
            PG8_WAIT_V(6); PG8_BAR; PG8_MMA(1, 1, At, B1); PG8_BAR;
            }
        }
        if constexpr (ALIGN_EPI) { if (wr == 0) PG8_BAR; }
        if constexpr (!Epi::AFTER_DRAIN) { E(acc, cur, wr, wc, fr, fq); S.done(cur); }
        if (!has_next) break;
#pragma unroll
        for (int a = 0; a < 2; ++a)
#pragma unroll
            for (int b = 0; b < 2; ++b)
#pragma unroll
                for (int m = 0; m < 4; ++m)
#pragma unroll
                    for (int n = 0; n < 2; ++n) acc[a][b][m][n] = (f32x4){0.f, 0.f, 0.f, 0.f};
        cur = nxt; cA = nA; cB = nB; ++ui;
        if constexpr (ALIGN_EPI) { if (wr == 1) PG8_BAR; }
    }
    PG8_WAIT_V(0);
    if constexpr (!ALIGN_EPI) { if (wr == 0) PG8_BAR; }
    PG8_BAR;
    if constexpr (Epi::AFTER_DRAIN) { E.fused(acc, cur, wr, wc, fr, fq, lds, wid, lane); S.done(cur); }
#undef PG8_SA
#undef PG8_SB
#undef PG8_STAGE
#undef PG8_LDA
#undef PG8_LDB
#undef PG8_MMA
#undef PG8_WAIT_V
#undef PG8_WAIT_L
#undef PG8_BAR
#undef PG8_SCHED
}
}
namespace att {
using bf16 = __hip_bfloat16;
constexpr int   D = 128, NW = 8, QBLK = 32, KVBLK = 64;
constexpr float SCALE = 0.088388347648318440f;
constexpr float THR = 8.f;
constexpr int SDEPTH = 2;
constexpr int LDQ = 1536, LDK = 512, LDO = 1536;
constexpr size_t SHM_V = KVBLK * D * 2, SHM_K = KVBLK * D * 2, SHM_ATTN = 2 * SHM_V + 2 * SHM_K + NW * 64 * 4;
__device__ __forceinline__ unsigned short f2bf_att(float f) { unsigned u = __builtin_bit_cast(unsigned, f); return (unsigned short)((u + 0x7fffu + ((u >> 16) & 1u)) >> 16); }
using bf16x8 = __attribute__((ext_vector_type(8))) short;
using s16x4  = __attribute__((ext_vector_type(4))) short;
using f32x16 = __attribute__((ext_vector_type(16))) float;
using f32x8  = __attribute__((ext_vector_type(8))) float;
using u32x4  = __attribute__((ext_vector_type(4))) unsigned;
#define KSWZ(row, colB) ((row) * 256 + ((colB) ^ (((row) & 7) << 4)))
#define SBAR() __builtin_amdgcn_sched_barrier(0)
__device__ __forceinline__ int crow(int r, int hi) { return (r & 3) + 8 * (r >> 2) + 4 * hi; }
__device__ __forceinline__ unsigned cvtpk(float lo, float hi) {
  unsigned r; asm volatile("v_cvt_pk_bf16_f32 %0, %1, %2" : "=v"(r) : "v"(lo), "v"(hi)); return r;
}
template <typename TIn> struct Stage;
template <> struct Stage<bf16>  { using T = bf16x8;
  __device__ static __forceinline__ T ld8(const bf16* p) { return *reinterpret_cast<const bf16x8*>(p); }
  __device__ static __forceinline__ bf16x8 tobf(T x) { return x; } };
template <> struct Stage<float> { using T = f32x8;
  __device__ static __forceinline__ T ld8(const float* p) { return *reinterpret_cast<const f32x8*>(p); }
  __device__ static __forceinline__ bf16x8 tobf(T x) {
    u32x4 w = {cvtpk(x[0], x[1]), cvtpk(x[2], x[3]), cvtpk(x[4], x[5]), cvtpk(x[6], x[7])}; return *reinterpret_cast<bf16x8*>(&w); } };

__device__ __forceinline__ void partialSM(f32x16& p0, f32x16& p1, float& m_reg, float& mn, float& alpha) {
  constexpr float C = SCALE * 1.4426950408889634f;
  float pmax = p0[0]; for (int r = 1; r < 16; ++r) pmax = fmaxf(pmax, p0[r]); for (int r = 0; r < 16; ++r) pmax = fmaxf(pmax, p1[r]);
  { auto rr = __builtin_amdgcn_permlane32_swap(__float_as_uint(pmax), __float_as_uint(pmax), false, false);
    pmax = fmaxf(__uint_as_float(rr[0]), __uint_as_float(rr[1])); }
  if (__builtin_expect(__all(pmax - m_reg <= THR / SCALE), 1)) { mn = m_reg; alpha = 1.f; }
  else { mn = fmaxf(m_reg, pmax); alpha = __builtin_amdgcn_exp2f((m_reg - mn) * C); m_reg = mn; }
  float mnC = -mn * C;
  for (int r = 0; r < 16; ++r) p0[r] = fmaf(p0[r], C, mnC); for (int r = 0; r < 16; ++r) p1[r] = fmaf(p1[r], C, mnC);
  for (int r = 0; r < 16; ++r) p0[r] = __builtin_amdgcn_exp2f(p0[r]);
}
__device__ __forceinline__ void finishSM(f32x16& p0, f32x16& p1, float alpha, float& l_reg, bf16x8& pa0, bf16x8& pa1, bf16x8& pa2, bf16x8& pa3) {
  for (int r = 0; r < 16; ++r) p1[r] = __builtin_amdgcn_exp2f(p1[r]);
  float ps = 0; for (int r = 0; r < 16; ++r) ps += p0[r]; for (int r = 0; r < 16; ++r) ps += p1[r];
  { auto rr = __builtin_amdgcn_permlane32_swap(__float_as_uint(ps), __float_as_uint(ps), false, false);
    ps = __uint_as_float(rr[0]) + __uint_as_float(rr[1]); }
  l_reg = l_reg * alpha + ps;
#define PK4(P, BASE, OUT) do { unsigned a0 = cvtpk(P[BASE + 0], P[BASE + 1]), a1 = cvtpk(P[BASE + 2], P[BASE + 3]);   \
    unsigned b0 = cvtpk(P[BASE + 4], P[BASE + 5]), b1 = cvtpk(P[BASE + 6], P[BASE + 7]);                              \
    auto r0 = __builtin_amdgcn_permlane32_swap(a0, b0, false, false); auto r1 = __builtin_amdgcn_permlane32_swap(a1, b1, false, false); \
    u32x4 w = {r0[0], r1[0], r0[1], r1[1]}; OUT = *reinterpret_cast<bf16x8*>(&w); } while (0)
  PK4(p0, 0, pa0); PK4(p0, 8, pa1); PK4(p1, 0, pa2); PK4(p1, 8, pa3);
#undef PK4
}
__device__ __forceinline__ void qkt(f32x16& p0, f32x16& p1, const bf16* Ks, const bf16x8* qr, int r32, int hi) {
  p0 = f32x16{}; p1 = f32x16{};
  for (int d0 = 0; d0 < 8; ++d0) { int cb = (d0 * 16 + hi * 8) * 2;
    bf16x8 b0 = *reinterpret_cast<const bf16x8*>((const char*)Ks + KSWZ(r32, cb));
    bf16x8 b1 = *reinterpret_cast<const bf16x8*>((const char*)Ks + KSWZ(32 + r32, cb));
    p0 = __builtin_amdgcn_mfma_f32_32x32x16_bf16(b0, qr[d0], p0, 0, 0, 0);
    p1 = __builtin_amdgcn_mfma_f32_32x32x16_bf16(b1, qr[d0], p1, 0, 0, 0); }
}
__device__ __forceinline__ int v_st(int k, int c) { const int kk = (k & ~0xC) | ((k & 4) << 1) | ((k & 8) >> 1); return ((kk >> 3) * 4 + (c >> 5)) * 512 + ((kk & 7) * 32 + (c & 31)) * 2; }
__device__ __forceinline__ int v_rd_base(int lane) { return ((lane & 3) << 3) | (((lane >> 2) & 3) << 6) | (((lane >> 4) & 1) << 5) | (((lane >> 5) & 1) << 8); }
constexpr int v_rd_off(int d0, int ks, int half) { return d0 * 512 + ks * 4096 + half * 2048; }
template <int OFF> __device__ __forceinline__ s16x4 tr_read(int vb) {
  s16x4 r; asm volatile("ds_read_b64_tr_b16 %0, %1 offset:%2" : "=&v"(r) : "v"(vb), "i"(OFF) : "memory"); return r;
}
template <int D0> __device__ __forceinline__ void pv_one(f32x16& od, int vb, bf16x8 pa0, bf16x8 pa1, bf16x8 pa2, bf16x8 pa3) {
  const s16x4 l0 = tr_read<v_rd_off(D0, 0, 0)>(vb), h0 = tr_read<v_rd_off(D0, 0, 1)>(vb), l1 = tr_read<v_rd_off(D0, 1, 0)>(vb), h1 = tr_read<v_rd_off(D0, 1, 1)>(vb);
  const s16x4 l2 = tr_read<v_rd_off(D0, 2, 0)>(vb), h2 = tr_read<v_rd_off(D0, 2, 1)>(vb), l3 = tr_read<v_rd_off(D0, 3, 0)>(vb), h3 = tr_read<v_rd_off(D0, 3, 1)>(vb);
  asm volatile("s_waitcnt lgkmcnt(0)" ::: "memory"); SBAR();
#define PK(L, H) (bf16x8){L[0], L[1], L[2], L[3], H[0], H[1], H[2], H[3]}
  od = __builtin_amdgcn_mfma_f32_32x32x16_bf16(pa0, PK(l0, h0), od, 0, 0, 0);
  od = __builtin_amdgcn_mfma_f32_32x32x16_bf16(pa1, PK(l1, h1), od, 0, 0, 0);
  od = __builtin_amdgcn_mfma_f32_32x32x16_bf16(pa2, PK(l2, h2), od, 0, 0, 0);
  od = __builtin_amdgcn_mfma_f32_32x32x16_bf16(pa3, PK(l3, h3), od, 0, 0, 0);
#undef PK
}
__device__ __forceinline__ void pv_d0(f32x16* o, int vb, bf16x8 pa0, bf16x8 pa1, bf16x8 pa2, bf16x8 pa3) {
  pv_one<0>(o[0], vb, pa0, pa1, pa2, pa3); pv_one<1>(o[1], vb, pa0, pa1, pa2, pa3); pv_one<2>(o[2], vb, pa0, pa1, pa2, pa3); pv_one<3>(o[3], vb, pa0, pa1, pa2, pa3);
}

template <typename TQ>
__device__ __forceinline__ void attn_dense_body(const TQ* __restrict__ Qb, const bf16* __restrict__ Kh, const bf16* __restrict__ Vh,
                                                unsigned short* __restrict__ Ob, int seq, char* lds, int tid_in) {
  using St = Stage<bf16>; using SQ = Stage<TQ>;
  int tid_ = tid_in; asm volatile("" : "+v"(tid_));
  const int tid = tid_, wid = tid >> 6, lane = tid & 63, r32 = lane & 31, hi = lane >> 5;
  bf16* V_lds = (bf16*)lds; bf16* K_lds = (bf16*)(lds + 2 * SHM_V);
  float* ws = (float*)(lds + 2 * SHM_V + 2 * SHM_K) + wid * 64; float* li_l = ws; float* al_l = ws + 32;
  float m_reg = -1e30f, l_reg = 0; f32x16 o[4] = {}; bf16x8 qr[8];
  const TQ* Qw = Qb + (long)(wid * QBLK + r32) * LDQ + hi * 8;
#pragma unroll
  for (int d0 = 0; d0 < 8; ++d0) qr[d0] = SQ::tobf(SQ::ld8(Qw + d0 * 16));
  const int sr = tid >> 4, sc = (tid & 15) * 8, vst0 = v_st(sr, sc), vst1 = v_st(32 + sr, sc);
  const int vb0 = (int)(uintptr_t)V_lds + v_rd_base(lane);
  struct { typename St::T vs0, vs1, ks0, ks1; } sr_[SDEPTH];
  const unsigned lo0 = (unsigned)(sr * LDK + sc) * 2u, lo1 = lo0 + 32u * LDK * 2u;
#define SLOAD(i, k0) do { const char* vt_ = (const char*)Vh + (size_t)(k0) * (LDK * 2); const char* kt_ = (const char*)Kh + (size_t)(k0) * (LDK * 2); \
    sr_[i].vs0 = *(const bf16x8*)(vt_ + lo0); sr_[i].vs1 = *(const bf16x8*)(vt_ + lo1); \
    sr_[i].ks0 = *(const bf16x8*)(kt_ + lo0); sr_[i].ks1 = *(const bf16x8*)(kt_ + lo1); } while (0)
#define SWRITE(b, i) do { *(bf16x8*)((char*)V_lds + (b) * SHM_V + vst0) = St::tobf(sr_[i].vs0);          \
    *(bf16x8*)((char*)V_lds + (b) * SHM_V + vst1) = St::tobf(sr_[i].vs1); int kc = sc * 2;               \
    *(bf16x8*)((char*)K_lds + (b) * SHM_K + KSWZ(sr, kc)) = St::tobf(sr_[i].ks0);                       \
    *(bf16x8*)((char*)K_lds + (b) * SHM_K + KSWZ(32 + sr, kc)) = St::tobf(sr_[i].ks1); } while (0)
#define SWAIT() do { if constexpr (SDEPTH == 2) asm volatile("s_waitcnt vmcnt(4)" ::: "memory"); else asm volatile("s_waitcnt vmcnt(0)" ::: "memory"); } while (0)
#define RESC(a) do { if (__any((a) < 1.f)) { if (hi == 0) al_l[r32] = (a); asm volatile("s_waitcnt lgkmcnt(0)" ::: "memory"); \
    for (int d = 0; d < 4; ++d) for (int r = 0; r < 16; ++r) o[d][r] *= al_l[crow(r, hi)]; } } while (0)
  f32x16 pA0, pA1, pB0, pB1; float mnA, mnB, alA, alB; bf16x8 pa0, pa1, pa2, pa3; const int NT = seq / KVBLK;
  constexpr int SE = 0, SO = SDEPTH - 1;
  SLOAD(SE, 0); asm volatile("s_waitcnt vmcnt(0)" ::: "memory"); SWRITE(0, SE); __syncthreads();
  qkt(pA0, pA1, K_lds, qr, r32, hi); partialSM(pA0, pA1, m_reg, mnA, alA);
  SLOAD(SO, KVBLK); if constexpr (SDEPTH == 2) { if (2 < NT) SLOAD(SE, 2 * KVBLK); }
  SWAIT(); SWRITE(1, SO); __syncthreads();
  for (int j = 1; j + 1 < NT; j += 2) {
    SBAR(); qkt(pB0, pB1, (bf16*)((char*)K_lds + SHM_K), qr, r32, hi);
    finishSM(pA0, pA1, alA, l_reg, pa0, pa1, pa2, pa3); SBAR();
    SLOAD(SO, (j + SDEPTH) * KVBLK); SBAR();
    pv_d0(o, vb0, pa0, pa1, pa2, pa3); partialSM(pB0, pB1, m_reg, mnB, alB);
    __syncthreads(); SWAIT(); SWRITE(0, SE);
    RESC(alB); __syncthreads();
    SBAR(); qkt(pA0, pA1, K_lds, qr, r32, hi);
    finishSM(pB0, pB1, alB, l_reg, pa0, pa1, pa2, pa3); SBAR();
    if (SDEPTH == 1 || j + 3 < NT) SLOAD(SE, (j + 1 + SDEPTH) * KVBLK); SBAR();
    pv_d0(o, vb0 + (int)SHM_V, pa0, pa1, pa2, pa3); partialSM(pA0, pA1, m_reg, mnA, alA);
    __syncthreads(); SWAIT(); SWRITE(1, SO);
    RESC(alA); __syncthreads();
  }
  SBAR(); qkt(pB0, pB1, (bf16*)((char*)K_lds + SHM_K), qr, r32, hi);
  finishSM(pA0, pA1, alA, l_reg, pa0, pa1, pa2, pa3); SBAR();
  pv_d0(o, vb0, pa0, pa1, pa2, pa3); partialSM(pB0, pB1, m_reg, mnB, alB);
  __syncthreads(); RESC(alB);
  finishSM(pB0, pB1, alB, l_reg, pa0, pa1, pa2, pa3); SBAR();
  pv_d0(o, vb0 + (int)SHM_V, pa0, pa1, pa2, pa3);
  if (hi == 0) li_l[r32] = l_reg; asm volatile("s_waitcnt lgkmcnt(0)" ::: "memory");
  float rli[16];
#pragma unroll
  for (int r = 0; r < 16; ++r) rli[r] = __builtin_amdgcn_rcpf(li_l[crow(r, hi)]);
  unsigned short* Ow = Ob + (long)(wid * QBLK) * LDO;
#pragma unroll
  for (int r = 0; r < 16; ++r) { int orow = crow(r, hi);
    for (int d0 = 0; d0 < 4; ++d0) Ow[(long)orow * LDO + d0 * 32 + r32] = f2bf_att(o[d0][r] * rli[r]); }
#undef SLOAD
#undef SWRITE
#undef SWAIT
#undef RESC
}

#undef KSWZ
#undef SBAR
}
constexpr int NWAVES = 8;
constexpr int DM = 4096, SEQ = 8192, CTXL = 256, MROWS = SEQ + CTXL, DEPTH = 4;
constexpr int WMIX = 1536, KVW = 512, NIN = 22528, DFF = 4096, MODR = 256, NMOD = 9;
constexpr int COL_AX = 0, COL_CK = 1536, COL_CV = 2048, COL_AG = 2560, COL_B = 4096, COL_CQ = 8704, COL_G = 10240;
constexpr int NCHUNK = MROWS / 64;
constexpr int FFTN = 16384;
constexpr float EPSN = 1e-6f;
constexpr int N_IN_TENSORS = 36;
enum { I_X = 0, I_C, I_CTX, I_CCTX, I_WMD, I_WMU, I_BMOD, I_NF1, I_NMIX, I_NF2, I_F1IN, I_F1OUT, I_F2IN, I_F2OUT, I_WIN, I_LCONV, I_LWA, I_LBA, I_LWX, I_LBX, I_LLAM,
       I_HCONV, I_HFW1, I_HFB1, I_HFREQ, I_HFW2, I_HFB2, I_HFW3, I_HSKIP, I_QN, I_KN, I_WBA, I_WBB, I_WBC, I_WOUT, I_FNORM };

constexpr size_t MiB = 1u << 20;
constexpr size_t WS_CTL = 0, CTL_ZERO_BYTES = 1 * MiB;
constexpr size_t WS_MOD = 2 * MiB;
constexpr size_t WS_W = 4 * MiB;
constexpr size_t WO_GU1 = 0, WO_D1 = 64 * MiB, WO_GU2 = 96 * MiB, WO_D2 = 160 * MiB, WO_IN = 192 * MiB, WO_BR = 368 * MiB, WO_OUT = 404 * MiB, WO_LRU = 436 * MiB, W_LAYER = 454 * MiB;
constexpr size_t WS_X = WS_W + DEPTH * W_LAYER;
constexpr size_t WS_U = WS_X + 132 * MiB;
constexpr size_t WS_H = WS_U + 66 * MiB;
constexpr size_t WS_P = WS_H + 66 * MiB;
constexpr size_t WS_XA = WS_P + 363 * MiB;
constexpr size_t WS_LA = WS_XA + 25 * MiB;
constexpr size_t WS_LB = WS_LA + 99 * MiB;
constexpr size_t WS_CA = WS_LB + 99 * MiB;
constexpr size_t WS_CB = WS_CA + 2 * MiB;
constexpr size_t WS_CIN = WS_CB + 2 * MiB;
constexpr size_t WS_QN = WS_CIN + 2 * MiB;
constexpr size_t WS_KN = WS_QN + 25 * MiB;
constexpr size_t WS_VN = WS_KN + 9 * MiB;
constexpr size_t WS_YA = WS_VN + 9 * MiB;
constexpr size_t WS_YB = WS_YA + 25 * MiB;
constexpr size_t WS_YC = WS_YB + 25 * MiB;
constexpr size_t WS_M32 = WS_YC + 25 * MiB;
constexpr size_t WS_VT = WS_M32 + 132 * MiB;
constexpr size_t WS_YBT = WS_VT + 144 * MiB;
constexpr size_t WS_KT = WS_YBT + 48 * MiB;
constexpr size_t WS_PM = WS_KT + 192 * MiB;
constexpr size_t WS_H2 = WS_PM + 384 * MiB;
constexpr size_t WS_H2C = WS_H2 + 2 * MiB;
constexpr size_t WS_KC = WS_H2C + 1 * MiB;
constexpr size_t WS_KCN = WS_KC + 6 * MiB;
constexpr size_t WS_UC = WS_KCN + 1 * MiB;
constexpr size_t WS_END = WS_UC + 5 * MiB;
constexpr int CW_TMO = 0, CW_CODE = 1;
constexpr int CW_BAR = 4096;
constexpr int CW_T1 = 16384;

constexpr int RING_OFF = 0, RING_BYTES = 131072;
constexpr int FFT_BYTES = (FFTN + FFTN / 32) * 8;
constexpr int RED_OFF = FFT_BYTES;
constexpr int WSCR_BYTES = 66 * 65 * 4;
constexpr int LDSCTL_OFF = 143360, MISC_OFF = LDSCTL_OFF + 320;
constexpr int LDS_BYTES = 147456;
static_assert(RED_OFF + 1024 <= LDSCTL_OFF && NWAVES * WSCR_BYTES <= LDSCTL_OFF && MISC_OFF + 128 <= LDS_BYTES, "LDS map");

#define GAS __attribute__((address_space(1)))
#define LAS __attribute__((address_space(3)))
typedef unsigned short bf16;
typedef unsigned v4u __attribute__((ext_vector_type(4)));
typedef unsigned v2u __attribute__((ext_vector_type(2)));
typedef float f32x4 __attribute__((ext_vector_type(4)));
typedef float f32x2 __attribute__((ext_vector_type(2)));
typedef GAS unsigned gu32;
#define RLX_AGENT __ATOMIC_RELAXED, __HIP_MEMORY_SCOPE_AGENT
#define LDS_WAIT() asm volatile("s_waitcnt lgkmcnt(0)" ::: "memory")
#define VM_WAIT() asm volatile("s_waitcnt vmcnt(0)" ::: "memory")
__device__ __forceinline__ unsigned f2bf(float f) { unsigned u = __builtin_bit_cast(unsigned, f); return (u + 0x7fffu + ((u >> 16) & 1u)) >> 16; }
__device__ __forceinline__ unsigned pk2(float lo, float hi) { return f2bf(lo) | (f2bf(hi) << 16); }
__device__ __forceinline__ float bflo(unsigned w) { return __uint_as_float(w << 16); }
__device__ __forceinline__ float bfhi(unsigned w) { return __uint_as_float(w & 0xffff0000u); }
__device__ __forceinline__ float bf1(bf16 h) { return __uint_as_float(((unsigned)h) << 16); }
template <int MASK> __device__ __forceinline__ float swz_xor(float v) { return __int_as_float(__builtin_amdgcn_ds_swizzle(__float_as_int(v), (MASK << 10) | 0x1f)); }
__device__ __forceinline__ float lane_bcast(float v, int l) { return __int_as_float(__builtin_amdgcn_readlane(__float_as_int(v), l)); }
__device__ __forceinline__ float wave_sum(float v) {
    v += swz_xor<1>(v); v += swz_xor<2>(v); v += swz_xor<4>(v); v += swz_xor<8>(v); v += swz_xor<16>(v);
    const auto rr = __builtin_amdgcn_permlane32_swap(__float_as_uint(v), __float_as_uint(v), false, false);
    return __uint_as_float(rr[0]) + __uint_as_float(rr[1]);
}
__device__ __forceinline__ float sigmoidf_(float x) { return 1.0f / (1.0f + __expf(-x)); }
#define XB_TMO      128
#define XB_XCNT(j)  (256  + 64 * (j))
#define XB_XSUB(j)  (1280 + 64 * (j))
#define XB_XGEN(j)  (2304 + 64 * (j))
#define XB_TOP      3328
#define XB_TOPGEN   3392
#define XCD_BAR_WORDS 3456
#define XB_SPIN_CAP (1u << 18)

__device__ __forceinline__ unsigned xb_ld(unsigned* p)              { return __hip_atomic_load(p, __ATOMIC_RELAXED, __HIP_MEMORY_SCOPE_AGENT); }
__device__ __forceinline__ unsigned xb_add(unsigned* p, unsigned v) { return __hip_atomic_fetch_add(p, v, __ATOMIC_RELAXED, __HIP_MEMORY_SCOPE_AGENT); }
__device__ __forceinline__ unsigned xb_xcc_id() { return (unsigned)__builtin_amdgcn_s_getreg((3 << 11) | 20) & 0xFu; }
#define XB_SPIN(cond, bar) do { unsigned _sp = 0; while (cond) { __builtin_amdgcn_s_sleep(1); \
    if ((++_sp & 255u) == 0u) { if (xb_ld(&(bar)[XB_TMO])) break; if (_sp > XB_SPIN_CAP) { atomicAdd(&(bar)[XB_TMO], 1u); break; } } } } while (0)

struct XcdBarrier {
    unsigned* bar; unsigned x;
    volatile LAS unsigned* st;
};

__device__ __forceinline__ XcdBarrier xcd_barrier_post(unsigned* bar, volatile LAS unsigned* st) {
    XcdBarrier b; b.bar = bar; b.x = xb_xcc_id(); b.st = st;
    if (threadIdx.x == 0) (void)xb_add(&bar[XB_XCNT(b.x)], 1u);
    return b;
}
__device__ __forceinline__ void xcd_barrier_complete(unsigned* bar, unsigned x, unsigned& nloc, unsigned& nx) {
    const unsigned G = gridDim.x * gridDim.y * gridDim.z;
    unsigned sum, cnt, mine, sp = 0u;
    for (;;) {
        sum = 0u; cnt = 0u; mine = 0u;
#pragma unroll
        for (unsigned j = 0; j < 16; ++j) { const unsigned c = xb_ld(&bar[XB_XCNT(j)]); sum += c; cnt += (c > 0u) ? 1u : 0u; mine = (j == x) ? c : mine; }
        if (sum == G) break;
        __builtin_amdgcn_s_sleep(1);
        if ((++sp & 255u) == 0u) { if (xb_ld(&bar[XB_TMO])) break; if (sp > XB_SPIN_CAP) { atomicAdd(&bar[XB_TMO], 1u); break; } }
    }
    nloc = mine > 0u ? mine : 1u; nx = cnt > 0u ? cnt : 1u;
}

__device__ __forceinline__ void xcd_barrier(const XcdBarrier& b) {
    asm volatile("s_waitcnt vmcnt(0)" ::: "memory");
    __syncthreads();
    if (threadIdx.x == 0) {
        unsigned* bar = b.bar;
        __builtin_amdgcn_s_waitcnt(0);
        unsigned nloc = b.st[0], nx = b.st[1];
        if (nloc == 0u) { xcd_barrier_complete(bar, b.x, nloc, nx); b.st[0] = nloc; b.st[1] = nx; }
        const unsigned old = xb_add(&bar[XB_XSUB(b.x)], 1u);
        const unsigned gen = old / nloc;
        if (old + 1u == (gen + 1u) * nloc) {
            __builtin_amdgcn_fence(__ATOMIC_RELEASE, "agent");
            asm volatile("s_waitcnt vmcnt(0)" ::: "memory");
            const unsigned og = xb_add(&bar[XB_TOP], 1u);
            const unsigned tg = og / nx;
            if (og + 1u == (tg + 1u) * nx) xb_add(&bar[XB_TOPGEN], 1u);
            else XB_SPIN(xb_ld(&bar[XB_TOPGEN]) == tg, bar);
            __builtin_amdgcn_fence(__ATOMIC_ACQUIRE, "agent");
            xb_add(&bar[XB_XGEN(b.x)], 1u);
            asm volatile("s_waitcnt vmcnt(0)" ::: "memory");
        } else {
            XB_SPIN(xb_ld(&bar[XB_XGEN(b.x)]) == gen, bar);
            __builtin_amdgcn_fence(__ATOMIC_ACQUIRE, "agent");
            asm volatile("s_waitcnt vmcnt(0)" ::: "memory");
        }
    }
    __syncthreads();
}
struct Args { const float* in[N_IN_TENSORS]; float* out; unsigned char* ws; int ph_lo, ph_hi; };
static_assert(sizeof(Args) == N_IN_TENSORS * 8 + 8 + 8 + 8, "Args has no padding");
__device__ __forceinline__ const float* inp(const Args& A, int i) { asm volatile("" : "+s"(i)); return (const float*)(const GAS float*)A.in[i]; }
struct Frame {
    LAS unsigned char* lds;
    unsigned char* ws;
    float* out;
    int tid, lane, wave, G, gw, ngw, bid;
};
__device__ __forceinline__ Frame fresh(const Frame& F) { Frame L = F; unsigned z = 0u; asm volatile("" : "+v"(z)); int wv = F.wave; asm volatile("" : "+s"(wv)); int b = F.bid; asm volatile("" : "+s"(b));
    unsigned long long w = (unsigned long long)F.ws; asm volatile("" : "+s"(w)); L.ws = (unsigned char*)(GAS unsigned char*)w;
    L.lane = (int)__builtin_amdgcn_mbcnt_hi(~0u, __builtin_amdgcn_mbcnt_lo(~0u, z));
    L.wave = wv; L.tid = wv * 64 + L.lane; L.bid = b; L.gw = b * NWAVES + wv; return L; }
#define WSP(T, off) ((T*)(F.ws + (off)))

__device__ __forceinline__ void transpose_item(const float* W, int K, int N, bf16* WT, int k0, int n0, int drow0, LAS float* scr, int lane) {
    const float* src = W + (size_t)k0 * N + n0 + lane;
#pragma unroll 16
    for (int kk = 0; kk < 64; ++kk) scr[kk * 65 + lane] = src[(size_t)kk * N];
    LDS_WAIT(); asm volatile("" ::: "memory");
    const int c = lane & 7;
#pragma unroll
    for (int j = 0; j < 8; ++j) { const int n = (lane >> 3) + 8 * j; const LAS float* s = scr + (8 * c) * 65 + n;
        v4u o; o.x = pk2(s[0 * 65], s[1 * 65]); o.y = pk2(s[2 * 65], s[3 * 65]); o.z = pk2(s[4 * 65], s[5 * 65]); o.w = pk2(s[6 * 65], s[7 * 65]);
        *(GAS v4u*)(WT + (size_t)(drow0 + n) * K + k0 + 8 * c) = o; }
    LDS_WAIT(); asm volatile("" ::: "memory");
}
template <int SWI> __device__ __forceinline__ void transpose_matrix(const Frame& F_, const Args& A, const float* W, int K, int N, bf16* WT, LAS float* scr) {
    const Frame F = fresh(F_);
    const int nblk = N / 64, nitems = (K / 64) * nblk;
    for (int it = F.gw; it < nitems; it += F.ngw) { const int kb = it / nblk, nb = it - kb * nblk, n0 = 64 * nb; int drow0 = n0;
        if (SWI) { const int h = n0 / 4096, c = n0 - h * 4096; drow0 = 256 * (c / 128) + 128 * h + (c & 127); }
        transpose_item(W, K, N, WT, 64 * kb, n0, drow0, scr, F.lane); }
}
__device__ __forceinline__ void prologue_a(const Frame& F_, const Args& A) {
    const Frame F = fresh(F_);
    LAS float* scr = (LAS float*)(F.lds + F.wave * 16640);
    { float* T1 = WSP(float, WS_CTL) + CW_T1; const float* cl = inp(A, I_C); const float* cc = inp(A, I_CCTX);
      for (int u = F.gw; u < DEPTH * 64; u += F.ngw) { const int layer = u >> 6, jg = u & 63;
          f32x4 al = {0.f, 0.f, 0.f, 0.f}, ac = {0.f, 0.f, 0.f, 0.f};
#pragma unroll 8
          for (int i = 0; i < 64; ++i) { const int d = F.lane + 64 * i; const float xl = cl[d], xc = cc[d]; const float sl = xl * sigmoidf_(xl), sc = xc * sigmoidf_(xc);
              const f32x4 w = *(const f32x4*)(inp(A, I_WMD) + ((size_t)layer * DM + d) * MODR + 4 * jg); al += w * sl; ac += w * sc; }
#pragma unroll
          for (int e = 0; e < 4; ++e) { const float tl = wave_sum(al[e]), tc = wave_sum(ac[e]);
              if (F.lane == 0) { T1[(layer * 2 + 0) * MODR + 4 * jg + e] = tl; T1[(layer * 2 + 1) * MODR + 4 * jg + e] = tc; } } } }
    { float* SPT = WSP(float, WS_MOD + 1536 * 1024); const float* lam = inp(A, I_LLAM);
      for (int i = F.bid * 512 + F.tid; i < DEPTH * 2 * WMIX; i += F.G * 512) SPT[i] = 8.0f * log1pf(__expf(-lam[i])); }
    { v2u* X = WSP(v2u, WS_X); const f32x4* xc = (const f32x4*)inp(A, I_CTX); const f32x4* xl = (const f32x4*)inp(A, I_X); const size_t nc = (size_t)CTXL * DM / 4, nt = (size_t)MROWS * DM / 4;
      for (size_t i = (size_t)F.bid * 512 + F.tid; i < nt; i += (size_t)F.G * 512) { const f32x4 v = (i < nc) ? xc[i] : xl[i - nc]; X[i] = (v2u){pk2(v.x, v.y), pk2(v.z, v.w)}; } }
    for (int layer = 0; layer < DEPTH; ++layer) { unsigned char* wb = F.ws + WS_W + (size_t)layer * W_LAYER;
        transpose_matrix<1>(F, A, inp(A, I_F1IN) + (size_t)layer * DM * 2 * DFF, DM, 2 * DFF, (bf16*)(wb + WO_GU1), scr);
        transpose_matrix<0>(F, A, inp(A, I_F1OUT) + (size_t)layer * DFF * DM, DFF, DM, (bf16*)(wb + WO_D1), scr);
        transpose_matrix<1>(F, A, inp(A, I_F2IN) + (size_t)layer * DM * 2 * DFF, DM, 2 * DFF, (bf16*)(wb + WO_GU2), scr);
        transpose_matrix<0>(F, A, inp(A, I_F2OUT) + (size_t)layer * DFF * DM, DFF, DM, (bf16*)(wb + WO_D2), scr);
        transpose_matrix<0>(F, A, inp(A, I_WIN) + (size_t)layer * DM * NIN, DM, NIN, (bf16*)(wb + WO_IN), scr);
        transpose_matrix<0>(F, A, inp(A, I_WBA) + (size_t)layer * WMIX * DM, WMIX, DM, (bf16*)(wb + WO_BR), scr);
        transpose_matrix<0>(F, A, inp(A, I_WBB) + (size_t)layer * WMIX * DM, WMIX, DM, (bf16*)(wb + WO_BR) + (size_t)DM * WMIX, scr);
        transpose_matrix<0>(F, A, inp(A, I_WBC) + (size_t)layer * WMIX * DM, WMIX, DM, (bf16*)(wb + WO_BR) + (size_t)2 * DM * WMIX, scr);
        transpose_matrix<0>(F, A, inp(A, I_WOUT) + (size_t)layer * DM * DM, DM, DM, (bf16*)(wb + WO_OUT), scr);
        { bf16* WL = (bf16*)(wb + WO_LRU); const float* wa = inp(A, I_LWA) + (size_t)layer * 2 * 12 * 128 * 128; const float* wx = inp(A, I_LWX) + (size_t)layer * 2 * 12 * 128 * 128;
          for (int row = F.gw; row < 6144; row += F.ngw) { const int jb = row >> 10, pnn = (row >> 8) & 3, h = (row >> 7) & 1, e = row & 127, dir = pnn >> 1, blk = 2 * jb + (pnn & 1);
              const float* src = (h ? wx : wa) + ((size_t)(dir * 12 + blk) * 128) * 128 + e;
              if (F.lane < 32) { const int k0 = F.lane * 8; v4u o = {0u, 0u, 0u, 0u};
                  if ((k0 >> 7) == (pnn & 1)) { const int dd = k0 & 127; float v[8];
#pragma unroll
                      for (int j = 0; j < 8; ++j) v[j] = src[(size_t)(dd + j) * 128];
                      o.x = pk2(v[0], v[1]); o.y = pk2(v[2], v[3]); o.z = pk2(v[4], v[5]); o.w = pk2(v[6], v[7]); }
                  *(GAS v4u*)(WL + (size_t)row * 256 + k0) = o; } } }
    }
}
__device__ __forceinline__ void prologue_b(const Frame& F_, const Args& A) {
    const Frame F = fresh(F_);
    const float* T1 = WSP(float, WS_CTL) + CW_T1; float* MOD = WSP(float, WS_MOD); constexpr int NM = NMOD * DM;
    for (int u = F.gw; u < DEPTH * 2 * (NM / 256); u += F.ngw) { const int lw = u / (NM / 256), nc = u - lw * (NM / 256), layer = lw >> 1, n0 = nc * 256 + 4 * F.lane;
        f32x4 acc = *(const f32x4*)(inp(A, I_BMOD) + (size_t)layer * NM + n0); const float* t1 = T1 + lw * MODR; const float* wu = inp(A, I_WMU) + (size_t)layer * MODR * NM + n0;
#pragma unroll 8
        for (int j = 0; j < MODR; ++j) acc += *(const f32x4*)(wu + (size_t)j * NM) * t1[j];
        *(f32x4*)(MOD + (size_t)lw * NM + n0) = acc; }
}
__device__ __forceinline__ void norm_phase(const Frame& F_, const Args& A, const float* g, const float* modL, const float* modC, int ishift, int iscale, int dfrom) {
    const Frame F = fresh(F_);
    bf16* X = WSP(bf16, WS_X); bf16* U = WSP(bf16, WS_U); const bf16* Dd = WSP(bf16, WS_M32); LAS f32x4* L4 = (LAS f32x4*)F.lds;
    __syncthreads();
    for (int i = F.tid; i < DM / 4; i += NWAVES * 64) { L4[i] = *(const f32x4*)(g + 4 * i);
        L4[1024 + i] = *(const f32x4*)(modL + ishift * DM + 4 * i); L4[2048 + i] = *(const f32x4*)(modL + iscale * DM + 4 * i) + 1.0f;
        L4[3072 + i] = *(const f32x4*)(modC + ishift * DM + 4 * i); L4[4096 + i] = *(const f32x4*)(modC + iscale * DM + 4 * i) + 1.0f; }
    __syncthreads();
    for (int r = F.gw; r < MROWS; r += F.ngw) { const int mo = (r < CTXL) ? 3072 : 1024; v2u* xr = (v2u*)(X + (size_t)r * DM) + F.lane;
        f32x4 v[16]; float s = 0.f;
#pragma unroll
        for (int i = 0; i < 16; ++i) { const v2u x = xr[64 * i]; v[i] = (f32x4){bflo(x.x), bfhi(x.x), bflo(x.y), bfhi(x.y)}; }
        if (r >= dfrom) { const v2u* dr = (const v2u*)(Dd + (size_t)r * DM) + F.lane;
#pragma unroll
            for (int i = 0; i < 16; ++i) { const v2u d = dr[64 * i]; v[i] += (f32x4){bflo(d.x), bfhi(d.x), bflo(d.y), bfhi(d.y)}; xr[64 * i] = (v2u){pk2(v[i].x, v[i].y), pk2(v[i].z, v[i].w)}; } }
#pragma unroll
        for (int i = 0; i < 16; ++i) s += (v[i].x * v[i].x + v[i].y * v[i].y) + (v[i].z * v[i].z + v[i].w * v[i].w);
        const float rms = rsqrtf(wave_sum(s) * (1.0f / DM) + EPSN);
        unsigned long long* o8 = (unsigned long long*)(U + (size_t)r * DM) + F.lane;
#pragma unroll
        for (int i = 0; i < 16; ++i) { const int c4 = F.lane + 64 * i; const f32x4 gg = L4[c4], sh = L4[mo + c4], sc1 = L4[mo + 1024 + c4];
            const f32x4 y = (v[i] * rms * gg) * sc1 + sh;
            o8[64 * i] = (unsigned long long)pk2(y.x, y.y) | ((unsigned long long)pk2(y.z, y.w) << 32); } }
    __syncthreads();
}
__device__ __forceinline__ void final_norm_phase(const Frame& F_, const Args& A) {
    const Frame F = fresh(F_);
    const bf16* X = WSP(bf16, WS_X); const bf16* Dd = WSP(bf16, WS_M32); const float* g = inp(A, I_FNORM);
    for (int r = F.gw; r < SEQ; r += F.ngw) { const v2u* xr = (const v2u*)(X + (size_t)(r + CTXL) * DM) + F.lane; const v2u* dr = (const v2u*)(Dd + (size_t)(r + CTXL) * DM) + F.lane; f32x4 v[16]; float s = 0.f;
#pragma unroll
        for (int i = 0; i < 16; ++i) { const v2u x = xr[64 * i], d = dr[64 * i]; v[i] = (f32x4){bflo(x.x) + bflo(d.x), bfhi(x.x) + bfhi(d.x), bflo(x.y) + bflo(d.y), bfhi(x.y) + bfhi(d.y)}; s += (v[i].x * v[i].x + v[i].y * v[i].y) + (v[i].z * v[i].z + v[i].w * v[i].w); }
        const float rms = rsqrtf(wave_sum(s) * (1.0f / DM) + EPSN); f32x4* o = (f32x4*)(F.out + (size_t)r * DM) + F.lane;
#pragma unroll
        for (int i = 0; i < 16; ++i) o[64 * i] = v[i] * rms * *(const f32x4*)(g + 4 * F.lane + 256 * i); }
}

#ifdef DUMP
__device__ __forceinline__ void dump_phase(const Frame& F_, const Args& A) {
    const Frame F = fresh(F_);
    const bf16* YC = WSP(bf16, WS_YC); const bf16* YA = WSP(bf16, WS_YA); const bf16* YB = WSP(bf16, WS_YB);
#if DUMP >= 8
    { const bf16* P = WSP(bf16, WS_P); const size_t nctx = (size_t)CTXL * NIN;
      for (size_t i = (size_t)F.bid * 512 + F.tid; i < (size_t)SEQ * DM; i += (size_t)F.G * 512) { float v = 0.f;
          if (i < nctx) { if (DUMP & 8) v = bf1(P[i]); } else { const size_t k = i - nctx; const size_t r = k / DM, c = k % DM; if (DUMP & 16) v = bf1(P[(size_t)(r + CTXL) * NIN + c]); }
          F.out[i] = v; } return; }
#endif
    for (size_t i = (size_t)F.bid * 512 + F.tid; i < (size_t)SEQ * DM; i += (size_t)F.G * 512) { const int r = (int)(i / DM), c = (int)(i % DM); float v = 0.f;
        if (c < 1536) { if (DUMP & 1) v = bf1(YC[(size_t)(r + CTXL) * WMIX + c]); }
        else if (c < 3072) { if (DUMP & 2) v = bf1(YA[(size_t)(r + CTXL) * WMIX + c - 1536]); }
        else { if (DUMP & 4) v = bf1(YB[(size_t)(r + CTXL) * WMIX + c - 3072]); }
        F.out[i] = v; }
}
#endif
__device__ __forceinline__ bool same_seq(int r, int r2) { return r2 >= 0 && r2 < MROWS && ((r < CTXL) == (r2 < CTXL)); }
__device__ __forceinline__ void prep_lru_conv(const Frame& F_, const Args& A, int layer) {
    const Frame F = fresh(F_);
    const bf16* P = WSP(bf16, WS_P); bf16* XA = WSP(bf16, WS_XA); const float* w = inp(A, I_LCONV) + (size_t)layer * 4 * WMIX;
    const int nitems = (MROWS / 16) * (WMIX / 8);
    for (int it = F.bid * 512 + F.tid; it < nitems; it += F.G * 512) { const int run = it / (WMIX / 8), c0 = (it - run * (WMIX / 8)) * 8, r0 = run * 16;
        float wk[4][8];
#pragma unroll
        for (int k = 0; k < 4; ++k) { const f32x4 w0 = *(const f32x4*)(w + k * WMIX + c0), w1 = *(const f32x4*)(w + k * WMIX + c0 + 4);
            wk[k][0] = w0.x; wk[k][1] = w0.y; wk[k][2] = w0.z; wk[k][3] = w0.w; wk[k][4] = w1.x; wk[k][5] = w1.y; wk[k][6] = w1.z; wk[k][7] = w1.w; }
        v4u rows[19];
#pragma unroll
        for (int q = 0; q < 19; ++q) { const int r2 = r0 - 1 + q; rows[q] = same_seq(r0, r2) ? *(const v4u*)(P + (size_t)r2 * NIN + COL_AX + c0) : (v4u){0u, 0u, 0u, 0u}; }
#pragma unroll
        for (int t = 0; t < 16; ++t) { float acc[8] = {0.f, 0.f, 0.f, 0.f, 0.f, 0.f, 0.f, 0.f};
#pragma unroll
            for (int k = 0; k < 4; ++k) { const v4u pw = rows[t + k];
                acc[0] += wk[k][0] * bflo(pw.x); acc[1] += wk[k][1] * bfhi(pw.x); acc[2] += wk[k][2] * bflo(pw.y); acc[3] += wk[k][3] * bfhi(pw.y);
                acc[4] += wk[k][4] * bflo(pw.z); acc[5] += wk[k][5] * bfhi(pw.z); acc[6] += wk[k][6] * bflo(pw.w); acc[7] += wk[k][7] * bfhi(pw.w); }
            v4u o; o.x = pk2(acc[0], acc[1]); o.y = pk2(acc[2], acc[3]); o.z = pk2(acc[4], acc[5]); o.w = pk2(acc[6], acc[7]);
            *(v4u*)(XA + ((size_t)(c0 >> 8) * MROWS + r0 + t) * 256 + (c0 & 255)) = o; } }
}
__device__ __forceinline__ void prep_qkv(const Frame& F_, const Args& A, int layer) {
    const Frame F = fresh(F_);
    const bf16* P = WSP(bf16, WS_P); bf16* QN = WSP(bf16, WS_QN); bf16* KN = WSP(bf16, WS_KN); bf16* VN = WSP(bf16, WS_VN);
    const float* qg = inp(A, I_QN) + layer * 128; const float* kg = inp(A, I_KN) + layer * 128;
    const int d0 = (F.lane & 15) * 8, hl = F.lane >> 4;
    float gq[8], gk[8];
#pragma unroll
    for (int j = 0; j < 8; ++j) { gq[j] = qg[d0 + j]; gk[j] = kg[d0 + j]; }
    for (int r = F.gw; r < MROWS; r += F.ngw) { const bf16* pr = P + (size_t)r * NIN;
        float cs[4], sn[4]; const bool lat = r >= CTXL;
        if (lat) { const int s = r - CTXL, prow = s >> 6, pcol = s & 63;
#pragma unroll
            for (int j = 0; j < 4; ++j) { const int p = (d0 >> 1) + j;
                const float inv = exp2f(-(float)(p & 31) * (13.287712379549449f / 32.0f));
                const float ang = (float)((p < 32) ? prow : pcol) * inv; sincosf(ang, &sn[j], &cs[j]); } }
#pragma unroll
        for (int i = 0; i < 4; ++i) { const bool isq = i < 3; const int head = isq ? (hl + 4 * i) : hl;
            const bf16* src = pr + (isq ? (COL_CQ + head * 128) : (COL_CK + head * 128)) + d0;
            const v4u w = *(const v4u*)src; float v[8] = {bflo(w.x), bfhi(w.x), bflo(w.y), bfhi(w.y), bflo(w.z), bfhi(w.z), bflo(w.w), bfhi(w.w)};
            float ss = 0.f;
#pragma unroll
            for (int j = 0; j < 8; ++j) ss += v[j] * v[j];
            ss += swz_xor<1>(ss); ss += swz_xor<2>(ss); ss += swz_xor<4>(ss); ss += swz_xor<8>(ss);
            const float rms = rsqrtf(ss * (1.0f / 128.0f) + EPSN);
#pragma unroll
            for (int j = 0; j < 8; ++j) v[j] = v[j] * rms * (isq ? gq[j] : gk[j]);
            if (lat) {
#pragma unroll
                for (int j = 0; j < 4; ++j) { const float t0 = v[2 * j], t1 = v[2 * j + 1]; v[2 * j] = t0 * cs[j] - t1 * sn[j]; v[2 * j + 1] = t0 * sn[j] + t1 * cs[j]; } }
            v4u o; o.x = pk2(v[0], v[1]); o.y = pk2(v[2], v[3]); o.z = pk2(v[4], v[5]); o.w = pk2(v[6], v[7]);
            if (isq) *(v4u*)(QN + (size_t)r * WMIX + head * 128 + d0) = o; else *(v4u*)(KN + (size_t)r * KVW + head * 128 + d0) = o; }
        *(v4u*)(VN + (size_t)r * KVW + F.lane * 8) = *(const v4u*)(pr + COL_CV + F.lane * 8); }
}
__device__ __forceinline__ void prep_hyena_t(const Frame& F_, const Args& A, int layer) {
    const Frame F = fresh(F_);
    const bf16* P = WSP(bf16, WS_P); float* VT = WSP(float, WS_VT); const float* w = inp(A, I_HCONV) + (size_t)layer * 3 * (3 * WMIX);
    LAS float* scr = (LAS float*)(F.lds + F.wave * WSCR_BYTES);
    constexpr int NCB = 3 * WMIX / 64;
    for (int u = F.gw; u < (SEQ / 64) * NCB; u += F.ngw) { const int tb = u / NCB, cb = u - tb * NCB, t0 = tb * 64, c0 = cb * 64;
#pragma unroll
        for (int ps = 0; ps < 9; ++ps) { const int rr = ps * 8 + (F.lane >> 3), cc = (F.lane & 7) * 8; if (rr < 66) { const int t = t0 - 1 + rr; v4u pw = {0u, 0u, 0u, 0u};
                if (t >= 0 && t < SEQ) pw = *(const v4u*)(P + (size_t)(t + CTXL) * NIN + COL_B + c0 + cc);
                LAS float* d = scr + rr * 65 + cc; d[0] = bflo(pw.x); d[1] = bfhi(pw.x); d[2] = bflo(pw.y); d[3] = bfhi(pw.y); d[4] = bflo(pw.z); d[5] = bfhi(pw.z); d[6] = bflo(pw.w); d[7] = bfhi(pw.w); } }
        LDS_WAIT(); asm volatile("" ::: "memory");
        { const int part = c0 / WMIX, pr0 = (c0 - part * WMIX) >> 1; unsigned* dst = (unsigned*)VT + ((size_t)part * (WMIX / 2) + pr0) * SEQ + t0 + F.lane;
          for (int c = 0; c < 64; c += 2) { const int ch = c0 + c; f32x2 o;
              o.x = w[ch] * scr[F.lane * 65 + c] + w[3 * WMIX + ch] * scr[(F.lane + 1) * 65 + c] + w[2 * 3 * WMIX + ch] * scr[(F.lane + 2) * 65 + c];
              o.y = w[ch + 1] * scr[F.lane * 65 + c + 1] + w[3 * WMIX + ch + 1] * scr[(F.lane + 1) * 65 + c + 1] + w[2 * 3 * WMIX + ch + 1] * scr[(F.lane + 2) * 65 + c + 1];
              dst[(size_t)(c >> 1) * SEQ] = pk2(o.x, o.y); } }
        LDS_WAIT(); asm volatile("" ::: "memory"); }
}
__device__ __forceinline__ void prep_hyena_ctx(const Frame& F_, const Args& A, int layer) {
    const Frame F = fresh(F_);
    const bf16* P = WSP(bf16, WS_P); float* UC = WSP(float, WS_UC); const float* w = inp(A, I_HCONV) + (size_t)layer * 3 * (3 * WMIX);
    for (int it = F.bid * 512 + F.tid; it < CTXL * 3 * WMIX; it += F.G * 512) { const int t = it / (3 * WMIX), ch = it - t * (3 * WMIX);
        float v = w[3 * WMIX + ch] * bf1(P[(size_t)t * NIN + COL_B + ch]);
        if (t > 0) v += w[ch] * bf1(P[(size_t)(t - 1) * NIN + COL_B + ch]);
        if (t < CTXL - 1) v += w[2 * 3 * WMIX + ch] * bf1(P[(size_t)(t + 1) * NIN + COL_B + ch]);
        const int part = ch / WMIX, c = ch - part * WMIX; UC[((size_t)part * CTXL + t) * WMIX + c] = v; }
}
__device__ __forceinline__ void filt_mlp(const Frame& F_, const Args& A, int layer, bool with_ctx) {
    const Frame F = fresh(F_);
    float* H2 = WSP(float, WS_H2); float* H2C = WSP(float, WS_H2C);
    const float* fw1 = inp(A, I_HFW1) + (size_t)layer * 33 * 64; const float* fb1 = inp(A, I_HFB1) + layer * 64; const float* fr = inp(A, I_HFREQ) + layer * 64;
    const float* fw2 = inp(A, I_HFW2) + (size_t)layer * 64 * 64; const float* fb2 = inp(A, I_HFB2) + layer * 64;
    const int j = F.lane; const float frj = fr[j], b1 = fb1[j], b2 = fb2[j];
    const int total = SEQ + (with_ctx ? CTXL : 0);
    for (int u = F.gw; u < total; u += F.ngw) { const bool isc = u >= SEQ; const int t = isc ? u - SEQ : u, L = isc ? CTXL : SEQ;
        const float tl = (float)t / (float)(L - 1);
        const int b = j & 15; const float band = 1e-4f + (float)b * ((15.0f - 1e-4f) / 15.0f);
        const float ang = (6.283185307179586f / (float)L) * (float)t * band; float sn, cs; sincosf(ang, &sn, &cs); const float zc = cs, zs = -sn;
        float pre = b1 + tl * fw1[j];
#pragma unroll
        for (int i = 0; i < 16; ++i) { pre += lane_bcast(zc, i) * fw1[(1 + i) * 64 + j]; pre += lane_bcast(zs, i) * fw1[(17 + i) * 64 + j]; }
        const float h1 = sinf(frj * pre);
        float pre2 = b2;
#pragma unroll 16
        for (int i = 0; i < 64; ++i) pre2 += lane_bcast(h1, i) * fw2[i * 64 + j];
        const float h2 = sinf(frj * pre2);
        (isc ? H2C : H2)[(size_t)t * 64 + j] = h2; }
}
__device__ __forceinline__ float hy_delta(int c) {
    const float d0 = -4.605170185988091f / 1.5f, d1 = -4.605170185988091f / 0.3f; return d0 + (float)c * ((d1 - d0) / 1535.0f);
}
__device__ __forceinline__ void filt_taps_unit(const Frame& F_, const Args& A, int layer, int u) {
    const Frame F = fresh(F_);
    const float* H2 = WSP(float, WS_H2); float* KT = WSP(float, WS_KT); const float* fw3 = inp(A, I_HFW3) + (size_t)layer * 64 * 6144;
    LAS float* Wl = (LAS float*)F.lds;
    { const int cg = u >> 4, tsb = u & 15, t = tsb * 512 + F.tid;
        __syncthreads();
#pragma unroll 1
        for (int i = 0; i < 12; ++i) { const int e = F.tid + 512 * i, j = e / 96, rem = e - j * 96, od = rem / 24, cl = rem - od * 24;
            Wl[(cl * 4 + od) * 64 + j] = fw3[(size_t)j * 6144 + od * WMIX + cg * 24 + cl]; }
        f32x4 h2[16];
#pragma unroll
        for (int i = 0; i < 16; ++i) h2[i] = *(const f32x4*)(H2 + (size_t)t * 64 + 4 * i);
        __syncthreads();
        const float tl = (float)t / (float)(SEQ - 1);
#pragma unroll 1
        for (int cp = 0; cp < 12; ++cp) { float acc[8];
#pragma unroll
            for (int q = 0; q < 8; ++q) { const LAS f32x4* wp = (const LAS f32x4*)(Wl + (cp * 8 + q) * 64); f32x4 a = {0.f, 0.f, 0.f, 0.f};
#pragma unroll
                for (int i = 0; i < 16; ++i) { a += h2[i] * wp[i]; if ((i & 3) == 3) asm volatile("" ::: "memory"); }
                acc[q] = (a.x + a.y) + (a.z + a.w); asm volatile("" : "+v"(acc[q]) :: "memory"); }
            const int c = cg * 24 + 2 * cp; const float d0 = __expf(tl * hy_delta(c)), d1 = __expf(tl * hy_delta(c + 1));
#pragma unroll
            for (int o = 0; o < 2; ++o) { f32x2* kt = (f32x2*)KT + ((size_t)o * (WMIX / 2) + (c >> 1)) * FFTN;
                const f32x2 hf = {acc[o * 2] * d0, acc[4 + o * 2] * d1}, hb = {acc[o * 2 + 1] * d0, acc[4 + o * 2 + 1] * d1};
                if (t == 0) { kt[0] = hf + hb; kt[SEQ] = (f32x2){0.f, 0.f}; } else { kt[t] = hf; kt[FFTN - t] = hb; } } }
    }
    __syncthreads();
}
__device__ __forceinline__ void filt_taps_ctx(const Frame& F_, const Args& A, int layer) {
    const Frame F = fresh(F_);
    const float* H2C = WSP(float, WS_H2C); float* KC = WSP(float, WS_KC); const float* fw3 = inp(A, I_HFW3) + (size_t)layer * 64 * 6144;
    for (int u = F.gw; u < CTXL * 48; u += F.ngw) { const int t = u / 48, oc = (u - t * 48) * 64 + F.lane, o = oc / WMIX, c = oc - o * WMIX;
        const float hrow = H2C[t * 64 + F.lane];
        const float* wf = fw3 + o * 2 * WMIX + c; float hf = 0.f, hb = 0.f;
#pragma unroll 32
        for (int j = 0; j < 64; ++j) { const float h = lane_bcast(hrow, j); hf += h * wf[(size_t)j * 6144]; hb += h * wf[(size_t)j * 6144 + WMIX]; }
        const float dec = __expf(((float)t / (float)(CTXL - 1)) * hy_delta(c)); hf *= dec; hb *= dec;
        float* kc = KC + (size_t)o * 512 * WMIX + c;
        if (t == 0) kc[(size_t)255 * WMIX] = hf + hb; else { kc[(size_t)(255 + t) * WMIX] = hf; kc[(size_t)(255 - t) * WMIX] = hb; } }
}
__device__ __forceinline__ void filt_norm_ctx(const Frame& F_, const Args& A) {
    const Frame F = fresh(F_);
    const float* KC = WSP(float, WS_KC); float* KCN = WSP(float, WS_KCN); LAS float* red = (LAS float*)F.lds;
    for (int u = F.bid; u < 48; u += F.G) { const int o = u / 24, c = (u - o * 24) * 64 + F.lane; const float* kc = KC + (size_t)o * 512 * WMIX + c; float s = 0.f;
#pragma unroll 16
        for (int i = 0; i < 64; ++i) { const int l = F.wave + 8 * i; const float k = (l < 511) ? kc[(size_t)l * WMIX] : 0.f; s += k * k; }
        __syncthreads(); red[F.wave * 64 + F.lane] = s; __syncthreads();
        if (F.wave == 0) { float t = 0.f;
#pragma unroll
            for (int w = 0; w < 8; ++w) t += red[w * 64 + F.lane];
            KCN[o * WMIX + c] = rsqrtf(t + EPSN); }
    }
    __syncthreads();
}

#define DFT_BF0(A_, B_) do { const f32x2 a_ = (A_), t_ = (B_); (A_) = a_ + t_; (B_) = a_ - t_; } while (0)
#define DFT_BF8(A_, B_) do { const f32x2 a_ = (A_), b_ = (B_); const f32x2 t_ = {b_.y, -b_.x}; (A_) = a_ + t_; (B_) = a_ - t_; } while (0)
#define DFT_BFW(A_, B_, C_, S_) do { const f32x2 a_ = (A_), b_ = (B_); const f32x2 t_ = {b_.x * (C_) - b_.y * (S_), b_.x * (S_) + b_.y * (C_)}; (A_) = a_ + t_; (B_) = a_ - t_; } while (0)
template <int OFF> __device__ __forceinline__ void dft32(f32x2 (&v)[32]) {
    { const f32x2 t = v[OFF + 1]; v[OFF + 1] = v[OFF + 16]; v[OFF + 16] = t; }
    { const f32x2 t = v[OFF + 2]; v[OFF + 2] = v[OFF + 8]; v[OFF + 8] = t; }
    { const f32x2 t = v[OFF + 3]; v[OFF + 3] = v[OFF + 24]; v[OFF + 24] = t; }
    { const f32x2 t = v[OFF + 5]; v[OFF + 5] = v[OFF + 20]; v[OFF + 20] = t; }
    { const f32x2 t = v[OFF + 6]; v[OFF + 6] = v[OFF + 12]; v[OFF + 12] = t; }
    { const f32x2 t = v[OFF + 7]; v[OFF + 7] = v[OFF + 28]; v[OFF + 28] = t; }
    { const f32x2 t = v[OFF + 9]; v[OFF + 9] = v[OFF + 18]; v[OFF + 18] = t; }
    { const f32x2 t = v[OFF + 11]; v[OFF + 11] = v[OFF + 26]; v[OFF + 26] = t; }
    { const f32x2 t = v[OFF + 13]; v[OFF + 13] = v[OFF + 22]; v[OFF + 22] = t; }
    { const f32x2 t = v[OFF + 15]; v[OFF + 15] = v[OFF + 30]; v[OFF + 30] = t; }
    { const f32x2 t = v[OFF + 19]; v[OFF + 19] = v[OFF + 25]; v[OFF + 25] = t; }
    { const f32x2 t = v[OFF + 23]; v[OFF + 23] = v[OFF + 29]; v[OFF + 29] = t; }
    DFT_BF0(v[OFF + 0], v[OFF + 1]);
    DFT_BF0(v[OFF + 2], v[OFF + 3]);
    DFT_BF0(v[OFF + 4], v[OFF + 5]);
    DFT_BF0(v[OFF + 6], v[OFF + 7]);
    DFT_BF0(v[OFF + 8], v[OFF + 9]);
    DFT_BF0(v[OFF + 10], v[OFF + 11]);
    DFT_BF0(v[OFF + 12], v[OFF + 13]);
    DFT_BF0(v[OFF + 14], v[OFF + 15]);
    DFT_BF0(v[OFF + 16], v[OFF + 17]);
    DFT_BF0(v[OFF + 18], v[OFF + 19]);
    DFT_BF0(v[OFF + 20], v[OFF + 21]);
    DFT_BF0(v[OFF + 22], v[OFF + 23]);
    DFT_BF0(v[OFF + 24], v[OFF + 25]);
    DFT_BF0(v[OFF + 26], v[OFF + 27]);
    DFT_BF0(v[OFF + 28], v[OFF + 29]);
    DFT_BF0(v[OFF + 30], v[OFF + 31]);
    DFT_BF0(v[OFF + 0], v[OFF + 2]);
    DFT_BF8(v[OFF + 1], v[OFF + 3]);
    DFT_BF0(v[OFF + 4], v[OFF + 6]);
    DFT_BF8(v[OFF + 5], v[OFF + 7]);
    DFT_BF0(v[OFF + 8], v[OFF + 10]);
    DFT_BF8(v[OFF + 9], v[OFF + 11]);
    DFT_BF0(v[OFF + 12], v[OFF + 14]);
    DFT_BF8(v[OFF + 13], v[OFF + 15]);
    DFT_BF0(v[OFF + 16], v[OFF + 18]);
    DFT_BF8(v[OFF + 17], v[OFF + 19]);
    DFT_BF0(v[OFF + 20], v[OFF + 22]);
    DFT_BF8(v[OFF + 21], v[OFF + 23]);
    DFT_BF0(v[OFF + 24], v[OFF + 26]);
    DFT_BF8(v[OFF + 25], v[OFF + 27]);
    DFT_BF0(v[OFF + 28], v[OFF + 30]);
    DFT_BF8(v[OFF + 29], v[OFF + 31]);
    DFT_BF0(v[OFF + 0], v[OFF + 4]);
    DFT_BFW(v[OFF + 1], v[OFF + 5], 0.70710678118654757f, -0.70710678118654746f);
    DFT_BF8(v[OFF + 2], v[OFF + 6]);
    DFT_BFW(v[OFF + 3], v[OFF + 7], -0.70710678118654746f, -0.70710678118654757f);
    DFT_BF0(v[OFF + 8], v[OFF + 12]);
    DFT_BFW(v[OFF + 9], v[OFF + 13], 0.70710678118654757f, -0.70710678118654746f);
    DFT_BF8(v[OFF + 10], v[OFF + 14]);
    DFT_BFW(v[OFF + 11], v[OFF + 15], -0.70710678118654746f, -0.70710678118654757f);
    DFT_BF0(v[OFF + 16], v[OFF + 20]);
    DFT_BFW(v[OFF + 17], v[OFF + 21], 0.70710678118654757f, -0.70710678118654746f);
    DFT_BF8(v[OFF + 18], v[OFF + 22]);
    DFT_BFW(v[OFF + 19], v[OFF + 23], -0.70710678118654746f, -0.70710678118654757f);
    DFT_BF0(v[OFF + 24], v[OFF + 28]);
    DFT_BFW(v[OFF + 25], v[OFF + 29], 0.70710678118654757f, -0.70710678118654746f);
    DFT_BF8(v[OFF + 26], v[OFF + 30]);
    DFT_BFW(v[OFF + 27], v[OFF + 31], -0.70710678118654746f, -0.70710678118654757f);
    DFT_BF0(v[OFF + 0], v[OFF + 8]);
    DFT_BFW(v[OFF + 1], v[OFF + 9], 0.92387953251128674f, -0.38268343236508978f);
    DFT_BFW(v[OFF + 2], v[OFF + 10], 0.70710678118654757f, -0.70710678118654746f);
    DFT_BFW(v[OFF + 3], v[OFF + 11], 0.38268343236508984f, -0.92387953251128674f);
    DFT_BF8(v[OFF + 4], v[OFF + 12]);
    DFT_BFW(v[OFF + 5], v[OFF + 13], -0.38268343236508973f, -0.92387953251128674f);
    DFT_BFW(v[OFF + 6], v[OFF + 14], -0.70710678118654746f, -0.70710678118654757f);
    DFT_BFW(v[OFF + 7], v[OFF + 15], -0.92387953251128674f, -0.38268343236508989f);
    DFT_BF0(v[OFF + 16], v[OFF + 24]);
    DFT_BFW(v[OFF + 17], v[OFF + 25], 0.92387953251128674f, -0.38268343236508978f);
    DFT_BFW(v[OFF + 18], v[OFF + 26], 0.70710678118654757f, -0.70710678118654746f);
    DFT_BFW(v[OFF + 19], v[OFF + 27], 0.38268343236508984f, -0.92387953251128674f);
    DFT_BF8(v[OFF + 20], v[OFF + 28]);
    DFT_BFW(v[OFF + 21], v[OFF + 29], -0.38268343236508973f, -0.92387953251128674f);
    DFT_BFW(v[OFF + 22], v[OFF + 30], -0.70710678118654746f, -0.70710678118654757f);
    DFT_BFW(v[OFF + 23], v[OFF + 31], -0.92387953251128674f, -0.38268343236508989f);
    DFT_BF0(v[OFF + 0], v[OFF + 16]);
    DFT_BFW(v[OFF + 1], v[OFF + 17], 0.98078528040323043f, -0.19509032201612825f);
    DFT_BFW(v[OFF + 2], v[OFF + 18], 0.92387953251128674f, -0.38268343236508978f);
    DFT_BFW(v[OFF + 3], v[OFF + 19], 0.83146961230254524f, -0.55557023301960218f);
    DFT_BFW(v[OFF + 4], v[OFF + 20], 0.70710678118654757f, -0.70710678118654746f);
    DFT_BFW(v[OFF + 5], v[OFF + 21], 0.55557023301960229f, -0.83146961230254524f);
    DFT_BFW(v[OFF + 6], v[OFF + 22], 0.38268343236508984f, -0.92387953251128674f);
    DFT_BFW(v[OFF + 7], v[OFF + 23], 0.19509032201612833f, -0.98078528040323043f);
    DFT_BF8(v[OFF + 8], v[OFF + 24]);
    DFT_BFW(v[OFF + 9], v[OFF + 25], -0.19509032201612819f, -0.98078528040323043f);
    DFT_BFW(v[OFF + 10], v[OFF + 26], -0.38268343236508973f, -0.92387953251128674f);
    DFT_BFW(v[OFF + 11], v[OFF + 27], -0.55557023301960196f, -0.83146961230254546f);
    DFT_BFW(v[OFF + 12], v[OFF + 28], -0.70710678118654746f, -0.70710678118654757f);
    DFT_BFW(v[OFF + 13], v[OFF + 29], -0.83146961230254535f, -0.55557023301960218f);
    DFT_BFW(v[OFF + 14], v[OFF + 30], -0.92387953251128674f, -0.38268343236508989f);
    DFT_BFW(v[OFF + 15], v[OFF + 31], -0.98078528040323043f, -0.19509032201612861f);
}
template <int OFF> __device__ __forceinline__ void dft16(f32x2 (&v)[32]) {
    { const f32x2 t = v[OFF + 1]; v[OFF + 1] = v[OFF + 8]; v[OFF + 8] = t; }
    { const f32x2 t = v[OFF + 2]; v[OFF + 2] = v[OFF + 4]; v[OFF + 4] = t; }
    { const f32x2 t = v[OFF + 3]; v[OFF + 3] = v[OFF + 12]; v[OFF + 12] = t; }
    { const f32x2 t = v[OFF + 5]; v[OFF + 5] = v[OFF + 10]; v[OFF + 10] = t; }
    { const f32x2 t = v[OFF + 7]; v[OFF + 7] = v[OFF + 14]; v[OFF + 14] = t; }
    { const f32x2 t = v[OFF + 11]; v[OFF + 11] = v[OFF + 13]; v[OFF + 13] = t; }
    DFT_BF0(v[OFF + 0], v[OFF + 1]);
    DFT_BF0(v[OFF + 2], v[OFF + 3]);
    DFT_BF0(v[OFF + 4], v[OFF + 5]);
    DFT_BF0(v[OFF + 6], v[OFF + 7]);
    DFT_BF0(v[OFF + 8], v[OFF + 9]);
    DFT_BF0(v[OFF + 10], v[OFF + 11]);
    DFT_BF0(v[OFF + 12], v[OFF + 13]);
    DFT_BF0(v[OFF + 14], v[OFF + 15]);
    DFT_BF0(v[OFF + 0], v[OFF + 2]);
    DFT_BF8(v[OFF + 1], v[OFF + 3]);
    DFT_BF0(v[OFF + 4], v[OFF + 6]);
    DFT_BF8(v[OFF + 5], v[OFF + 7]);
    DFT_BF0(v[OFF + 8], v[OFF + 10]);
    DFT_BF8(v[OFF + 9], v[OFF + 11]);
    DFT_BF0(v[OFF + 12], v[OFF + 14]);
    DFT_BF8(v[OFF + 13], v[OFF + 15]);
    DFT_BF0(v[OFF + 0], v[OFF + 4]);
    DFT_BFW(v[OFF + 1], v[OFF + 5], 0.70710678118654757f, -0.70710678118654746f);
    DFT_BF8(v[OFF + 2], v[OFF + 6]);
    DFT_BFW(v[OFF + 3], v[OFF + 7], -0.70710678118654746f, -0.70710678118654757f);
    DFT_BF0(v[OFF + 8], v[OFF + 12]);
    DFT_BFW(v[OFF + 9], v[OFF + 13], 0.70710678118654757f, -0.70710678118654746f);
    DFT_BF8(v[OFF + 10], v[OFF + 14]);
    DFT_BFW(v[OFF + 11], v[OFF + 15], -0.70710678118654746f, -0.70710678118654757f);
    DFT_BF0(v[OFF + 0], v[OFF + 8]);
    DFT_BFW(v[OFF + 1], v[OFF + 9], 0.92387953251128674f, -0.38268343236508978f);
    DFT_BFW(v[OFF + 2], v[OFF + 10], 0.70710678118654757f, -0.70710678118654746f);
    DFT_BFW(v[OFF + 3], v[OFF + 11], 0.38268343236508984f, -0.92387953251128674f);
    DFT_BF8(v[OFF + 4], v[OFF + 12]);
    DFT_BFW(v[OFF + 5], v[OFF + 13], -0.38268343236508973f, -0.92387953251128674f);
    DFT_BFW(v[OFF + 6], v[OFF + 14], -0.70710678118654746f, -0.70710678118654757f);
    DFT_BFW(v[OFF + 7], v[OFF + 15], -0.92387953251128674f, -0.38268343236508989f);
}

__device__ __forceinline__ f32x2 cmul(f32x2 a, f32x2 b) { return (f32x2){a.x * b.x - a.y * b.y, a.x * b.y + a.y * b.x}; }
__device__ __forceinline__ int pidx(int i) { return i + (i >> 5); }
template <int R, int OFF> __device__ __forceinline__ void twiddle_reg(f32x2 (&v)[32], int num, float inv_den) {
    float s, c; __sincosf(-6.283185307179586f * (float)num * inv_den, &s, &c); const f32x2 w = {c, s}; f32x2 wr = w;
#pragma unroll
    for (int r = 1; r < R; ++r) { v[OFF + r] = cmul(v[OFF + r], wr); wr = cmul(wr, w); }
}
template <bool IN_REGS, bool HALF_ZERO, bool OUT_REGS> __device__ __forceinline__ void fft16k(LAS f32x2* Z, f32x2 (&v)[32], int tid) {
    asm volatile("" : "+v"(tid));
    LAS f32x2* Zt = Z + pidx(tid);
    if (!IN_REGS) {
#pragma unroll
        for (int r = 0; r < 32; ++r) v[r] = (HALF_ZERO && r >= 16) ? (f32x2){0.f, 0.f} : Zt[528 * r];
        __syncthreads(); }
    dft32<0>(v);
    { LAS f32x2* Zw = Z + 33 * tid;
#pragma unroll
      for (int q = 0; q < 32; ++q) Zw[q] = v[q]; }
    __syncthreads();
#pragma unroll
    for (int r = 0; r < 32; ++r) v[r] = Zt[528 * r];
    __syncthreads();
    twiddle_reg<32, 0>(v, tid & 31, 1.0f / 1024.0f); dft32<0>(v);
    { LAS f32x2* Zw = Z + (tid >> 5) * 1056 + (tid & 31);
#pragma unroll
      for (int q = 0; q < 32; ++q) Zw[33 * q] = v[q]; }
    __syncthreads();
#pragma unroll
    for (int h = 0; h < 2; ++h)
#pragma unroll
        for (int r = 0; r < 16; ++r) v[h * 16 + r] = Zt[528 * h + 1056 * r];
    __syncthreads();
    twiddle_reg<16, 0>(v, tid, 1.0f / 16384.0f); twiddle_reg<16, 16>(v, tid + 512, 1.0f / 16384.0f); dft16<0>(v); dft16<16>(v);
    if (!OUT_REGS) {
#pragma unroll
        for (int h = 0; h < 2; ++h)
#pragma unroll
            for (int q = 0; q < 16; ++q) Zt[528 * h + 1056 * q] = v[h * 16 + q];
        __syncthreads(); }
}
__device__ __forceinline__ void filt_spectra_unit(const Frame& F_, const Args& A, int u) {
    const Frame F = fresh(F_);
    const float* KT = WSP(float, WS_KT); f32x2* PM = WSP(f32x2, WS_PM); LAS f32x2* Z = (LAS f32x2*)F.lds; LAS float* red = (LAS float*)(F.lds + RED_OFF); constexpr int PMS = 8704;
    { const int o = u / 768, p = u - o * 768;
        const f32x2* kab = (const f32x2*)KT + ((size_t)o * (WMIX / 2) + p) * FFTN + F.tid;
        f32x2 v[32]; float sa = 0.f, sb = 0.f;
#pragma unroll
        for (int r = 0; r < 32; ++r) { v[r] = kab[512 * r]; sa += v[r].x * v[r].x; sb += v[r].y * v[r].y; }
        sa = wave_sum(sa); sb = wave_sum(sb);
        __syncthreads();
        if (F.lane == 0) { red[F.wave * 2] = sa; red[F.wave * 2 + 1] = sb; }
        __syncthreads();
        float ta = 0.f, tb = 0.f;
#pragma unroll
        for (int w = 0; w < 8; ++w) { ta += red[w * 2]; tb += red[w * 2 + 1]; }
        const float na = rsqrtf(ta + EPSN) * 0.5f, nb = rsqrtf(tb + EPSN) * 0.5f;
#pragma unroll
        for (int r = 0; r < 32; ++r) { const float a = v[r].x * na, b = v[r].y * nb; v[r] = (f32x2){a + b, a - b}; }
        fft16k<true, false, false>(Z, v, F.tid);
        f32x4* pm4 = (f32x4*)PM + (size_t)(o * 768 + p) * PMS;
#pragma unroll 4
        for (int i = 0; i < 16; ++i) { const int k = F.tid + 512 * i, km = (FFTN - k) & (FFTN - 1); const f32x2 wk = Z[pidx(k)], wm = Z[pidx(km)];
            pm4[k] = (f32x4){0.5f * (wk.x + wm.x), 0.5f * (wk.y - wm.y), 0.5f * (wk.y + wm.y), -0.5f * (wk.x - wm.x)}; }
        if (F.tid == 0) { const f32x2 wk = Z[pidx(FFTN / 2)]; pm4[FFTN / 2] = (f32x4){wk.x, 0.f, wk.y, 0.f}; }
    }
    __syncthreads();
}
__device__ __forceinline__ void filler(const Frame& F, const Args& A, int kind, int flayer, int base, int j, int nidle, int quota) {
    if (j < 0) return;
    const int total = (kind == 1) ? 1024 : 1536;
#pragma unroll 1
    for (int m = 0; m < quota; ++m) { const int u = base + j + nidle * m; if (u >= total || u >= base + nidle * quota) break;
        if (kind == 1) filt_taps_unit(F, A, flayer, u); else filt_spectra_unit(F, A, u); }
}
__device__ __forceinline__ void hyena_conv_unit(const Frame& F_, const Args& A, int layer, int p) {
    const Frame F = fresh(F_);
    const unsigned* VT2 = WSP(unsigned, WS_VT)  ; unsigned* YBT2 = WSP(unsigned, WS_YBT)  ; const f32x4* PM4 = WSP(f32x4, WS_PM); LAS f32x2* Z = (LAS f32x2*)F.lds; constexpr int PMS = 8704;
    const int tid = F.tid; const float* skip = inp(A, I_HSKIP) + (size_t)layer * 2 * WMIX;
    LAS f32x2* Zt = Z + pidx(tid);
    f32x2 v[32];
    __syncthreads();
    { const unsigned* v0 = VT2 + (size_t)p * SEQ + tid;
#pragma unroll
      for (int r = 0; r < 16; ++r) { const unsigned w = v0[512 * r]; Zt[528 * r] = (f32x2){bflo(w), bfhi(w)}; } }
    __syncthreads();
#pragma unroll 1
    for (int o = 0; o < 2; ++o) {
        const f32x4* pmp = PM4 + (size_t)(o * 768 + p) * PMS;
        f32x4 pm[16];
#pragma unroll
        for (int i = 0; i < 16; ++i) pm[i] = pmp[tid + 512 * i];
        const f32x4 pmh = pmp[FFTN / 2];
        fft16k<false, true, false>(Z, v, tid);
#pragma unroll
        for (int i = 0; i < 16; ++i) { const int k = tid + 512 * i, km = (FFTN - k) & (FFTN - 1); const f32x2 zk = Zt[528 * i], zm = Z[pidx(km)];
            const f32x2 pk = {pm[i].x, pm[i].y}, mk = {pm[i].z, pm[i].w};
            const f32x2 cyk = cmul((f32x2){zk.x, -zk.y}, (f32x2){pk.x, -pk.y}) + cmul(zm, (f32x2){mk.x, -mk.y});
            const f32x2 cym = cmul((f32x2){zm.x, -zm.y}, pk) + cmul(zk, mk);
            Zt[528 * i] = cyk; if (km != k) Z[pidx(km)] = cym; }
        if (tid == 0) { const int k = FFTN / 2; const f32x2 zk = Z[pidx(k)]; const f32x2 pk = {pmh.x, pmh.y}, mk = {pmh.z, pmh.w};
            Z[pidx(k)] = cmul((f32x2){zk.x, -zk.y}, (f32x2){pk.x, -pk.y}) + cmul(zk, (f32x2){mk.x, -mk.y}); }
        __syncthreads();
        const unsigned* gp = VT2 + ((size_t)(o + 1) * (WMIX / 2) + p) * SEQ + tid;
        const unsigned* zp = ((o == 0) ? VT2 : (const unsigned*)YBT2) + (size_t)p * SEQ + tid;
        unsigned gg[16], zz[16];
#pragma unroll
        for (int h = 0; h < 2; ++h)
#pragma unroll
            for (int q = 0; q < 8; ++q) { const int dt = 512 * h + 1024 * q; gg[h * 8 + q] = gp[dt]; zz[h * 8 + q] = zp[dt]; }
        fft16k<false, false, true>(Z, v, tid);
        const float ska = skip[o * WMIX + 2 * p], skb = skip[o * WMIX + 2 * p + 1];
        unsigned* yo = YBT2 + (size_t)p * SEQ + tid;
#pragma unroll
        for (int h = 0; h < 2; ++h)
#pragma unroll
            for (int q = 0; q < 8; ++q) { const f32x2 R = v[h * 16 + q], g = {bflo(gg[h * 8 + q]), bfhi(gg[h * 8 + q])}, z = {bflo(zz[h * 8 + q]), bfhi(zz[h * 8 + q])};
                const f32x2 zn = {g.x * (R.x * (1.0f / FFTN) + ska * z.x), g.y * (-R.y * (1.0f / FFTN) + skb * z.y)};
                const unsigned zw = pk2(zn.x, zn.y); yo[512 * h + 1024 * q] = zw; if (o == 0) Zt[528 * h + 1056 * q] = (f32x2){bflo(zw), bfhi(zw)}; }
        __syncthreads();
    }
}
#ifdef PROBE_FFT
__device__ __forceinline__ void hyena_fft_dummy(const Frame& F_) {
    const Frame F = fresh(F_); LAS f32x2* Z = (LAS f32x2*)F.lds; f32x2 v[32];
    __syncthreads();
#pragma unroll 1
    for (int o = 0; o < 2; ++o) { fft16k<false, true, false>(Z, v, F.tid); fft16k<false, false, true>(Z, v, F.tid);
        if (v[0].x == 123456.789f) Z[0] = v[5];
        __syncthreads(); }
}
#endif
__device__ __forceinline__ void hyena_ctx_unit(const Frame& F_, const Args& A, int layer, int u) {
    const Frame F = fresh(F_);
    const float* UC = WSP(float, WS_UC); const float* KC = WSP(float, WS_KC); const float* KCN = WSP(float, WS_KCN); bf16* YB = WSP(bf16, WS_YB);
    LAS float* zb0 = (LAS float*)F.lds; LAS float* zb1 = zb0 + 256 * 32;
    const int cl = F.tid & 31, tb = F.tid >> 5, c = u * 32 + cl, t0 = tb * 16; const float* skip = inp(A, I_HSKIP) + (size_t)layer * 2 * WMIX;
    float zc[16], g1[16], g2[16];
    __syncthreads();
#pragma unroll
    for (int i = 0; i < 16; ++i) { zc[i] = UC[((size_t)0 * CTXL + t0 + i) * WMIX + c]; g1[i] = UC[((size_t)1 * CTXL + t0 + i) * WMIX + c]; g2[i] = UC[((size_t)2 * CTXL + t0 + i) * WMIX + c]; zb0[(t0 + i) * 32 + cl] = zc[i]; }
    __syncthreads();
#pragma unroll
    for (int o = 0; o < 2; ++o) { const LAS float* zb = o ? zb1 : zb0; const float* kc = KC + (size_t)o * 512 * WMIX + c; float acc[16];
#pragma unroll
        for (int i = 0; i < 16; ++i) acc[i] = 0.f;
#pragma unroll 1
        for (int s0 = 0; s0 < CTXL; s0 += 16) { float w[31]; const float* kb = kc + (size_t)(255 + t0 - s0 - 15) * WMIX;
#pragma unroll
            for (int q = 0; q < 31; ++q) w[q] = kb[(size_t)q * WMIX];
#pragma unroll
            for (int j = 0; j < 16; ++j) { const float zs = zb[(s0 + j) * 32 + cl];
#pragma unroll
                for (int i = 0; i < 16; ++i) acc[i] += w[15 + i - j] * zs; } }
        const float kn = KCN[o * WMIX + c], sk = skip[o * WMIX + c];
#pragma unroll
        for (int i = 0; i < 16; ++i) { const float zn = (o ? g2[i] : g1[i]) * (acc[i] * kn + sk * zc[i]);
            if (o == 0) { zc[i] = zn; zb1[(t0 + i) * 32 + cl] = zn; } else YB[(size_t)(t0 + i) * WMIX + c] = (bf16)f2bf(zn); }
        __syncthreads(); }
}
__device__ __forceinline__ void lru_chunk_agg(const Frame& F_, const Args& A) {
    const Frame F = fresh(F_);
    const unsigned* LAB = WSP(unsigned, WS_LA); float* CA = WSP(float, WS_CA); float* CB = WSP(float, WS_CB);
    for (int u = F.gw; u < NCHUNK * 12; u += F.ngw) { const int chunk = u / 12, rem = u - chunk * 12, dir = rem / 6, c = (rem - dir * 6) * 256 + 4 * F.lane;
        const unsigned* pab = LAB + (((size_t)dir * NCHUNK + chunk) * 6 + (c >> 8)) * 64 * 256 + (c & 255);
        f32x4 Aa = {1.f, 1.f, 1.f, 1.f}, B = {0.f, 0.f, 0.f, 0.f};
#pragma unroll 32
        for (int i = 0; i < 64; ++i) { const int rr = dir ? 63 - i : i; const v4u w = *(const v4u*)(pab + rr * 256);
            const f32x4 a = {__expf(bflo(w.x)), __expf(bflo(w.y)), __expf(bflo(w.z)), __expf(bflo(w.w))}, b = {bfhi(w.x), bfhi(w.y), bfhi(w.z), bfhi(w.w)}; B = a * B + b; Aa = Aa * a; }
        *(f32x4*)(CA + ((size_t)dir * NCHUNK + chunk) * WMIX + c) = Aa; *(f32x4*)(CB + ((size_t)dir * NCHUNK + chunk) * WMIX + c) = B; }
}
__device__ __forceinline__ void lru_carries(const Frame& F_, const Args& A) {
    const Frame F = fresh(F_);
    const float* CA = WSP(float, WS_CA); const float* CB = WSP(float, WS_CB); float* CIN = WSP(float, WS_CIN);
    const int slot = F.bid >> 3; if ((F.bid & 7) != 1 || slot < 4 || slot >= 10) return;
    { const int u = (slot - 4) * 8 + F.wave; const int dir = u / 24, c = (u - dir * 24) * 64 + F.lane; float H = 0.f;
#pragma unroll 1
        for (int i0 = 0; i0 < NCHUNK; i0 += 22) { float ca[22], cb[22];
#pragma unroll
            for (int j = 0; j < 22; ++j) { const int i = i0 + j, chunk = dir ? ((i < 4) ? 3 - i : NCHUNK + 3 - i) : i; const size_t ix = ((size_t)dir * NCHUNK + chunk) * WMIX + c; ca[j] = CA[ix]; cb[j] = CB[ix]; }
#pragma unroll
            for (int j = 0; j < 22; ++j) { const int i = i0 + j, chunk = dir ? ((i < 4) ? 3 - i : NCHUNK + 3 - i) : i; const size_t ix = ((size_t)dir * NCHUNK + chunk) * WMIX + c; CIN[ix] = H; H = ca[j] * H + cb[j]; } } }
}
__device__ __forceinline__ void lru_out(const Frame& F_, const Args& A) {
    const Frame F = fresh(F_);
    const unsigned* LAB = WSP(unsigned, WS_LA); const float* CIN = WSP(float, WS_CIN); const bf16* P = WSP(bf16, WS_P); bf16* YA = WSP(bf16, WS_YA);
    for (int u = F.gw; u < NCHUNK * 12; u += F.ngw) { const int chunk = u / 12, c = (u - chunk * 12) * 128 + 2 * F.lane, base = chunk * 64;
        const unsigned* pf = LAB + (((size_t)chunk) * 6 + (c >> 8)) * 64 * 256 + (c & 255); const unsigned* pr = pf + (size_t)NCHUNK * 6 * 64 * 256;
        f32x2 hf[64]; f32x2 H = *(const f32x2*)(CIN + ((size_t)chunk) * WMIX + c);
#pragma unroll
        for (int i = 0; i < 64; ++i) { const v2u w = *(const v2u*)(pf + i * 256); H = (f32x2){__expf(bflo(w.x)), __expf(bflo(w.y))} * H + (f32x2){bfhi(w.x), bfhi(w.y)}; hf[i] = H; }
        H = *(const f32x2*)(CIN + ((size_t)NCHUNK + chunk) * WMIX + c);
#pragma unroll
        for (int i = 63; i >= 0; --i) { const v2u w = *(const v2u*)(pr + i * 256); H = (f32x2){__expf(bflo(w.x)), __expf(bflo(w.y))} * H + (f32x2){bfhi(w.x), bfhi(w.y)};
            const unsigned gw = *(const unsigned*)(P + (size_t)(base + i) * NIN + COL_AG + c); const f32x2 y = (hf[i] + H) * (f32x2){bflo(gw), bfhi(gw)};
            *(unsigned*)(YA + (size_t)(base + i) * WMIX + c) = pk2(y.x, y.y); } }
}
__device__ __forceinline__ void yb_transpose(const Frame& F_, const Args& A) {
    const Frame F = fresh(F_);
    const float* YBT = WSP(float, WS_YBT); bf16* YB = WSP(bf16, WS_YB); LAS float* scr = (LAS float*)(F.lds + F.wave * WSCR_BYTES);
    for (int u = F.gw; u < (SEQ / 64) * 24; u += F.ngw) { const int tb = u / 24, c0 = (u - tb * 24) * 64, t0 = tb * 64;
#pragma unroll
        for (int i = 0; i < 32; ++i) { const unsigned y = ((const unsigned*)YBT)[(size_t)((c0 >> 1) + i) * SEQ + t0 + F.lane]; scr[(2 * i) * 65 + F.lane] = bflo(y); scr[(2 * i + 1) * 65 + F.lane] = bfhi(y); }
        LDS_WAIT(); asm volatile("" ::: "memory");
#pragma unroll 8
        for (int tt = 0; tt < 64; ++tt) YB[(size_t)(CTXL + t0 + tt) * WMIX + c0 + F.lane] = (bf16)f2bf(scr[F.lane * 65 + tt]);
        LDS_WAIT(); asm volatile("" ::: "memory"); }
}
__device__ __forceinline__ void attn_phase(const Frame& F_, const Args& A, bool with_ctx, char* lds) {
    const Frame F = fresh(F_);
    const att::bf16* QN = WSP(att::bf16, WS_QN); const att::bf16* KN = WSP(att::bf16, WS_KN); const att::bf16* VN = WSP(att::bf16, WS_VN); bf16* YC = WSP(bf16, WS_YC);
    const int x = F.bid & 7, slot = F.bid >> 3, kvh = x >> 1, per = F.G >> 2;
    const int nunits = 3 * (with_ctx ? 33 : 32);
    for (int idx = (x & 1) * (F.G >> 3) + slot; idx < nunits; idx += per) { const int qh = kvh * 3 + idx % 3, qb = idx / 3;
        const int row0 = (qb < 32) ? CTXL + qb * 256 : 0, seq = (qb < 32) ? MROWS : CTXL;
        __syncthreads();
        att::attn_dense_body<att::bf16>(QN + (size_t)row0 * WMIX + qh * 128, KN + kvh * 128, VN + kvh * 128, YC + (size_t)row0 * WMIX + qh * 128, seq, lds, F.tid);
    }
    __syncthreads();
}
#ifndef GEMM_SP2
#define GEMM_SP2 true
#endif
#ifndef GEMM_ALIGN
#define GEMM_ALIGN true
#endif
#ifndef WIN_WGM
#define WIN_WGM 4
#endif
#ifndef KH_CTX
#define KH_CTX 1
#endif
#ifndef KH_LAST
#define KH_LAST 0
#endif
#ifndef WIN_NS
#define WIN_NS 1
#endif
#ifndef UP1_QUOTA
#define UP1_QUOTA 2
#endif
#ifndef WIN_SLABS
#define WIN_SLABS 2
#endif
#ifndef MERGE_ALIGN
#define MERGE_ALIGN GEMM_ALIGN
#endif
#ifndef RESID_ALIGN
#define RESID_ALIGN GEMM_ALIGN
#endif
#ifndef MK_PER_PHASE
#define MK_PER_PHASE 0
#endif
constexpr int PH_PER_LAYER = 15, PH_LAYER0 = 2, PH_FINAL = PH_LAYER0 + DEPTH * PH_PER_LAYER, N_PHASES = PH_FINAL + 1;

__global__ void __launch_bounds__(NWAVES * 64, 2) mk_fwd(Args A) {
    extern __shared__ __attribute__((aligned(16))) unsigned char lds[];
    Frame F;
    F.lds = (LAS unsigned char*)lds; F.ws = (unsigned char*)(GAS unsigned char*)A.ws; F.out = (float*)(GAS float*)A.out;
    F.tid = threadIdx.x; F.lane = F.tid & 63; F.wave = __builtin_amdgcn_readfirstlane((int)threadIdx.x >> 6);
    F.G = gridDim.x; F.bid = blockIdx.x; F.gw = blockIdx.x * NWAVES + F.wave; F.ngw = F.G * NWAVES;
    volatile LAS unsigned* MISC = (volatile LAS unsigned*)(F.lds + MISC_OFF);
    for (int u = F.tid; u < (LDS_BYTES - LDSCTL_OFF) / 4; u += NWAVES * 64) ((LAS unsigned*)(F.lds + LDSCTL_OFF))[u] = 0u;
    __syncthreads();
    gu32* ctl = (gu32*)(F.ws + WS_CTL);
    XcdBarrier bar = xcd_barrier_post((unsigned*)(ctl + CW_BAR), MISC + 8);
    const int lo = A.ph_lo, hi = A.ph_hi;
#define IN(k) (lo <= (k) && (k) < hi)
#ifndef EN_MASK
#define EN_MASK 0xffffffffu
#endif
#define EN(b) ((EN_MASK >> (b)) & 1u)
#ifndef REP_MASK
#define REP_MASK 0u
#endif
#define REPS(b) (((REP_MASK >> (b)) & 1u) ? 2 : 1)
#ifdef PROBE_BAR
#define SEAM(k) do { if (IN(k) && IN((k) + 1)) { xcd_barrier(bar); xcd_barrier(bar); } } while (0)
#else
#define SEAM(k) do { if (IN(k) && IN((k) + 1)) xcd_barrier(bar); } while (0)
#endif
    LAS unsigned char* ring = F.lds + RING_OFF;

    if (EN(0) && IN(0)) { for (int rep_ = 0; rep_ < REPS(0); ++rep_) prologue_a(F, A); filt_mlp(F, A, 0, true); }
    SEAM(0);
    if (EN(1) && IN(1)) { prologue_b(F, A); { const Frame L = fresh(F); for (int u = L.bid; u < 1024; u += L.G) filt_taps_unit(F, A, 0, u); } filt_taps_ctx(F, A, 0); }
    SEAM(1);

    for (int layer = 0; layer < DEPTH; ++layer) {
        const int pb = PH_LAYER0 + layer * PH_PER_LAYER;
        if (!(lo < pb + PH_PER_LAYER && pb < hi)) continue;
        const bool ctx_out = layer < DEPTH - 1;
        const int roff = ctx_out ? 0 : CTXL;
        unsigned char* wb = F.ws + WS_W + (size_t)layer * W_LAYER;
        const float* modL = WSP(float, WS_MOD) + (size_t)(layer * 2 + 0) * NMOD * DM; const float* modC = modL + (size_t)NMOD * DM;
        bf16* U = WSP(bf16, WS_U); bf16* H = WSP(bf16, WS_H); float* X = WSP(float, WS_X); bf16* P = WSP(bf16, WS_P);
        for (int half = 0; half < 2; ++half) {
            const int p0 = pb + (half ? 12 : 0), im = half ? 6 : 0;
            if (EN(2) && IN(p0)) { for (int rep_ = 0; rep_ < REPS(2); ++rep_) { __syncthreads(); norm_phase(F, A, inp(A, half ? I_NF2 : I_NF1) + (size_t)layer * DM, modL, modC, im + 0, im + 1, half ? roff : (layer == 0 ? MROWS : 0));
                if (!half && layer == 0) { const Frame L = fresh(F); for (int u = L.bid; u < 480; u += L.G) filt_spectra_unit(F, A, u); }
                if (half && layer + 1 < DEPTH - 1) filt_taps_ctx(F, A, layer + 1); } }
            SEAM(p0);
            const int hro = half ? roff : 0; const size_t hoff = (size_t)hro * DM;
            if (EN(3) && IN(p0 + 1)) { for (int rep_ = 0; rep_ < REPS(3); ++rep_) { __syncthreads(); pg8::Gemm g{U + hoff, (const bf16*)(wb + (half ? WO_GU2 : WO_GU1)), MROWS - hro, 2 * DFF, DM}; pg8::StaticOrder S; S.init(MROWS - hro, 2 * DFF, F.G, fresh(F).bid);
                pg8::EpiSwiglu E{H + hoff, DFF}; pg8::gemm_phase<pg8::EpiSwiglu, pg8::StaticOrder, GEMM_ALIGN, GEMM_SP2>(ring, g, S, E, fresh(F).tid);
                if (!half) filler(F, A, 2, layer, 480, fresh(F).bid - 32, 224, UP1_QUOTA); else if (layer + 1 < DEPTH) filler(F, A, 1, layer + 1, 960, fresh(F).bid - 32, 224, 1); } }
            SEAM(p0 + 1);
            if (EN(4) && IN(p0 + 2)) for (int rep_ = 0; rep_ < REPS(4); ++rep_) { __syncthreads(); pg8::Gemm g{H + hoff, (const bf16*)(wb + (half ? WO_D2 : WO_D1)), MROWS - hro, DM, DFF}; pg8::StaticOrder S; S.init(MROWS - hro, DM, F.G, fresh(F).bid);
                pg8::EpiResid E{WSP(bf16, WS_M32) + hoff, DM, modL + (im + 2) * DM, (hro ? modL : modC) + (im + 2) * DM, 0.5f}; pg8::gemm_phase<pg8::EpiResid, pg8::StaticOrder, RESID_ALIGN, GEMM_SP2>(ring, g, S, E, fresh(F).tid);
                if (!half) filler(F, A, 2, layer, 928, fresh(F).bid - 16, 240, 2); else if (layer + 1 < DEPTH) filler(F, A, 2, layer + 1, 0, fresh(F).bid - 16, 240, 2); }
            if (half) { SEAM(p0 + 2); continue; }
            SEAM(p0 + 2);
            if (EN(5) && IN(pb + 3)) { for (int rep_ = 0; rep_ < REPS(5); ++rep_) { __syncthreads(); norm_phase(F, A, inp(A, I_NMIX) + (size_t)layer * DM, modL, modC, 3, 4, 0); } }
            SEAM(pb + 3);
            if (EN(6) && IN(pb + 4)) { for (int rep_ = 0; rep_ < REPS(6); ++rep_) { __syncthreads();
                constexpr int NSL = WIN_SLABS, NT_SL = (NIN / 256) / NSL, R_SL = (33 * NT_SL) % 256;
#pragma unroll 1
                for (int sl = 0; sl < NSL; ++sl) { pg8::Gemm g{U, (const bf16*)(wb + WO_IN) + (size_t)sl * (NT_SL * 256) * DM, MROWS, NT_SL * 256, DM}; pg8::StaticOrder S; S.init(MROWS, NT_SL * 256, F.G, fresh(F).bid); S.wgm = WIN_WGM;
                    pg8::EpiWin E{P, NIN, sl * NT_SL}; pg8::gemm_phase<pg8::EpiWin, pg8::StaticOrder, GEMM_ALIGN, GEMM_SP2>(ring, g, S, E, fresh(F).tid); }
                filler(F, A, 2, layer, 1408, fresh(F).bid - R_SL, 256 - R_SL, (168 + 255 - R_SL) / (256 - R_SL)); } }
            SEAM(pb + 4);
            if (EN(7) && IN(pb + 5)) { for (int rep_ = 0; rep_ < REPS(7); ++rep_) { __syncthreads(); prep_lru_conv(F, A, layer); prep_qkv(F, A, layer); prep_hyena_t(F, A, layer); if (ctx_out) { prep_hyena_ctx(F, A, layer); filt_norm_ctx(F, A); } } }
            SEAM(pb + 5);
            if (EN(8) && IN(pb + 6)) { for (int rep_ = 0; rep_ < REPS(8); ++rep_) { __syncthreads(); int klru = 256; asm volatile("" : "+s"(klru));
                pg8::Gemm g{WSP(bf16, WS_XA), (const bf16*)(wb + WO_LRU), 6 * MROWS, 6 * 1024, klru}; pg8::LruOrder S; S.init(F.G, fresh(F).bid);
                pg8::EpiLru E{WSP(float, WS_LA), WSP(float, WS_LB), WSP(bf16, WS_XA), inp(A, I_LBA) + (size_t)layer * 2 * WMIX, inp(A, I_LBX) + (size_t)layer * 2 * WMIX, WSP(float, WS_MOD + 1536 * 1024) + (size_t)layer * 2 * WMIX, MROWS, WSP(float, WS_CA), WSP(float, WS_CB)};
                pg8::gemm_phase<pg8::EpiLru, pg8::LruOrder, GEMM_ALIGN, GEMM_SP2>(ring, g, S, E, fresh(F).tid); } }
            SEAM(pb + 6);
            if (EN(9) && IN(pb + 7)) {   }
            if (EN(10) && IN(pb + 8)) { for (int rep_ = 0; rep_ < REPS(10); ++rep_) { __syncthreads();
                lru_carries(F, A);
                if (EN(17)) for (int r2_ = 0; r2_ < REPS(17); ++r2_) attn_phase(F, A, ctx_out, (char*)lds);
                { const Frame L = fresh(F); const int x = L.bid & 7, slot = L.bid >> 3, nunits = 3 * (ctx_out ? 33 : 32), thr = nunits - 96, KH = ctx_out ? KH_CTX : KH_LAST;
                  const bool light = (x & 1) && slot >= thr; const int nh = 128 + 4 * thr, nl = 4 * (32 - thr), total = 768 + (ctx_out ? 48 : 0);
                  const int hi_ = (x & 1) ? 128 + (x >> 1) * thr + slot : (x >> 1) * 32 + slot, li = (x >> 1) * (32 - thr) + (slot - thr);
                  for (int r2_ = 0; r2_ < REPS(18); ++r2_)
                  for (int m = 0; ; ++m) { int u; if (light) { u = KH * nh + li + nl * m; if (u >= total) break; } else { if (m >= KH) break; u = hi_ + nh * m; if (u >= total) break; }
                      if (u < 768) { if (EN(18)) hyena_conv_unit(F, A, layer, u);
#ifdef PROBE_FFT
                          hyena_fft_dummy(F);
#endif
                      } else { if (EN(19)) hyena_ctx_unit(F, A, layer, u - 768); } } }
            } }
            SEAM(pb + 8);
            if (EN(11) && IN(pb + 9)) { for (int rep_ = 0; rep_ < REPS(11); ++rep_) { __syncthreads(); lru_out(F, A); yb_transpose(F, A); if (layer + 1 < DEPTH) filt_mlp(F, A, layer + 1, layer + 1 < DEPTH - 1); } }
            SEAM(pb + 9);
            if (EN(12) && IN(pb + 10)) { for (int rep_ = 0; rep_ < REPS(12); ++rep_) { __syncthreads(); const bf16* WB = (const bf16*)(wb + WO_BR); float* M32 = WSP(float, WS_M32) + (size_t)roff * DM; pg8::StaticOrder S; S.init(MROWS - roff, DM, F.G, fresh(F).bid);
                const size_t yo = (size_t)roff * WMIX; bf16* Hm = H + (size_t)roff * DM; const bf16* Pg = P + (size_t)roff * NIN + COL_G; const int Mm = MROWS - roff;
                { pg8::Gemm g{WSP(bf16, WS_YA) + yo, WB, Mm, DM, WMIX}; pg8::EpiMerge<0> E{M32, Hm, Pg, NIN}; pg8::gemm_phase<pg8::EpiMerge<0>, pg8::StaticOrder, MERGE_ALIGN, GEMM_SP2>(ring, g, S, E, fresh(F).tid); }
                { pg8::Gemm g{WSP(bf16, WS_YB) + yo, WB + (size_t)DM * WMIX, Mm, DM, WMIX}; pg8::EpiMerge<1> E{M32, Hm, Pg + DM, NIN}; pg8::gemm_phase<pg8::EpiMerge<1>, pg8::StaticOrder, MERGE_ALIGN, GEMM_SP2>(ring, g, S, E, fresh(F).tid); }
                { pg8::Gemm g{WSP(bf16, WS_YC) + yo, WB + (size_t)2 * DM * WMIX, Mm, DM, WMIX}; pg8::EpiMerge<2> E{M32, Hm, Pg + 2 * DM, NIN}; pg8::gemm_phase<pg8::EpiMerge<2>, pg8::StaticOrder, MERGE_ALIGN, GEMM_SP2>(ring, g, S, E, fresh(F).tid); }
                if (layer + 1 < DEPTH) filler(F, A, 1, layer + 1, 0, fresh(F).bid - 16, 240, 2); } }
            SEAM(pb + 10);
            if (EN(13) && IN(pb + 11)) for (int rep_ = 0; rep_ < REPS(13); ++rep_) { __syncthreads(); pg8::Gemm g{H + (size_t)roff * DM, (const bf16*)(wb + WO_OUT), MROWS - roff, DM, DM}; pg8::StaticOrder S; S.init(MROWS - roff, DM, F.G, fresh(F).bid);
                pg8::EpiResid E{WSP(bf16, WS_M32) + (size_t)roff * DM, DM, modL + 5 * DM, (roff ? modL : modC) + 5 * DM, 1.0f}; pg8::gemm_phase<pg8::EpiResid, pg8::StaticOrder, RESID_ALIGN, GEMM_SP2>(ring, g, S, E, fresh(F).tid);
                if (layer + 1 < DEPTH) filler(F, A, 1, layer + 1, 480, fresh(F).bid - 16, 240, 2); }
            SEAM(pb + 11);
        }
    }
#ifdef DUMP
    if (IN(PH_FINAL)) dump_phase(F, A);
#else
    if (EN(14) && IN(PH_FINAL)) final_norm_phase(F, A);
#endif
#undef IN
#undef SEAM
}

extern "C" void kernel_launch(void* const* d_in, const int* in_sizes, int n_in, void* d_out, int out_size, void* d_ws, size_t ws_size, hipStream_t stream) {
    static int grid = 0;
    if (grid == 0) {
        if (n_in != N_IN_TENSORS || in_sizes[0] != SEQ * DM || out_size != SEQ * DM || ws_size < WS_END) {
            fprintf(stderr, "kernel_launch: shape mismatch: n_in %d in0 %d out %d ws %zu (need %zu)\n", n_in, n_in > 0 ? in_sizes[0] : -1, out_size, ws_size, (size_t)WS_END); grid = -1; return; }
        int dev = 0, cus = 0, per_cu = 0;
        if (hipGetDevice(&dev) != hipSuccess || hipDeviceGetAttribute(&cus, hipDeviceAttributeMultiprocessorCount, dev) != hipSuccess) { fprintf(stderr, "kernel_launch: device query failed\n"); grid = -1; return; }
        if (hipFuncSetAttribute((const void*)mk_fwd, hipFuncAttributeMaxDynamicSharedMemorySize, LDS_BYTES) != hipSuccess) { fprintf(stderr, "kernel_launch: hipFuncSetAttribute failed\n"); grid = -1; return; }
        if (hipOccupancyMaxActiveBlocksPerMultiprocessor(&per_cu, (const void*)mk_fwd, NWAVES * 64, LDS_BYTES) != hipSuccess || per_cu < 1)
            fprintf(stderr, "kernel_launch: note: occupancy query reports %d workgroups per CU\n", per_cu);
        (void)hipGetLastError();
        grid = cus;
        if (grid != 256) { fprintf(stderr, "kernel_launch: built for 256 CUs, found %d\n", cus); grid = -1; return; }
    }
    if (grid < 0) return;
    if (hipMemsetAsync((char*)d_ws + WS_CTL, 0, CTL_ZERO_BYTES, stream) != hipSuccess) { fprintf(stderr, "kernel_launch: memset failed\n"); return; }
    Args a{};
    for (int i = 0; i < N_IN_TENSORS; ++i) a.in[i] = (const float*)d_in[i];
    a.out = (float*)d_out; a.ws = (unsigned char*)d_ws;
#if MK_PER_PHASE
#ifndef STOP_PHASE
#define STOP_PHASE PH_FINAL
#endif
    for (int ph = 0; ph < N_PHASES; ++ph) { if (ph >= STOP_PHASE && ph != PH_FINAL) continue; a.ph_lo = ph; a.ph_hi = ph + 1; hipLaunchKernelGGL(mk_fwd, dim3(grid), dim3(NWAVES * 64), LDS_BYTES, stream, a); }
#else
    a.ph_lo = 0; a.ph_hi = N_PHASES; hipLaunchKernelGGL(mk_fwd, dim3(grid), dim3(NWAVES * 64), LDS_BYTES, stream, a);
#endif
    const hipError_t le = hipPeekAtLastError();
    if (le != hipSuccess) fprintf(stderr, "kernel_launch: launch failed: %s\n", hipGetErrorName(le));
}
```

```cpp
#include <hip/hip_runtime.h>
#include <hip/hip_bf16.h>
#include <cstdio>
#include <cstdint>
namespace pg8 {
#define PG8_LAS __attribute__((address_space(3)))
typedef unsigned short bf16_t;
typedef short bf16x8 __attribute__((ext_vector_type(8)));
typedef float f32x4 __attribute__((ext_vector_type(4)));
typedef unsigned u32x4 __attribute__((ext_vector_type(4)));
constexpr int BM = 256, BK = 64, HALF = 128, HTB = HALF * BK * 2  , STAGE_BYTES = 8 * HTB, NXCD = 8, WGM = 8;

__host__ __device__ __forceinline__ int lds_byte(int r, int c) { const int st = (r >> 4) * 2 + (c >> 5), rr = r & 15, cc = c & 31, ob = rr * 64 + cc * 2; return st * 1024 + (ob ^ (((ob >> 9) & 1) << 5)); }
__host__ __device__ __forceinline__ void stage_rc(int b, int& R, int& C) { const int st = b / 1024, sb = b % 1024, swz = sb ^ (((sb >> 9) & 1) << 5); R = (st >> 1) * 16 + swz / 64; C = (st & 1) * 32 + (swz % 64) / 2; }
__host__ __device__ __forceinline__ int perm32(int rho) { const int n = rho >> 4, i = rho & 15; return 8 * (i >> 2) + 4 * n + (i & 3); }

struct Unit { int pm, pn; };
struct Gemm { const bf16_t* A; const bf16_t* Bt; int M, N, K; };

struct StaticOrder {
    int nM, nN, nwg, G, c, wgm = WGM;
    __host__ __device__ void init(int M, int N, int G_, int c_) { nM = M / BM; nN = N / BM; nwg = nM * nN; G = G_; c = c_; }
    __host__ __device__ bool next(int i, Unit& u) const {
        const long L = (long)i * G + c; if (L >= nwg) return false;
        int wgid = (int)L; { const int q = nwg / NXCD, r = nwg % NXCD, xcd = wgid % NXCD, off = wgid / NXCD; wgid = (xcd < r ? xcd * (q + 1) : r * (q + 1) + (xcd - r) * q) + off; }
        const int nig = wgm * nN, gid = wgid / nig, fm = gid * wgm, gsz = (nM - fm) < wgm ? (nM - fm) : wgm;
        u.pm = fm + ((wgid % nig) % gsz); u.pn = (wgid % nig) / gsz; return true;
    }
    __device__ __forceinline__ void a_ready(const Unit&) const {}
    __device__ __forceinline__ void done(const Unit&) const {}
};
struct SplitNOrder {
    int nM, nNs, ns, nwg, G, c, wgm;
    __host__ __device__ void init(int M, int N, int NS, int G_, int c_, int wgm_) { nM = M / BM; ns = NS; nNs = (N / BM) / NS; nwg = nM * nNs * NS; G = G_; c = c_; wgm = wgm_; }
    __host__ __device__ bool next(int i, Unit& u) const {
        const long L = (long)i * G + c; if (L >= nwg) return false;
        int wgid = (int)L; { const int q = nwg / NXCD, r = nwg % NXCD, xcd = wgid % NXCD, off = wgid / NXCD; wgid = (xcd < r ? xcd * (q + 1) : r * (q + 1) + (xcd - r) * q) + off; }
        const int nMv = nM * ns, nig = wgm * nNs, gid = wgid / nig, fm = gid * wgm, gsz = (nMv - fm) < wgm ? (nMv - fm) : wgm;
        const int pv = fm + ((wgid % nig) % gsz), pnl = (wgid % nig) / gsz, slab = pv / nM;
        u.pm = pv - slab * nM; u.pn = slab * nNs + pnl; return true;
    }
    __device__ __forceinline__ void a_ready(const Unit&) const {}
    __device__ __forceinline__ void done(const Unit&) const {}
};
__device__ __forceinline__ unsigned cvt_pk_bf16(float lo, float hi) { unsigned r; asm volatile("v_cvt_pk_bf16_f32 %0, %1, %2" : "=v"(r) : "v"(lo), "v"(hi)); return r; }
typedef float f32x2 __attribute__((ext_vector_type(2)));
template <int MASK> __device__ __forceinline__ float swz_xor(float v) { return __int_as_float(__builtin_amdgcn_ds_swizzle(__float_as_int(v), (MASK << 10) | 0x1f)); }
__device__ __forceinline__ float fast_sigmoid(float x) { return __builtin_amdgcn_rcpf(1.0f + __expf(-x)); }
__device__ __forceinline__ float gelu_tanh(float x) { const float u = 0.7978845608028654f * (x + 0.044715f * x * x * x); return x * fast_sigmoid(2.0f * u); }
__device__ __forceinline__ float bf_lo(unsigned w) { return __uint_as_float(w << 16); }
__device__ __forceinline__ float bf_hi(unsigned w) { return __uint_as_float(w & 0xffff0000u); }

struct EpiSwiglu {
    static constexpr bool PERM = true, AFTER_DRAIN = false;
    bf16_t* O; int ldo;
    __device__ __forceinline__ void operator()(const f32x4 (&acc)[2][2][4][2], const Unit& u, int wr, int wc, int fr, int fq) const {
        const int row0 = u.pm * BM + wr * 64 + fr, col0 = u.pn * HALF + wc * 32 + 8 * fq;
#pragma unroll
        for (int ai = 0; ai < 2; ++ai)
#pragma unroll
            for (int m = 0; m < 4; ++m) { bf16_t* rowp = O + (size_t)(row0 + ai * HALF + m * 16) * ldo + col0;
                float v[8];
#pragma unroll
                for (int n = 0; n < 2; ++n)
#pragma unroll
                    for (int j = 0; j < 4; ++j) { const float a = acc[ai][0][m][n][j], b = acc[ai][1][m][n][j]; v[n * 4 + j] = a * fast_sigmoid(a) * b; }
                u32x4 w; w.x = cvt_pk_bf16(v[0], v[1]); w.y = cvt_pk_bf16(v[2], v[3]); w.z = cvt_pk_bf16(v[4], v[5]); w.w = cvt_pk_bf16(v[6], v[7]);
                *(u32x4*)rowp = w; }
    }
};
struct EpiResid {
    static constexpr bool PERM = true, AFTER_DRAIN = false;
    bf16_t* Dd; int ldd; const float* gate_lat; const float* gate_ctx; float coef;
    __device__ __forceinline__ void operator()(const f32x4 (&acc)[2][2][4][2], const Unit& u, int wr, int wc, int fr, int fq) const {
        const int row0 = u.pm * BM + wr * 64 + fr, col0 = u.pn * BM + wc * 32 + 8 * fq;
        const float* gate = (u.pm == 0) ? gate_ctx : gate_lat;
        f32x4 gv[2][2];
#pragma unroll
        for (int bj = 0; bj < 2; ++bj)
#pragma unroll
            for (int n = 0; n < 2; ++n) gv[bj][n] = *(const f32x4*)(gate + col0 + bj * HALF + 4 * n) * coef;
#pragma unroll
        for (int ai = 0; ai < 2; ++ai)
#pragma unroll
            for (int m = 0; m < 4; ++m) { bf16_t* rowp = Dd + (size_t)(row0 + ai * HALF + m * 16) * ldd + col0;
#pragma unroll
                for (int bj = 0; bj < 2; ++bj) { const f32x4 v0 = gv[bj][0] * acc[ai][bj][m][0], v1 = gv[bj][1] * acc[ai][bj][m][1];
                    u32x4 w; w.x = cvt_pk_bf16(v0[0], v0[1]); w.y = cvt_pk_bf16(v0[2], v0[3]); w.z = cvt_pk_bf16(v1[0], v1[1]); w.w = cvt_pk_bf16(v1[2], v1[3]);
                    *(u32x4*)(rowp + bj * HALF) = w; } }
    }
};
struct EpiWin {
    static constexpr bool PERM = true, AFTER_DRAIN = false;
    bf16_t* O; int ldo; int pn0;
    __device__ __forceinline__ void operator()(const f32x4 (&acc)[2][2][4][2], const Unit& u, int wr, int wc, int fr, int fq) const {
        const int pn = u.pn + pn0, row0 = u.pm * BM + wr * 64 + fr, col0 = pn * BM + wc * 32 + 8 * fq;
        const bool sig = pn >= 40, gel = (pn >= 10 && pn < 16);
        const float kx = sig ? 1.0f : (gel ? 2.0f * 0.7978845608028654f : 0.0f), k3 = gel ? 2.0f * 0.7978845608028654f * 0.044715f : 0.0f, k0 = (sig || gel) ? 0.0f : 80.0f;
#pragma unroll
        for (int ai = 0; ai < 2; ++ai)
#pragma unroll
            for (int m = 0; m < 4; ++m) { bf16_t* rowp = O + (size_t)(row0 + ai * HALF + m * 16) * ldo + col0;
#pragma unroll
                for (int bj = 0; bj < 2; ++bj) { float v[8];
#pragma unroll
                    for (int n = 0; n < 2; ++n)
#pragma unroll
                        for (int j = 0; j < 4; ++j) { const float x = acc[ai][bj][m][n][j]; const float t = k0 + x * (kx + k3 * x * x);
                            const float r = __builtin_amdgcn_rcpf(1.0f + __expf(-t)); v[n * 4 + j] = sig ? r : x * r; }
                    u32x4 w; w.x = cvt_pk_bf16(v[0], v[1]); w.y = cvt_pk_bf16(v[2], v[3]); w.z = cvt_pk_bf16(v[4], v[5]); w.w = cvt_pk_bf16(v[6], v[7]);
                    *(u32x4*)(rowp + bj * HALF) = w; } }
    }
};
struct LruOrder {
    int G, c;
    __host__ __device__ void init(int G_, int c_) { G = G_; c = c_; }
    __host__ __device__ bool next(int i, Unit& u) const { const int L = i * G + c; if (L >= 6 * 33 * 4) return false; const int pmv = L >> 2; u.pm = pmv; u.pn = (pmv / 33) * 4 + (L & 3); return true; }
    __device__ __forceinline__ void a_ready(const Unit&) const {}
    __device__ __forceinline__ void done(const Unit&) const {}
};
struct EpiLru {
    static constexpr bool PERM = true, AFTER_DRAIN = false;
    float* LA; float* LB; const bf16_t* XA; const float* b_a; const float* b_x; const float* lam;
    int M; float* CA; float* CB;
    __device__ __forceinline__ void operator()(const f32x4 (&acc)[2][2][4][2], const Unit& u, int wr, int wc, int fr, int fq) const {
        const int jb = u.pm / 33, pmr = u.pm - jb * 33, pnn = u.pn & 3, d = pnn >> 1, blk = 2 * jb + (pnn & 1);
        const int row0 = pmr * BM + wr * 64 + fr, c0 = blk * HALF + wc * 32 + 8 * fq;
        const float* pba = b_a + d * 1536 + c0; const float* pbx = b_x + d * 1536 + c0; const float* psp = lam + d * 1536 + c0;
#pragma unroll
        for (int ai = 0; ai < 2; ++ai) { float RA[8], RB[8];
#pragma unroll
            for (int m = 0; m < 4; ++m) { const size_t row = (size_t)(row0 + ai * HALF + m * 16);
                const bf16_t* xp = XA + ((size_t)jb * M + row) * 256 + (c0 - 256 * jb);
                unsigned* pab = (unsigned*)LA + ((((size_t)d * (M >> 6) + (row >> 6)) * 6 + (c0 >> 8)) * 64 + (row & 63)) * 256 + (c0 & 255);
#pragma unroll
                for (int n = 0; n < 2; ++n) { const f32x4 ba = *(const f32x4*)(pba + 4 * n), bx = *(const f32x4*)(pbx + 4 * n), sp = *(const f32x4*)(psp + 4 * n);
                    const unsigned long long xw = *(const unsigned long long*)(xp + 4 * n); const unsigned x01 = (unsigned)xw, x23 = (unsigned)(xw >> 32);
                    const float xa[4] = {bf_lo(x01), bf_hi(x01), bf_lo(x23), bf_hi(x23)};
                    u32x4 ab;
#pragma unroll
                    for (int j = 0; j < 4; ++j) {
                        const float r = fast_sigmoid(acc[ai][0][m][n][j] + ba[j]), ig = fast_sigmoid(acc[ai][1][m][n][j] + bx[j]);
                        const float la = -sp[j] * r, x2 = 2.0f * la;
                        const float em = (x2 > -0.5f) ? -x2 * (1.0f + x2 * (0.5f + x2 * (0.16666667f + x2 * (0.041666668f + x2 * (0.0083333338f + x2 * 0.0013888889f))))) : 1.0f - __expf(x2);
                        ab[j] = cvt_pk_bf16(la, sqrtf(fmaxf(em, 0.0f)) * (ig * xa[j])); }
                    *(u32x4*)(pab + 4 * n) = ab;
#pragma unroll
                    for (int j = 0; j < 4; ++j) { float a = __expf(bf_lo(ab[j])), b = bf_hi(ab[j]);
#define LRU_STEP(S_) { const float pa = swz_xor<S_>(a), pb = swz_xor<S_>(b); const bool mine_first = (((fr & S_) == 0) != (d == 1)); b = mine_first ? (pa * b + pb) : (a * pb + b); a = a * pa; }
                        LRU_STEP(1) LRU_STEP(2) LRU_STEP(4) LRU_STEP(8)
#undef LRU_STEP
                        const int e = n * 4 + j;
                        if (m == 0) { RA[e] = a; RB[e] = b; } else { const float f0 = a * RB[e] + b, f1 = RA[e] * b + RB[e]; RB[e] = (d == 0) ? f0 : f1; RA[e] = RA[e] * a; } }
                    asm volatile("" ::: "memory"); }
                asm volatile("" ::: "memory"); }
            { const size_t ci = ((size_t)d * (M >> 6) + ((row0 + ai * HALF) >> 6)) * 1536 + c0;
                *(f32x4*)(CA + ci) = (f32x4){RA[0], RA[1], RA[2], RA[3]}; *(f32x4*)(CA + ci + 4) = (f32x4){RA[4], RA[5], RA[6], RA[7]};
                *(f32x4*)(CB + ci) = (f32x4){RB[0], RB[1], RB[2], RB[3]}; *(f32x4*)(CB + ci + 4) = (f32x4){RB[4], RB[5], RB[6], RB[7]}; } }
    }
};
template <int STEP> struct EpiMerge {
    static constexpr bool PERM = true, AFTER_DRAIN = false;
    float* M32; bf16_t* Mb; const bf16_t* G; int ldg;
    __device__ __forceinline__ void operator()(const f32x4 (&acc)[2][2][4][2], const Unit& u, int wr, int wc, int fr, int fq) const {
        const int row0 = u.pm * BM + wr * 64 + fr, col0 = u.pn * BM + wc * 32 + 8 * fq;
#pragma unroll
        for (int ai = 0; ai < 2; ++ai)
#pragma unroll
            for (int m = 0; m < 4; ++m) { const size_t row = (size_t)(row0 + ai * HALF + m * 16);
#pragma unroll
                for (int bj = 0; bj < 2; ++bj) { const int col = col0 + bj * HALF;
                    const u32x4 gw = *(const u32x4*)(G + row * ldg + col);
                    const float g[8] = {bf_lo(gw.x), bf_hi(gw.x), bf_lo(gw.y), bf_hi(gw.y), bf_lo(gw.z), bf_hi(gw.z), bf_lo(gw.w), bf_hi(gw.w)};
                    float v[8];
#pragma unroll
                    for (int n = 0; n < 2; ++n)
#pragma unroll
                        for (int j = 0; j < 4; ++j) v[n * 4 + j] = g[n * 4 + j] * acc[ai][bj][m][n][j];
                    bf16_t* mp = Mb + row * 4096 + col;
                    if (STEP >= 1) { const u32x4 o = *(const u32x4*)mp;
                        v[0] += bf_lo(o.x); v[1] += bf_hi(o.x); v[2] += bf_lo(o.y); v[3] += bf_hi(o.y); v[4] += bf_lo(o.z); v[5] += bf_hi(o.z); v[6] += bf_lo(o.w); v[7] += bf_hi(o.w); }
                    u32x4 w; w.x = cvt_pk_bf16(v[0], v[1]); w.y = cvt_pk_bf16(v[2], v[3]); w.z = cvt_pk_bf16(v[4], v[5]); w.w = cvt_pk_bf16(v[6], v[7]);
                    *(u32x4*)mp = w;
                    asm volatile("" ::: "memory"); } }
    }
};
template <class Epi, class Sched, bool ALIGN_EPI = false, bool SP2 = false>
__device__ __forceinline__ void gemm_phase(PG8_LAS unsigned char* lds, const Gemm g, const Sched& S, const Epi& E, int tid_in) {
    int tid_ = tid_in; asm volatile("" : "+v"(tid_));
    const int tid = tid_, wid = __builtin_amdgcn_readfirstlane(tid >> 6), lane = tid & 63, wr = wid >> 2, wc = wid & 3, fr = lane & 15, fq = lane >> 4;
    const int K = g.K, nt = K / BK;
    unsigned voffA[2], voffB[2];
#pragma unroll
    for (int i = 0; i < 2; ++i) { int R, C; stage_rc(tid * 16 + i * 8192, R, C); const int Rb = Epi::PERM ? ((R & ~31) + perm32(R & 31)) : R;
        voffA[i] = (unsigned)(R * K + C) * 2u; voffB[i] = (unsigned)(Rb * K + C) * 2u; }
    const size_t kstep = (size_t)(BK * 2);
    const size_t hstep = (size_t)HALF * K * 2;
    const size_t tstep = 2 * hstep;
    const unsigned ldsw = (unsigned)wid * 1024u;
    const int aoff = lds_byte(wr * 64 + fr, fq * 8), boff = lds_byte(wc * 32 + fr, fq * 8);
#define PG8_SA(b, h) (((b) * 2 + (h)) * HTB)
#define PG8_SB(b, h) ((4 + (b) * 2 + (h)) * HTB)
#define PG8_STAGE(bufoff, gbase, voff) do { _Pragma("unroll") for (int _i = 0; _i < 2; ++_i) \
        __builtin_amdgcn_global_load_lds((const unsigned*)((const char*)(gbase) + (voff)[_i]), (PG8_LAS unsigned*)(lds + (bufoff) + ldsw + _i * 8192), 16, 0, 0); } while (0)
#define PG8_LDA(dst, b, h) do { _Pragma("unroll") for (int m = 0; m < 4; ++m) _Pragma("unroll") for (int k = 0; k < 2; ++k) dst[m][k] = *(const PG8_LAS bf16x8*)(lds + PG8_SA(b, h) + aoff + m * 2048 + k * 1024); } while (0)
#define PG8_LDB(dst, b, h) do { _Pragma("unroll") for (int n = 0; n < 2; ++n) _Pragma("unroll") for (int k = 0; k < 2; ++k) dst[n][k] = *(const PG8_LAS bf16x8*)(lds + PG8_SB(b, h) + boff + n * 2048 + k * 1024); } while (0)
#define PG8_MMA(ai, bj, At, Bt) do { __builtin_amdgcn_s_setprio(1); _Pragma("unroll") for (int m = 0; m < 4; ++m) _Pragma("unroll") for (int n = 0; n < 2; ++n) _Pragma("unroll") for (int k = 0; k < 2; ++k) \
        acc[ai][bj][m][n] = __builtin_amdgcn_mfma_f32_16x16x32_bf16(Bt[n][k], At[m][k], acc[ai][bj][m][n], 0, 0, 0); __builtin_amdgcn_s_setprio(0); } while (0)
#define PG8_WAIT_V(n) asm volatile("s_waitcnt vmcnt(" #n ")" ::: "memory")
#define PG8_WAIT_L(n) asm volatile("s_waitcnt lgkmcnt(" #n ")" ::: "memory")
#define PG8_BAR __builtin_amdgcn_s_barrier()
#define PG8_SCHED __builtin_amdgcn_sched_barrier(0)
    Unit cur, nxt; int ui = 0;
    if (!S.next(0, cur)) return;
    f32x4 acc[2][2][4][2];
#pragma unroll
    for (int a = 0; a < 2; ++a)
#pragma unroll
        for (int b = 0; b < 2; ++b)
#pragma unroll
            for (int m = 0; m < 4; ++m)
#pragma unroll
                for (int n = 0; n < 2; ++n) acc[a][b][m][n] = (f32x4){0.f, 0.f, 0.f, 0.f};
    bf16x8 At[4][2], B0[2][2], B1[2][2];
    const char* cA = (const char*)g.A + (size_t)cur.pm * tstep; const char* cB = (const char*)g.Bt + (size_t)cur.pn * tstep;
    S.a_ready(cur);
    if constexpr (SP2) {
        PG8_STAGE(PG8_SB(0, 0), cB, voffB); PG8_STAGE(PG8_SB(0, 1), cB + hstep, voffB); PG8_STAGE(PG8_SA(0, 0), cA, voffA); PG8_STAGE(PG8_SA(0, 1), cA + hstep, voffA);
        if (wr == 1) PG8_BAR;
        PG8_WAIT_V(2); PG8_BAR;
        PG8_STAGE(PG8_SB(1, 0), cB + kstep, voffB); PG8_STAGE(PG8_SA(1, 0), cA + kstep, voffA); PG8_STAGE(PG8_SB(1, 1), cB + hstep + kstep, voffB);
        PG8_WAIT_V(6); PG8_BAR;
    } else {
        PG8_STAGE(PG8_SB(0, 0), cB, voffB); PG8_STAGE(PG8_SA(0, 0), cA, voffA); PG8_STAGE(PG8_SB(0, 1), cB + hstep, voffB); PG8_STAGE(PG8_SA(0, 1), cA + hstep, voffA);
        if (wr == 1) PG8_BAR;
        PG8_WAIT_V(4); PG8_BAR;
        PG8_STAGE(PG8_SB(1, 0), cB + kstep, voffB); PG8_STAGE(PG8_SA(1, 0), cA + kstep, voffA); PG8_STAGE(PG8_SB(1, 1), cB + hstep + kstep, voffB);
        PG8_WAIT_V(6); PG8_BAR;
    }
    for (;;) {
        const bool has_next = S.next(ui + 1, nxt);
        const char* nA = has_next ? (const char*)g.A + (size_t)nxt.pm * tstep : cA; const char* nB = has_next ? (const char*)g.Bt + (size_t)nxt.pn * tstep : cB;
        for (int t = 0; t < nt; t += 2) {
            const bool last = (t == nt - 2);
            const char* a1 = cA + (size_t)(t + 1) * kstep;
            const char* a2 = last ? nA : cA + (size_t)(t + 2) * kstep; const char* b2 = last ? nB : cB + (size_t)(t + 2) * kstep;
            const char* a3 = a2 + kstep; const char* b3 = b2 + kstep;
            if (last && has_next) S.a_ready(nxt);
            if constexpr (SP2) {
            PG8_LDB(B0, 0, 0); PG8_LDB(B1, 0, 1); PG8_SCHED; PG8_LDA(At, 0, 0); PG8_STAGE(PG8_SA(1, 1), a1 + hstep, voffA);
            PG8_WAIT_V(8); PG8_WAIT_L(0); PG8_BAR; PG8_MMA(0, 0, At, B0); PG8_MMA(0, 1, At, B1); PG8_BAR; PG8_SCHED;
            PG8_LDA(At, 0, 1); PG8_STAGE(PG8_SB(0, 0), b2, voffB); PG8_STAGE(PG8_SB(0, 1), b2 + hstep, voffB); PG8_STAGE(PG8_SA(0, 0), a2, voffA);
            PG8_WAIT_V(8); PG8_WAIT_L(0); PG8_BAR; PG8_MMA(1, 0, At, B0); PG8_MMA(1, 1, At, B1); PG8_BAR; PG8_SCHED;
            PG8_LDB(B0, 1, 0); PG8_LDB(B1, 1, 1); PG8_SCHED; PG8_LDA(At, 1, 0); PG8_STAGE(PG8_SA(0, 1), a2 + hstep, voffA);
            PG8_WAIT_V(8); PG8_WAIT_L(0); PG8_BAR; PG8_MMA(0, 0, At, B0); PG8_MMA(0, 1, At, B1); PG8_BAR; PG8_SCHED;
            PG8_LDA(At, 1, 1); PG8_STAGE(PG8_SB(1, 0), b3, voffB); PG8_STAGE(PG8_SB(1, 1), b3 + hstep, voffB); PG8_STAGE(PG8_SA(1, 0), a3, voffA);
            PG8_WAIT_V(8); PG8_WAIT_L(0); PG8_BAR; PG8_MMA(1, 0, At, B0); PG8_MMA(1, 1, At, B1); PG8_BAR; PG8_SCHED;
            } else {
            PG8_LDB(B0, 0, 0); PG8_SCHED; PG8_LDA(At, 0, 0); PG8_STAGE(PG8_SA(1, 1), a1 + hstep, voffA);
            PG8_WAIT_L(8); PG8_BAR; PG8_WAIT_L(0); PG8_MMA(0, 0, At, B0); PG8_BAR; PG8_SCHED;
            PG8_LDB(B1, 0, 1); PG8_STAGE(PG8_SB(0, 0), b2, voffB);
            PG8_BAR; PG8_WAIT_L(0); PG8_MMA(0, 1, At, B1); PG8_BAR;
            PG8_LDA(At, 0, 1); PG8_STAGE(PG8_SA(0, 0), a2, voffA);
            PG8_BAR; PG8_WAIT_L(0); PG8_MMA(1, 0, At, B0); PG8_BAR; PG8_SCHED;
            PG8_STAGE(PG8_SB(0, 1), b2 + hstep, voffB);
            PG8_WAIT_V(6); PG8_BAR; PG8_MMA(1, 1, At, B1); PG8_BAR;
            PG8_LDB(B0, 1, 0); PG8_SCHED; PG8_LDA(At, 1, 0); PG8_STAGE(PG8_SA(0, 1), a2 + hstep, voffA);
            PG8_WAIT_L(8); PG8_BAR; PG8_WAIT_L(0); PG8_MMA(0, 0, At, B0); PG8_BAR; PG8_SCHED;
            PG8_LDB(B1, 1, 1); PG8_STAGE(PG8_SB(1, 0), b3, voffB);
            PG8_BAR; PG8_WAIT_L(0); PG8_MMA(0, 1, At, B1); PG8_BAR;
            PG8_LDA(At, 1, 1); PG8_STAGE(PG8_SA(1, 0), a3, voffA);
            PG8_BAR; PG8_WAIT_L(0); PG8_MMA(1, 0, At, B0); PG8_BAR; PG8_SCHED;
            PG8_STAGE(PG8_SB(1, 1), b3 + hstep, voffB);
            PG8_WAIT_V(6); PG8_BAR; PG8_MMA(1, 1, At, B1); PG8_BAR;
            }
        }
        if constexpr (ALIGN_EPI) { if (wr == 0) PG8_BAR; }
        if constexpr (!Epi::AFTER_DRAIN) { E(acc, cur, wr, wc, fr, fq); S.done(cur); }
        if (!has_next) break;
#pragma unroll
        for (int a = 0; a < 2; ++a)
#pragma unroll
            for (int b = 0; b < 2; ++b)
#pragma unroll
                for (int m = 0; m < 4; ++m)
#pragma unroll
                    for (int n = 0; n < 2; ++n) acc[a][b][m][n] = (f32x4){0.f, 0.f, 0.f, 0.f};
        cur = nxt; cA = nA; cB = nB; ++ui;
        if constexpr (ALIGN_EPI) { if (wr == 1) PG8_BAR; }
    }
    PG8_WAIT_V(0);
    if constexpr (!ALIGN_EPI) { if (wr == 0) PG8_BAR; }
    PG8_BAR;
    if constexpr (Epi::AFTER_DRAIN) { E.fused(acc, cur, wr, wc, fr, fq, lds, wid, lane); S.done(cur); }
#undef PG8_SA
#undef PG8_SB
#undef PG8_STAGE
#undef PG8_LDA
#undef PG8_LDB
#undef PG8_MMA
#undef PG8_WAIT_V
#undef PG8_WAIT_L
#undef PG8_BAR
#undef PG8_SCHED
}
}
namespace att {
using bf16 = __hip_bfloat16;
constexpr int   D = 128, NW = 8, QBLK = 32, KVBLK = 64;
constexpr float SCALE = 0.088388347648318440f;
constexpr float THR = 8.f;
constexpr int SDEPTH = 2;
constexpr int LDQ = 1536, LDK = 512, LDO = 1536;
constexpr size_t SHM_V = KVBLK * D * 2, SHM_K = KVBLK * D * 2, SHM_ATTN = 2 * SHM_V + 2 * SHM_K + NW * 64 * 4;
__device__ __forceinline__ unsigned short f2bf_att(float f) { unsigned u = __builtin_bit_cast(unsigned, f); return (unsigned short)((u + 0x7fffu + ((u >> 16) & 1u)) >> 16); }
using bf16x8 = __attribute__((ext_vector_type(8))) short;
using s16x4  = __attribute__((ext_vector_type(4))) short;
using f32x16 = __attribute__((ext_vector_type(16))) float;
using f32x8  = __attribute__((ext_vector_type(8))) float;
using u32x4  = __attribute__((ext_vector_type(4))) unsigned;
#define KSWZ(row, colB) ((row) * 256 + ((colB) ^ (((row) & 7) << 4)))
#define SBAR() __builtin_amdgcn_sched_barrier(0)
__device__ __forceinline__ int crow(int r, int hi) { return (r & 3) + 8 * (r >> 2) + 4 * hi; }
__device__ __forceinline__ unsigned cvtpk(float lo, float hi) {
  unsigned r; asm volatile("v_cvt_pk_bf16_f32 %0, %1, %2" : "=v"(r) : "v"(lo), "v"(hi)); return r;
}
template <typename TIn> struct Stage;
template <> struct Stage<bf16>  { using T = bf16x8;
  __device__ static __forceinline__ T ld8(const bf16* p) { return *reinterpret_cast<const bf16x8*>(p); }
  __device__ static __forceinline__ bf16x8 tobf(T x) { return x; } };
template <> struct Stage<float> { using T = f32x8;
  __device__ static __forceinline__ T ld8(const float* p) { return *reinterpret_cast<const f32x8*>(p); }
  __device__ static __forceinline__ bf16x8 tobf(T x) {
    u32x4 w = {cvtpk(x[0], x[1]), cvtpk(x[2], x[3]), cvtpk(x[4], x[5]), cvtpk(x[6], x[7])}; return *reinterpret_cast<bf16x8*>(&w); } };

__device__ __forceinline__ void partialSM(f32x16& p0, f32x16& p1, float& m_reg, float& mn, float& alpha) {
  constexpr float C = SCALE * 1.4426950408889634f;
  float pmax = p0[0]; for (int r = 1; r < 16; ++r) pmax = fmaxf(pmax, p0[r]); for (int r = 0; r < 16; ++r) pmax = fmaxf(pmax, p1[r]);
  { auto rr = __builtin_amdgcn_permlane32_swap(__float_as_uint(pmax), __float_as_uint(pmax), false, false);
    pmax = fmaxf(__uint_as_float(rr[0]), __uint_as_float(rr[1])); }
  if (__builtin_expect(__all(pmax - m_reg <= THR / SCALE), 1)) { mn = m_reg; alpha = 1.f; }
  else { mn = fmaxf(m_reg, pmax); alpha = __builtin_amdgcn_exp2f((m_reg - mn) * C); m_reg = mn; }
  float mnC = -mn * C;
  for (int r = 0; r < 16; ++r) p0[r] = fmaf(p0[r], C, mnC); for (int r = 0; r < 16; ++r) p1[r] = fmaf(p1[r], C, mnC);
  for (int r = 0; r < 16; ++r) p0[r] = __builtin_amdgcn_exp2f(p0[r]);
}
__device__ __forceinline__ void finishSM(f32x16& p0, f32x16& p1, float alpha, float& l_reg, bf16x8& pa0, bf16x8& pa1, bf16x8& pa2, bf16x8& pa3) {
  for (int r = 0; r < 16; ++r) p1[r] = __builtin_amdgcn_exp2f(p1[r]);
  float ps = 0; for (int r = 0; r < 16; ++r) ps += p0[r]; for (int r = 0; r < 16; ++r) ps += p1[r];
  { auto rr = __builtin_amdgcn_permlane32_swap(__float_as_uint(ps), __float_as_uint(ps), false, false);
    ps = __uint_as_float(rr[0]) + __uint_as_float(rr[1]); }
  l_reg = l_reg * alpha + ps;
#define PK4(P, BASE, OUT) do { unsigned a0 = cvtpk(P[BASE + 0], P[BASE + 1]), a1 = cvtpk(P[BASE + 2], P[BASE + 3]);   \
    unsigned b0 = cvtpk(P[BASE + 4], P[BASE + 5]), b1 = cvtpk(P[BASE + 6], P[BASE + 7]);                              \
    auto r0 = __builtin_amdgcn_permlane32_swap(a0, b0, false, false); auto r1 = __builtin_amdgcn_permlane32_swap(a1, b1, false, false); \
    u32x4 w = {r0[0], r1[0], r0[1], r1[1]}; OUT = *reinterpret_cast<bf16x8*>(&w); } while (0)
  PK4(p0, 0, pa0); PK4(p0, 8, pa1); PK4(p1, 0, pa2); PK4(p1, 8, pa3);
#undef PK4
}
__device__ __forceinline__ void qkt(f32x16& p0, f32x16& p1, const bf16* Ks, const bf16x8* qr, int r32, int hi) {
  p0 = f32x16{}; p1 = f32x16{};
  for (int d0 = 0; d0 < 8; ++d0) { int cb = (d0 * 16 + hi * 8) * 2;
    bf16x8 b0 = *reinterpret_cast<const bf16x8*>((const char*)Ks + KSWZ(r32, cb));
    bf16x8 b1 = *reinterpret_cast<const bf16x8*>((const char*)Ks + KSWZ(32 + r32, cb));
    p0 = __builtin_amdgcn_mfma_f32_32x32x16_bf16(b0, qr[d0], p0, 0, 0, 0);
    p1 = __builtin_amdgcn_mfma_f32_32x32x16_bf16(b1, qr[d0], p1, 0, 0, 0); }
}
__device__ __forceinline__ int v_st(int k, int c) { const int kk = (k & ~0xC) | ((k & 4) << 1) | ((k & 8) >> 1); return ((kk >> 3) * 4 + (c >> 5)) * 512 + ((kk & 7) * 32 + (c & 31)) * 2; }
__device__ __forceinline__ int v_rd_base(int lane) { return ((lane & 3) << 3) | (((lane >> 2) & 3) << 6) | (((lane >> 4) & 1) << 5) | (((lane >> 5) & 1) << 8); }
constexpr int v_rd_off(int d0, int ks, int half) { return d0 * 512 + ks * 4096 + half * 2048; }
template <int OFF> __device__ __forceinline__ s16x4 tr_read(int vb) {
  s16x4 r; asm volatile("ds_read_b64_tr_b16 %0, %1 offset:%2" : "=&v"(r) : "v"(vb), "i"(OFF) : "memory"); return r;
}
template <int D0> __device__ __forceinline__ void pv_one(f32x16& od, int vb, bf16x8 pa0, bf16x8 pa1, bf16x8 pa2, bf16x8 pa3) {
  const s16x4 l0 = tr_read<v_rd_off(D0, 0, 0)>(vb), h0 = tr_read<v_rd_off(D0, 0, 1)>(vb), l1 = tr_read<v_rd_off(D0, 1, 0)>(vb), h1 = tr_read<v_rd_off(D0, 1, 1)>(vb);
  const s16x4 l2 = tr_read<v_rd_off(D0, 2, 0)>(vb), h2 = tr_read<v_rd_off(D0, 2, 1)>(vb), l3 = tr_read<v_rd_off(D0, 3, 0)>(vb), h3 = tr_read<v_rd_off(D0, 3, 1)>(vb);
  asm volatile("s_waitcnt lgkmcnt(0)" ::: "memory"); SBAR();
#define PK(L, H) (bf16x8){L[0], L[1], L[2], L[3], H[0], H[1], H[2], H[3]}
  od = __builtin_amdgcn_mfma_f32_32x32x16_bf16(pa0, PK(l0, h0), od, 0, 0, 0);
  od = __builtin_amdgcn_mfma_f32_32x32x16_bf16(pa1, PK(l1, h1), od, 0, 0, 0);
  od = __builtin_amdgcn_mfma_f32_32x32x16_bf16(pa2, PK(l2, h2), od, 0, 0, 0);
  od = __builtin_amdgcn_mfma_f32_32x32x16_bf16(pa3, PK(l3, h3), od, 0, 0, 0);
#undef PK
}
__device__ __forceinline__ void pv_d0(f32x16* o, int vb, bf16x8 pa0, bf16x8 pa1, bf16x8 pa2, bf16x8 pa3) {
  pv_one<0>(o[0], vb, pa0, pa1, pa2, pa3); pv_one<1>(o[1], vb, pa0, pa1, pa2, pa3); pv_one<2>(o[2], vb, pa0, pa1, pa2, pa3); pv_one<3>(o[3], vb, pa0, pa1, pa2, pa3);
}

template <typename TQ>
__device__ __forceinline__ void attn_dense_body(const TQ* __restrict__ Qb, const bf16* __restrict__ Kh, const bf16* __restrict__ Vh,
                                                unsigned short* __restrict__ Ob, int seq, char* lds, int tid_in) {
  using St = Stage<bf16>; using SQ = Stage<TQ>;
  int tid_ = tid_in; asm volatile("" : "+v"(tid_));
  const int tid = tid_, wid = tid >> 6, lane = tid & 63, r32 = lane & 31, hi = lane >> 5;
  bf16* V_lds = (bf16*)lds; bf16* K_lds = (bf16*)(lds + 2 * SHM_V);
  float* ws = (float*)(lds + 2 * SHM_V + 2 * SHM_K) + wid * 64; float* li_l = ws; float* al_l = ws + 32;
  float m_reg = -1e30f, l_reg = 0; f32x16 o[4] = {}; bf16x8 qr[8];
  const TQ* Qw = Qb + (long)(wid * QBLK + r32) * LDQ + hi * 8;
#pragma unroll
  for (int d0 = 0; d0 < 8; ++d0) qr[d0] = SQ::tobf(SQ::ld8(Qw + d0 * 16));
  const int sr = tid >> 4, sc = (tid & 15) * 8, vst0 = v_st(sr, sc), vst1 = v_st(32 + sr, sc);
  const int vb0 = (int)(uintptr_t)V_lds + v_rd_base(lane);
  struct { typename St::T vs0, vs1, ks0, ks1; } sr_[SDEPTH];
  const unsigned lo0 = (unsigned)(sr * LDK + sc) * 2u, lo1 = lo0 + 32u * LDK * 2u;
#define SLOAD(i, k0) do { const char* vt_ = (const char*)Vh + (size_t)(k0) * (LDK * 2); const char* kt_ = (const char*)Kh + (size_t)(k0) * (LDK * 2); \
    sr_[i].vs0 = *(const bf16x8*)(vt_ + lo0); sr_[i].vs1 = *(const bf16x8*)(vt_ + lo1); \
    sr_[i].ks0 = *(const bf16x8*)(kt_ + lo0); sr_[i].ks1 = *(const bf16x8*)(kt_ + lo1); } while (0)
#define SWRITE(b, i) do { *(bf16x8*)((char*)V_lds + (b) * SHM_V + vst0) = St::tobf(sr_[i].vs0);          \
    *(bf16x8*)((char*)V_lds + (b) * SHM_V + vst1) = St::tobf(sr_[i].vs1); int kc = sc * 2;               \
    *(bf16x8*)((char*)K_lds + (b) * SHM_K + KSWZ(sr, kc)) = St::tobf(sr_[i].ks0);                       \
    *(bf16x8*)((char*)K_lds + (b) * SHM_K + KSWZ(32 + sr, kc)) = St::tobf(sr_[i].ks1); } while (0)
#define SWAIT() do { if constexpr (SDEPTH == 2) asm volatile("s_waitcnt vmcnt(4)" ::: "memory"); else asm volatile("s_waitcnt vmcnt(0)" ::: "memory"); } while (0)
#define RESC(a) do { if (__any((a) < 1.f)) { if (hi == 0) al_l[r32] = (a); asm volatile("s_waitcnt lgkmcnt(0)" ::: "memory"); \
    for (int d = 0; d < 4; ++d) for (int r = 0; r < 16; ++r) o[d][r] *= al_l[crow(r, hi)]; } } while (0)
  f32x16 pA0, pA1, pB0, pB1; float mnA, mnB, alA, alB; bf16x8 pa0, pa1, pa2, pa3; const int NT = seq / KVBLK;
  constexpr int SE = 0, SO = SDEPTH - 1;
  SLOAD(SE, 0); asm volatile("s_waitcnt vmcnt(0)" ::: "memory"); SWRITE(0, SE); __syncthreads();
  qkt(pA0, pA1, K_lds, qr, r32, hi); partialSM(pA0, pA1, m_reg, mnA, alA);
  SLOAD(SO, KVBLK); if constexpr (SDEPTH == 2) { if (2 < NT) SLOAD(SE, 2 * KVBLK); }
  SWAIT(); SWRITE(1, SO); __syncthreads();
  for (int j = 1; j + 1 < NT; j += 2) {
    SBAR(); qkt(pB0, pB1, (bf16*)((char*)K_lds + SHM_K), qr, r32, hi);
    finishSM(pA0, pA1, alA, l_reg, pa0, pa1, pa2, pa3); SBAR();
    SLOAD(SO, (j + SDEPTH) * KVBLK); SBAR();
    pv_d0(o, vb0, pa0, pa1, pa2, pa3); partialSM(pB0, pB1, m_reg, mnB, alB);
    __syncthreads(); SWAIT(); SWRITE(0, SE);
    RESC(alB); __syncthreads();
    SBAR(); qkt(pA0, pA1, K_lds, qr, r32, hi);
    finishSM(pB0, pB1, alB, l_reg, pa0, pa1, pa2, pa3); SBAR();
    if (SDEPTH == 1 || j + 3 < NT) SLOAD(SE, (j + 1 + SDEPTH) * KVBLK); SBAR();
    pv_d0(o, vb0 + (int)SHM_V, pa0, pa1, pa2, pa3); partialSM(pA0, pA1, m_reg, mnA, alA);
    __syncthreads(); SWAIT(); SWRITE(1, SO);
    RESC(alA); __syncthreads();
  }
  SBAR(); qkt(pB0, pB1, (bf16*)((char*)K_lds + SHM_K), qr, r32, hi);
  finishSM(pA0, pA1, alA, l_reg, pa0, pa1, pa2, pa3); SBAR();
  pv_d0(o, vb0, pa0, pa1, pa2, pa3); partialSM(pB0, pB1, m_reg, mnB, alB);
  __syncthreads(); RESC(alB);
  finishSM(pB0, pB1, alB, l_reg, pa0, pa1, pa2, pa3); SBAR();
  pv_d0(o, vb0 + (int)SHM_V, pa0, pa1, pa2, pa3);
  if (hi == 0) li_l[r32] = l_reg; asm volatile("s_waitcnt lgkmcnt(0)" ::: "memory");
  float rli[16];
#pragma unroll
  for (int r = 0; r < 16; ++r) rli[r] = __builtin_amdgcn_rcpf(li_l[crow(r, hi)]);
  unsigned short* Ow = Ob + (long)(wid * QBLK) * LDO;
#pragma unroll
  for (int r = 0; r < 16; ++r) { int orow = crow(r, hi);
    for (int d0 = 0; d0 < 4; ++d0) Ow[(long)orow * LDO + d0 * 32 + r32] = f2bf_att(o[d0][r] * rli[r]); }
#undef SLOAD
#undef SWRITE
#undef SWAIT
#undef RESC
}

#undef KSWZ
#undef SBAR
}
constexpr int NWAVES = 8;
constexpr int DM = 4096, SEQ = 8192, CTXL = 256, MROWS = SEQ + CTXL, DEPTH = 4;
constexpr int WMIX = 1536, KVW = 512, NIN = 22528, DFF = 4096, MODR = 256, NMOD = 9;
constexpr int COL_AX = 0, COL_CK = 1536, COL_CV = 2048, COL_AG = 2560, COL_B = 4096, COL_CQ = 8704, COL_G = 10240;
constexpr int NCHUNK = MROWS / 64;
constexpr int FFTN = 16384;
constexpr float EPSN = 1e-6f;
constexpr int N_IN_TENSORS = 36;
enum { I_X = 0, I_C, I_CTX, I_CCTX, I_WMD, I_WMU, I_BMOD, I_NF1, I_NMIX, I_NF2, I_F1IN, I_F1OUT, I_F2IN, I_F2OUT, I_WIN, I_LCONV, I_LWA, I_LBA, I_LWX, I_LBX, I_LLAM,
       I_HCONV, I_HFW1, I_HFB1, I_HFREQ, I_HFW2, I_HFB2, I_HFW3, I_HSKIP, I_QN, I_KN, I_WBA, I_WBB, I_WBC, I_WOUT, I_FNORM };

constexpr size_t MiB = 1u << 20;
constexpr size_t WS_CTL = 0, CTL_ZERO_BYTES = 1 * MiB;
constexpr size_t WS_MOD = 2 * MiB;
constexpr size_t WS_W = 4 * MiB;
constexpr size_t WO_GU1 = 0, WO_D1 = 64 * MiB, WO_GU2 = 96 * MiB, WO_D2 = 160 * MiB, WO_IN = 192 * MiB, WO_BR = 368 * MiB, WO_OUT = 404 * MiB, WO_LRU = 436 * MiB, W_LAYER = 454 * MiB;
constexpr size_t WS_X = WS_W + DEPTH * W_LAYER;
constexpr size_t WS_U = WS_X + 132 * MiB;
constexpr size_t WS_H = WS_U + 66 * MiB;
constexpr size_t WS_P = WS_H + 66 * MiB;
constexpr size_t WS_XA = WS_P + 363 * MiB;
constexpr size_t WS_LA = WS_XA + 25 * MiB;
constexpr size_t WS_LB = WS_LA + 99 * MiB;
constexpr size_t WS_CA = WS_LB + 99 * MiB;
constexpr size_t WS_CB = WS_CA + 2 * MiB;
constexpr size_t WS_CIN = WS_CB + 2 * MiB;
constexpr size_t WS_QN = WS_CIN + 2 * MiB;
constexpr size_t WS_KN = WS_QN + 25 * MiB;
constexpr size_t WS_VN = WS_KN + 9 * MiB;
constexpr size_t WS_YA = WS_VN + 9 * MiB;
constexpr size_t WS_YB = WS_YA + 25 * MiB;
constexpr size_t WS_YC = WS_YB + 25 * MiB;
constexpr size_t WS_M32 = WS_YC + 25 * MiB;
constexpr size_t WS_VT = WS_M32 + 132 * MiB;
constexpr size_t WS_YBT = WS_VT + 144 * MiB;
constexpr size_t WS_KT = WS_YBT + 48 * MiB;
constexpr size_t WS_PM = WS_KT + 192 * MiB;
constexpr size_t WS_H2 = WS_PM + 384 * MiB;
constexpr size_t WS_H2C = WS_H2 + 2 * MiB;
constexpr size_t WS_KC = WS_H2C + 1 * MiB;
constexpr size_t WS_KCN = WS_KC + 6 * MiB;
constexpr size_t WS_UC = WS_KCN + 1 * MiB;
constexpr size_t WS_END = WS_UC + 5 * MiB;
constexpr int CW_TMO = 0, CW_CODE = 1;
constexpr int CW_BAR = 4096;
constexpr int CW_T1 = 16384;

constexpr int RING_OFF = 0, RING_BYTES = 131072;
constexpr int FFT_BYTES = (FFTN + FFTN / 32) * 8;
constexpr int RED_OFF = FFT_BYTES;
constexpr int WSCR_BYTES = 66 * 65 * 4;
constexpr int LDSCTL_OFF = 143360, MISC_OFF = LDSCTL_OFF + 320;
constexpr int LDS_BYTES = 147456;
static_assert(RED_OFF + 1024 <= LDSCTL_OFF && NWAVES * WSCR_BYTES <= LDSCTL_OFF && MISC_OFF + 128 <= LDS_BYTES, "LDS map");

#define GAS __attribute__((address_space(1)))
#define LAS __attribute__((address_space(3)))
typedef unsigned short bf16;
typedef unsigned v4u __attribute__((ext_vector_type(4)));
typedef unsigned v2u __attribute__((ext_vector_type(2)));
typedef float f32x4 __attribute__((ext_vector_type(4)));
typedef float f32x2 __attribute__((ext_vector_type(2)));
typedef GAS unsigned gu32;
#define RLX_AGENT __ATOMIC_RELAXED, __HIP_MEMORY_SCOPE_AGENT
#define LDS_WAIT() asm volatile("s_waitcnt lgkmcnt(0)" ::: "memory")
#define VM_WAIT() asm volatile("s_waitcnt vmcnt(0)" ::: "memory")
__device__ __forceinline__ unsigned f2bf(float f) { unsigned u = __builtin_bit_cast(unsigned, f); return (u + 0x7fffu + ((u >> 16) & 1u)) >> 16; }
__device__ __forceinline__ unsigned pk2(float lo, float hi) { return f2bf(lo) | (f2bf(hi) << 16); }
__device__ __forceinline__ float bflo(unsigned w) { return __uint_as_float(w << 16); }
__device__ __forceinline__ float bfhi(unsigned w) { return __uint_as_float(w & 0xffff0000u); }
__device__ __forceinline__ float bf1(bf16 h) { return __uint_as_float(((unsigned)h) << 16); }
template <int MASK> __device__ __forceinline__ float swz_xor(float v) { return __int_as_float(__builtin_amdgcn_ds_swizzle(__float_as_int(v), (MASK << 10) | 0x1f)); }
__device__ __forceinline__ float lane_bcast(float v, int l) { return __int_as_float(__builtin_amdgcn_readlane(__float_as_int(v), l)); }
__device__ __forceinline__ float wave_sum(float v) {
    v += swz_xor<1>(v); v += swz_xor<2>(v); v += swz_xor<4>(v); v += swz_xor<8>(v); v += swz_xor<16>(v);
    const auto rr = __builtin_amdgcn_permlane32_swap(__float_as_uint(v), __float_as_uint(v), false, false);
    return __uint_as_float(rr[0]) + __uint_as_float(rr[1]);
}
__device__ __forceinline__ float sigmoidf_(float x) { return 1.0f / (1.0f + __expf(-x)); }
#define XB_TMO      128
#define XB_XCNT(j)  (256  + 64 * (j))
#define XB_XSUB(j)  (1280 + 64 * (j))
#define XB_XGEN(j)  (2304 + 64 * (j))
#define XB_TOP      3328
#define XB_TOPGEN   3392
#define XCD_BAR_WORDS 3456
#define XB_SPIN_CAP (1u << 18)

__device__ __forceinline__ unsigned xb_ld(unsigned* p)              { return __hip_atomic_load(p, __ATOMIC_RELAXED, __HIP_MEMORY_SCOPE_AGENT); }
__device__ __forceinline__ unsigned xb_add(unsigned* p, unsigned v) { return __hip_atomic_fetch_add(p, v, __ATOMIC_RELAXED, __HIP_MEMORY_SCOPE_AGENT); }
__device__ __forceinline__ unsigned xb_xcc_id() { return (unsigned)__builtin_amdgcn_s_getreg((3 << 11) | 20) & 0xFu; }
#define XB_SPIN(cond, bar) do { unsigned _sp = 0; while (cond) { __builtin_amdgcn_s_sleep(1); \
    if ((++_sp & 255u) == 0u) { if (xb_ld(&(bar)[XB_TMO])) break; if (_sp > XB_SPIN_CAP) { atomicAdd(&(bar)[XB_TMO], 1u); break; } } } } while (0)

struct XcdBarrier {
    unsigned* bar; unsigned x;
    volatile LAS unsigned* st;
};

__device__ __forceinline__ XcdBarrier xcd_barrier_post(unsigned* bar, volatile LAS unsigned* st) {
    XcdBarrier b; b.bar = bar; b.x = xb_xcc_id(); b.st = st;
    if (threadIdx.x == 0) (void)xb_add(&bar[XB_XCNT(b.x)], 1u);
    return b;
}
__device__ __forceinline__ void xcd_barrier_complete(unsigned* bar, unsigned x, unsigned& nloc, unsigned& nx) {
    const unsigned G = gridDim.x * gridDim.y * gridDim.z;
    unsigned sum, cnt, mine, sp = 0u;
    for (;;) {
        sum = 0u; cnt = 0u; mine = 0u;
#pragma unroll
        for (unsigned j = 0; j < 16; ++j) { const unsigned c = xb_ld(&bar[XB_XCNT(j)]); sum += c; cnt += (c > 0u) ? 1u : 0u; mine = (j == x) ? c : mine; }
        if (sum == G) break;
        __builtin_amdgcn_s_sleep(1);
        if ((++sp & 255u) == 0u) { if (xb_ld(&bar[XB_TMO])) break; if (sp > XB_SPIN_CAP) { atomicAdd(&bar[XB_TMO], 1u); break; } }
    }
    nloc = mine > 0u ? mine : 1u; nx = cnt > 0u ? cnt : 1u;
}

__device__ __forceinline__ void xcd_barrier(const XcdBarrier& b) {
    asm volatile("s_waitcnt vmcnt(0)" ::: "memory");
    __syncthreads();
    if (threadIdx.x == 0) {
        unsigned* bar = b.bar;
        __builtin_amdgcn_s_waitcnt(0);
        unsigned nloc = b.st[0], nx = b.st[1];
        if (nloc == 0u) { xcd_barrier_complete(bar, b.x, nloc, nx); b.st[0] = nloc; b.st[1] = nx; }
        const unsigned old = xb_add(&bar[XB_XSUB(b.x)], 1u);
        const unsigned gen = old / nloc;
        if (old + 1u == (gen + 1u) * nloc) {
            __builtin_amdgcn_fence(__ATOMIC_RELEASE, "agent");
            asm volatile("s_waitcnt vmcnt(0)" ::: "memory");
            const unsigned og = xb_add(&bar[XB_TOP], 1u);
            const unsigned tg = og / nx;
            if (og + 1u == (tg + 1u) * nx) xb_add(&bar[XB_TOPGEN], 1u);
            else XB_SPIN(xb_ld(&bar[XB_TOPGEN]) == tg, bar);
            __builtin_amdgcn_fence(__ATOMIC_ACQUIRE, "agent");
            xb_add(&bar[XB_XGEN(b.x)], 1u);
            asm volatile("s_waitcnt vmcnt(0)" ::: "memory");
        } else {
            XB_SPIN(xb_ld(&bar[XB_XGEN(b.x)]) == gen, bar);
            __builtin_amdgcn_fence(__ATOMIC_ACQUIRE, "agent");
            asm volatile("s_waitcnt vmcnt(0)" ::: "memory");
        }
    }
    __syncthreads();
}
struct Args { const float* in[N_IN_TENSORS]; float* out; unsigned char* ws; int ph_lo, ph_hi; };
static_assert(sizeof(Args) == N_IN_TENSORS * 8 + 8 + 8 + 8, "Args has no padding");
__device__ __forceinline__ const float* inp(const Args& A, int i) { asm volatile("" : "+s"(i)); return (const float*)(const GAS float*)A.in[i]; }
struct Frame {
    LAS unsigned char* lds;
    unsigned char* ws;
    float* out;
    int tid, lane, wave, G, gw, ngw, bid;
};
__device__ __forceinline__ Frame fresh(const Frame& F) { Frame L = F; unsigned z = 0u; asm volatile("" : "+v"(z)); int wv = F.wave; asm volatile("" : "+s"(wv)); int b = F.bid; asm volatile("" : "+s"(b));
    unsigned long long w = (unsigned long long)F.ws; asm volatile("" : "+s"(w)); L.ws = (unsigned char*)(GAS unsigned char*)w;
    L.lane = (int)__builtin_amdgcn_mbcnt_hi(~0u, __builtin_amdgcn_mbcnt_lo(~0u, z));
    L.wave = wv; L.tid = wv * 64 + L.lane; L.bid = b; L.gw = b * NWAVES + wv; return L; }
#define WSP(T, off) ((T*)(F.ws + (off)))

__device__ __forceinline__ void transpose_item(const float* W, int K, int N, bf16* WT, int k0, int n0, int drow0, LAS float* scr, int lane) {
    const float* src = W + (size_t)k0 * N + n0 + lane;
#pragma unroll 16
    for (int kk = 0; kk < 64; ++kk) scr[kk * 65 + lane] = src[(size_t)kk * N];
    LDS_WAIT(); asm volatile("" ::: "memory");
    const int c = lane & 7;
#pragma unroll
    for (int j = 0; j < 8; ++j) { const int n = (lane >> 3) + 8 * j; const LAS float* s = scr + (8 * c) * 65 + n;
        v4u o; o.x = pk2(s[0 * 65], s[1 * 65]); o.y = pk2(s[2 * 65], s[3 * 65]); o.z = pk2(s[4 * 65], s[5 * 65]); o.w = pk2(s[6 * 65], s[7 * 65]);
        *(GAS v4u*)(WT + (size_t)(drow0 + n) * K + k0 + 8 * c) = o; }
    LDS_WAIT(); asm volatile("" ::: "memory");
}
template <int SWI> __device__ __forceinline__ void transpose_matrix(const Frame& F_, const Args& A, const float* W, int K, int N, bf16* WT, LAS float* scr) {
    const Frame F = fresh(F_);
    const int nblk = N / 64, nitems = (K / 64) * nblk;
    for (int it = F.gw; it < nitems; it += F.ngw) { const int kb = it / nblk, nb = it - kb * nblk, n0 = 64 * nb; int drow0 = n0;
        if (SWI) { const int h = n0 / 4096, c = n0 - h * 4096; drow0 = 256 * (c / 128) + 128 * h + (c & 127); }
        transpose_item(W, K, N, WT, 64 * kb, n0, drow0, scr, F.lane); }
}
__device__ __forceinline__ void prologue_a(const Frame& F_, const Args& A) {
    const Frame F = fresh(F_);
    LAS float* scr = (LAS float*)(F.lds + F.wave * 16640);
    { float* T1 = WSP(float, WS_CTL) + CW_T1; const float* cl = inp(A, I_C); const float* cc = inp(A, I_CCTX);
      for (int u = F.gw; u < DEPTH * 64; u += F.ngw) { const int layer = u >> 6, jg = u & 63;
          f32x4 al = {0.f, 0.f, 0.f, 0.f}, ac = {0.f, 0.f, 0.f, 0.f};
#pragma unroll 8
          for (int i = 0; i < 64; ++i) { const int d = F.lane + 64 * i; const float xl = cl[d], xc = cc[d]; const float sl = xl * sigmoidf_(xl), sc = xc * sigmoidf_(xc);
              const f32x4 w = *(const f32x4*)(inp(A, I_WMD) + ((size_t)layer * DM + d) * MODR + 4 * jg); al += w * sl; ac += w * sc; }
#pragma unroll
          for (int e = 0; e < 4; ++e) { const float tl = wave_sum(al[e]), tc = wave_sum(ac[e]);
              if (F.lane == 0) { T1[(layer * 2 + 0) * MODR + 4 * jg + e] = tl; T1[(layer * 2 + 1) * MODR + 4 * jg + e] = tc; } } } }
    { float* SPT = WSP(float, WS_MOD + 1536 * 1024); const float* lam = inp(A, I_LLAM);
      for (int i = F.bid * 512 + F.tid; i < DEPTH * 2 * WMIX; i += F.G * 512) SPT[i] = 8.0f * log1pf(__expf(-lam[i])); }
    { v2u* X = WSP(v2u, WS_X); const f32x4* xc = (const f32x4*)inp(A, I_CTX); const f32x4* xl = (const f32x4*)inp(A, I_X); const size_t nc = (size_t)CTXL * DM / 4, nt = (size_t)MROWS * DM / 4;
      for (size_t i = (size_t)F.bid * 512 + F.tid; i < nt; i += (size_t)F.G * 512) { const f32x4 v = (i < nc) ? xc[i] : xl[i - nc]; X[i] = (v2u){pk2(v.x, v.y), pk2(v.z, v.w)}; } }
    for (int layer = 0; layer < DEPTH; ++layer) { unsigned char* wb = F.ws + WS_W + (size_t)layer * W_LAYER;
        transpose_matrix<1>(F, A, inp(A, I_F1IN) + (size_t)layer * DM * 2 * DFF, DM, 2 * DFF, (bf16*)(wb + WO_GU1), scr);
        transpose_matrix<0>(F, A, inp(A, I_F1OUT) + (size_t)layer * DFF * DM, DFF, DM, (bf16*)(wb + WO_D1), scr);
        transpose_matrix<1>(F, A, inp(A, I_F2IN) + (size_t)layer * DM * 2 * DFF, DM, 2 * DFF, (bf16*)(wb + WO_GU2), scr);
        transpose_matrix<0>(F, A, inp(A, I_F2OUT) + (size_t)layer * DFF * DM, DFF, DM, (bf16*)(wb + WO_D2), scr);
        transpose_matrix<0>(F, A, inp(A, I_WIN) + (size_t)layer * DM * NIN, DM, NIN, (bf16*)(wb + WO_IN), scr);
        transpose_matrix<0>(F, A, inp(A, I_WBA) + (size_t)layer * WMIX * DM, WMIX, DM, (bf16*)(wb + WO_BR), scr);
        transpose_matrix<0>(F, A, inp(A, I_WBB) + (size_t)layer * WMIX * DM, WMIX, DM, (bf16*)(wb + WO_BR) + (size_t)DM * WMIX, scr);
        transpose_matrix<0>(F, A, inp(A, I_WBC) + (size_t)layer * WMIX * DM, WMIX, DM, (bf16*)(wb + WO_BR) + (size_t)2 * DM * WMIX, scr);
        transpose_matrix<0>(F, A, inp(A, I_WOUT) + (size_t)layer * DM * DM, DM, DM, (bf16*)(wb + WO_OUT), scr);
        { bf16* WL = (bf16*)(wb + WO_LRU); const float* wa = inp(A, I_LWA) + (size_t)layer * 2 * 12 * 128 * 128; const float* wx = inp(A, I_LWX) + (size_t)layer * 2 * 12 * 128 * 128;
          for (int row = F.gw; row < 6144; row += F.ngw) { const int jb = row >> 10, pnn = (row >> 8) & 3, h = (row >> 7) & 1, e = row & 127, dir = pnn >> 1, blk = 2 * jb + (pnn & 1);
              const float* src = (h ? wx : wa) + ((size_t)(dir * 12 + blk) * 128) * 128 + e;
              if (F.lane < 32) { const int k0 = F.lane * 8; v4u o = {0u, 0u, 0u, 0u};
                  if ((k0 >> 7) == (pnn & 1)) { const int dd = k0 & 127; float v[8];
#pragma unroll
                      for (int j = 0; j < 8; ++j) v[j] = src[(size_t)(dd + j) * 128];
                      o.x = pk2(v[0], v[1]); o.y = pk2(v[2], v[3]); o.z = pk2(v[4], v[5]); o.w = pk2(v[6], v[7]); }
                  *(GAS v4u*)(WL + (size_t)row * 256 + k0) = o; } } }
    }
}
__device__ __forceinline__ void prologue_b(const Frame& F_, const Args& A) {
    const Frame F = fresh(F_);
    const float* T1 = WSP(float, WS_CTL) + CW_T1; float* MOD = WSP(float, WS_MOD); constexpr int NM = NMOD * DM;
    for (int u = F.gw; u < DEPTH * 2 * (NM / 256); u += F.ngw) { const int lw = u / (NM / 256), nc = u - lw * (NM / 256), layer = lw >> 1, n0 = nc * 256 + 4 * F.lane;
        f32x4 acc = *(const f32x4*)(inp(A, I_BMOD) + (size_t)layer * NM + n0); const float* t1 = T1 + lw * MODR; const float* wu = inp(A, I_WMU) + (size_t)layer * MODR * NM + n0;
#pragma unroll 8
        for (int j = 0; j < MODR; ++j) acc += *(const f32x4*)(wu + (size_t)j * NM) * t1[j];
        *(f32x4*)(MOD + (size_t)lw * NM + n0) = acc; }
}
__device__ __forceinline__ void norm_phase(const Frame& F_, const Args& A, const float* g, const float* modL, const float* modC, int ishift, int iscale, int dfrom) {
    const Frame F = fresh(F_);
    bf16* X = WSP(bf16, WS_X); bf16* U = WSP(bf16, WS_U); const bf16* Dd = WSP(bf16, WS_M32); LAS f32x4* L4 = (LAS f32x4*)F.lds;
    __syncthreads();
    for (int i = F.tid; i < DM / 4; i += NWAVES * 64) { L4[i] = *(const f32x4*)(g + 4 * i);
        L4[1024 + i] = *(const f32x4*)(modL + ishift * DM + 4 * i); L4[2048 + i] = *(const f32x4*)(modL + iscale * DM + 4 * i) + 1.0f;
        L4[3072 + i] = *(const f32x4*)(modC + ishift * DM + 4 * i); L4[4096 + i] = *(const f32x4*)(modC + iscale * DM + 4 * i) + 1.0f; }
    __syncthreads();
    for (int r = F.gw; r < MROWS; r += F.ngw) { const int mo = (r < CTXL) ? 3072 : 1024; v4u* xr = (v4u*)(X + (size_t)r * DM) + F.lane;
        f32x4 v[8][2]; float s = 0.f;
#pragma unroll
        for (int i = 0; i < 8; ++i) { const v4u x = xr[64 * i]; v[i][0] = (f32x4){bflo(x.x), bfhi(x.x), bflo(x.y), bfhi(x.y)}; v[i][1] = (f32x4){bflo(x.z), bfhi(x.z), bflo(x.w), bfhi(x.w)}; }
        if (r >= dfrom) { const v4u* dr = (const v4u*)(Dd + (size_t)r * DM) + F.lane;
#pragma unroll
            for (int i = 0; i < 8; ++i) { const v4u d = dr[64 * i]; v[i][0] += (f32x4){bflo(d.x), bfhi(d.x), bflo(d.y), bfhi(d.y)}; v[i][1] += (f32x4){bflo(d.z), bfhi(d.z), bflo(d.w), bfhi(d.w)};
                xr[64 * i] = (v4u){pk2(v[i][0].x, v[i][0].y), pk2(v[i][0].z, v[i][0].w), pk2(v[i][1].x, v[i][1].y), pk2(v[i][1].z, v[i][1].w)}; } }
#pragma unroll
        for (int i = 0; i < 8; ++i)
#pragma unroll
            for (int h = 0; h < 2; ++h) s += (v[i][h].x * v[i][h].x + v[i][h].y * v[i][h].y) + (v[i][h].z * v[i][h].z + v[i][h].w * v[i][h].w);
        const float rms = rsqrtf(wave_sum(s) * (1.0f / DM) + EPSN);
        v4u* o16 = (v4u*)(U + (size_t)r * DM) + F.lane;
#pragma unroll
        for (int i = 0; i < 8; ++i) { f32x4 y[2];
#pragma unroll
            for (int h = 0; h < 2; ++h) { const int c4 = 2 * F.lane + 128 * i + h; const f32x4 gg = L4[c4], sh = L4[mo + c4], sc1 = L4[mo + 1024 + c4]; y[h] = (v[i][h] * rms * gg) * sc1 + sh; }
            o16[64 * i] = (v4u){pk2(y[0].x, y[0].y), pk2(y[0].z, y[0].w), pk2(y[1].x, y[1].y), pk2(y[1].z, y[1].w)}; } }
    __syncthreads();
}
__device__ __forceinline__ void final_norm_phase(const Frame& F_, const Args& A) {
    const Frame F = fresh(F_);
    const bf16* X = WSP(bf16, WS_X); const bf16* Dd = WSP(bf16, WS_M32); const float* g = inp(A, I_FNORM);
    for (int r = F.gw; r < SEQ; r += F.ngw) { const v2u* xr = (const v2u*)(X + (size_t)(r + CTXL) * DM) + F.lane; const v2u* dr = (const v2u*)(Dd + (size_t)(r + CTXL) * DM) + F.lane; f32x4 v[16]; float s = 0.f;
#pragma unroll
        for (int i = 0; i < 16; ++i) { const v2u x = xr[64 * i], d = dr[64 * i]; v[i] = (f32x4){bflo(x.x) + bflo(d.x), bfhi(x.x) + bfhi(d.x), bflo(x.y) + bflo(d.y), bfhi(x.y) + bfhi(d.y)}; s += (v[i].x * v[i].x + v[i].y * v[i].y) + (v[i].z * v[i].z + v[i].w * v[i].w); }
        const float rms = rsqrtf(wave_sum(s) * (1.0f / DM) + EPSN); f32x4* o = (f32x4*)(F.out + (size_t)r * DM) + F.lane;
#pragma unroll
        for (int i = 0; i < 16; ++i) o[64 * i] = v[i] * rms * *(const f32x4*)(g + 4 * F.lane + 256 * i); }
}

#ifdef DUMP
__device__ __forceinline__ void dump_phase(const Frame& F_, const Args& A) {
    const Frame F = fresh(F_);
    const bf16* YC = WSP(bf16, WS_YC); const bf16* YA = WSP(bf16, WS_YA); const bf16* YB = WSP(bf16, WS_YB);
#if DUMP >= 8
    { const bf16* P = WSP(bf16, WS_P); const size_t nctx = (size_t)CTXL * NIN;
      for (size_t i = (size_t)F.bid * 512 + F.tid; i < (size_t)SEQ * DM; i += (size_t)F.G * 512) { float v = 0.f;
          if (i < nctx) { if (DUMP & 8) v = bf1(P[i]); } else { const size_t k = i - nctx; const size_t r = k / DM, c = k % DM; if (DUMP & 16) v = bf1(P[(size_t)(r + CTXL) * NIN + c]); }
          F.out[i] = v; } return; }
#endif
    for (size_t i = (size_t)F.bid * 512 + F.tid; i < (size_t)SEQ * DM; i += (size_t)F.G * 512) { const int r = (int)(i / DM), c = (int)(i % DM); float v = 0.f;
        if (c < 1536) { if (DUMP & 1) v = bf1(YC[(size_t)(r + CTXL) * WMIX + c]); }
        else if (c < 3072) { if (DUMP & 2) v = bf1(YA[(size_t)(r + CTXL) * WMIX + c - 1536]); }
        else { if (DUMP & 4) v = bf1(YB[(size_t)(r + CTXL) * WMIX + c - 3072]); }
        F.out[i] = v; }
}
#endif
__device__ __forceinline__ bool same_seq(int r, int r2) { return r2 >= 0 && r2 < MROWS && ((r < CTXL) == (r2 < CTXL)); }
__device__ __forceinline__ void prep_lru_conv(const Frame& F_, const Args& A, int layer) {
    const Frame F = fresh(F_);
    const bf16* P = WSP(bf16, WS_P); bf16* XA = WSP(bf16, WS_XA); const float* w = inp(A, I_LCONV) + (size_t)layer * 4 * WMIX;
    const int nitems = (MROWS / 16) * (WMIX / 8);
    for (int it = F.bid * 512 + F.tid; it < nitems; it += F.G * 512) { const int run = it / (WMIX / 8), c0 = (it - run * (WMIX / 8)) * 8, r0 = run * 16;
        float wk[4][8];
#pragma unroll
        for (int k = 0; k < 4; ++k) { const f32x4 w0 = *(const f32x4*)(w + k * WMIX + c0), w1 = *(const f32x4*)(w + k * WMIX + c0 + 4);
            wk[k][0] = w0.x; wk[k][1] = w0.y; wk[k][2] = w0.z; wk[k][3] = w0.w; wk[k][4] = w1.x; wk[k][5] = w1.y; wk[k][6] = w1.z; wk[k][7] = w1.w; }
        v4u rows[19];
#pragma unroll
        for (int q = 0; q < 19; ++q) { const int r2 = r0 - 1 + q; rows[q] = same_seq(r0, r2) ? *(const v4u*)(P + (size_t)r2 * NIN + COL_AX + c0) : (v4u){0u, 0u, 0u, 0u}; }
#pragma unroll
        for (int t = 0; t < 16; ++t) { float acc[8] = {0.f, 0.f, 0.f, 0.f, 0.f, 0.f, 0.f, 0.f};
#pragma unroll
            for (int k = 0; k < 4; ++k) { const v4u pw = rows[t + k];
                acc[0] += wk[k][0] * bflo(pw.x); acc[1] += wk[k][1] * bfhi(pw.x); acc[2] += wk[k][2] * bflo(pw.y); acc[3] += wk[k][3] * bfhi(pw.y);
                acc[4] += wk[k][4] * bflo(pw.z); acc[5] += wk[k][5] * bfhi(pw.z); acc[6] += wk[k][6] * bflo(pw.w); acc[7] += wk[k][7] * bfhi(pw.w); }
            v4u o; o.x = pk2(acc[0], acc[1]); o.y = pk2(acc[2], acc[3]); o.z = pk2(acc[4], acc[5]); o.w = pk2(acc[6], acc[7]);
            *(v4u*)(XA + ((size_t)(c0 >> 8) * MROWS + r0 + t) * 256 + (c0 & 255)) = o; } }
}
__device__ __forceinline__ void prep_qkv(const Frame& F_, const Args& A, int layer) {
    const Frame F = fresh(F_);
    const bf16* P = WSP(bf16, WS_P); bf16* QN = WSP(bf16, WS_QN); bf16* KN = WSP(bf16, WS_KN); bf16* VN = WSP(bf16, WS_VN);
    const float* qg = inp(A, I_QN) + layer * 128; const float* kg = inp(A, I_KN) + layer * 128;
    const int d0 = (F.lane & 15) * 8, hl = F.lane >> 4;
    float gq[8], gk[8];
#pragma unroll
    for (int j = 0; j < 8; ++j) { gq[j] = qg[d0 + j]; gk[j] = kg[d0 + j]; }
    for (int r = F.gw; r < MROWS; r += F.ngw) { const bf16* pr = P + (size_t)r * NIN;
        float cs[4], sn[4]; const bool lat = r >= CTXL;
        if (lat) { const int s = r - CTXL, prow = s >> 6, pcol = s & 63;
#pragma unroll
            for (int j = 0; j < 4; ++j) { const int p = (d0 >> 1) + j;
                const float inv = exp2f(-(float)(p & 31) * (13.287712379549449f / 32.0f));
                const float ang = (float)((p < 32) ? prow : pcol) * inv; sincosf(ang, &sn[j], &cs[j]); } }
#pragma unroll
        for (int i = 0; i < 4; ++i) { const bool isq = i < 3; const int head = isq ? (hl + 4 * i) : hl;
            const bf16* src = pr + (isq ? (COL_CQ + head * 128) : (COL_CK + head * 128)) + d0;
            const v4u w = *(const v4u*)src; float v[8] = {bflo(w.x), bfhi(w.x), bflo(w.y), bfhi(w.y), bflo(w.z), bfhi(w.z), bflo(w.w), bfhi(w.w)};
            float ss = 0.f;
#pragma unroll
            for (int j = 0; j < 8; ++j) ss += v[j] * v[j];
            ss += swz_xor<1>(ss); ss += swz_xor<2>(ss); ss += swz_xor<4>(ss); ss += swz_xor<8>(ss);
            const float rms = rsqrtf(ss * (1.0f / 128.0f) + EPSN);
#pragma unroll
            for (int j = 0; j < 8; ++j) v[j] = v[j] * rms * (isq ? gq[j] : gk[j]);
            if (lat) {
#pragma unroll
                for (int j = 0; j < 4; ++j) { const float t0 = v[2 * j], t1 = v[2 * j + 1]; v[2 * j] = t0 * cs[j] - t1 * sn[j]; v[2 * j + 1] = t0 * sn[j] + t1 * cs[j]; } }
            v4u o; o.x = pk2(v[0], v[1]); o.y = pk2(v[2], v[3]); o.z = pk2(v[4], v[5]); o.w = pk2(v[6], v[7]);
            if (isq) *(v4u*)(QN + (size_t)r * WMIX + head * 128 + d0) = o; else *(v4u*)(KN + (size_t)r * KVW + head * 128 + d0) = o; }
        *(v4u*)(VN + (size_t)r * KVW + F.lane * 8) = *(const v4u*)(pr + COL_CV + F.lane * 8); }
}
__device__ __forceinline__ void prep_hyena_t(const Frame& F_, const Args& A, int layer) {
    const Frame F = fresh(F_);
    const bf16* P = WSP(bf16, WS_P); float* VT = WSP(float, WS_VT); const float* w = inp(A, I_HCONV) + (size_t)layer * 3 * (3 * WMIX);
    LAS float* scr = (LAS float*)(F.lds + F.wave * WSCR_BYTES);
    constexpr int NCB = 3 * WMIX / 64;
    for (int u = F.gw; u < (SEQ / 64) * NCB; u += F.ngw) { const int tb = u / NCB, cb = u - tb * NCB, t0 = tb * 64, c0 = cb * 64;
#pragma unroll
        for (int ps = 0; ps < 9; ++ps) { const int rr = ps * 8 + (F.lane >> 3), cc = (F.lane & 7) * 8; if (rr < 66) { const int t = t0 - 1 + rr; v4u pw = {0u, 0u, 0u, 0u};
                if (t >= 0 && t < SEQ) pw = *(const v4u*)(P + (size_t)(t + CTXL) * NIN + COL_B + c0 + cc);
                LAS float* d = scr + rr * 65 + cc; d[0] = bflo(pw.x); d[1] = bfhi(pw.x); d[2] = bflo(pw.y); d[3] = bfhi(pw.y); d[4] = bflo(pw.z); d[5] = bfhi(pw.z); d[6] = bflo(pw.w); d[7] = bfhi(pw.w); } }
        LDS_WAIT(); asm volatile("" ::: "memory");
        { const int part = c0 / WMIX, pr0 = (c0 - part * WMIX) >> 1;
          const int tl = 4 * (F.lane & 15), pl = F.lane >> 4;
#pragma unroll 2
          for (int pg = 0; pg < 8; ++pg) { const int pi = 4 * pg + pl, c = 2 * pi, ch = c0 + c; v4u o;
              const float w00 = w[ch], w01 = w[3 * WMIX + ch], w02 = w[2 * 3 * WMIX + ch], w10 = w[ch + 1], w11 = w[3 * WMIX + ch + 1], w12 = w[2 * 3 * WMIX + ch + 1];
              float xe[6], xo[6];
#pragma unroll
              for (int q = 0; q < 6; ++q) { xe[q] = scr[(tl + q) * 65 + c]; xo[q] = scr[(tl + q) * 65 + c + 1]; }
              o.x = pk2(w00 * xe[0] + w01 * xe[1] + w02 * xe[2], w10 * xo[0] + w11 * xo[1] + w12 * xo[2]);
              o.y = pk2(w00 * xe[1] + w01 * xe[2] + w02 * xe[3], w10 * xo[1] + w11 * xo[2] + w12 * xo[3]);
              o.z = pk2(w00 * xe[2] + w01 * xe[3] + w02 * xe[4], w10 * xo[2] + w11 * xo[3] + w12 * xo[4]);
              o.w = pk2(w00 * xe[3] + w01 * xe[4] + w02 * xe[5], w10 * xo[3] + w11 * xo[4] + w12 * xo[5]);
              *(v4u*)((unsigned*)VT + ((size_t)part * (WMIX / 2) + pr0 + pi) * SEQ + t0 + tl) = o; } }
        LDS_WAIT(); asm volatile("" ::: "memory"); }
}
__device__ __forceinline__ void prep_hyena_ctx(const Frame& F_, const Args& A, int layer) {
    const Frame F = fresh(F_);
    const bf16* P = WSP(bf16, WS_P); float* UC = WSP(float, WS_UC); const float* w = inp(A, I_HCONV) + (size_t)layer * 3 * (3 * WMIX);
    for (int it = F.bid * 512 + F.tid; it < CTXL * 3 * WMIX; it += F.G * 512) { const int t = it / (3 * WMIX), ch = it - t * (3 * WMIX);
        float v = w[3 * WMIX + ch] * bf1(P[(size_t)t * NIN + COL_B + ch]);
        if (t > 0) v += w[ch] * bf1(P[(size_t)(t - 1) * NIN + COL_B + ch]);
        if (t < CTXL - 1) v += w[2 * 3 * WMIX + ch] * bf1(P[(size_t)(t + 1) * NIN + COL_B + ch]);
        const int part = ch / WMIX, c = ch - part * WMIX; UC[((size_t)part * CTXL + t) * WMIX + c] = v; }
}
__device__ __forceinline__ void filt_mlp(const Frame& F_, const Args& A, int layer, bool with_ctx) {
    const Frame F = fresh(F_);
    float* H2 = WSP(float, WS_H2); float* H2C = WSP(float, WS_H2C);
    const float* fw1 = inp(A, I_HFW1) + (size_t)layer * 33 * 64; const float* fb1 = inp(A, I_HFB1) + layer * 64; const float* fr = inp(A, I_HFREQ) + layer * 64;
    const float* fw2 = inp(A, I_HFW2) + (size_t)layer * 64 * 64; const float* fb2 = inp(A, I_HFB2) + layer * 64;
    const int j = F.lane; const float frj = fr[j], b1 = fb1[j], b2 = fb2[j];
    const int total = SEQ + (with_ctx ? CTXL : 0);
    for (int u = F.gw; u < total; u += F.ngw) { const bool isc = u >= SEQ; const int t = isc ? u - SEQ : u, L = isc ? CTXL : SEQ;
        const float tl = (float)t / (float)(L - 1);
        const int b = j & 15; const float band = 1e-4f + (float)b * ((15.0f - 1e-4f) / 15.0f);
        const float ang = (6.283185307179586f / (float)L) * (float)t * band; float sn, cs; sincosf(ang, &sn, &cs); const float zc = cs, zs = -sn;
        float pre = b1 + tl * fw1[j];
#pragma unroll
        for (int i = 0; i < 16; ++i) { pre += lane_bcast(zc, i) * fw1[(1 + i) * 64 + j]; pre += lane_bcast(zs, i) * fw1[(17 + i) * 64 + j]; }
        const float h1 = sinf(frj * pre);
        float pre2 = b2;
#pragma unroll 16
        for (int i = 0; i < 64; ++i) pre2 += lane_bcast(h1, i) * fw2[i * 64 + j];
        const float h2 = sinf(frj * pre2);
        (isc ? H2C : H2)[(size_t)t * 64 + j] = h2; }
}
__device__ __forceinline__ float hy_delta(int c) {
    const float d0 = -4.605170185988091f / 1.5f, d1 = -4.605170185988091f / 0.3f; return d0 + (float)c * ((d1 - d0) / 1535.0f);
}
__device__ __forceinline__ void filt_taps_unit(const Frame& F_, const Args& A, int layer, int u) {
    const Frame F = fresh(F_);
    const float* H2 = WSP(float, WS_H2); float* KT = WSP(float, WS_KT); const float* fw3 = inp(A, I_HFW3) + (size_t)layer * 64 * 6144;
    LAS float* Wl = (LAS float*)F.lds;
    { const int cg = u >> 4, tsb = u & 15, t = tsb * 512 + F.tid;
        __syncthreads();
#pragma unroll 1
        for (int i = 0; i < 12; ++i) { const int e = F.tid + 512 * i, j = e / 96, rem = e - j * 96, od = rem / 24, cl = rem - od * 24;
            Wl[(cl * 4 + od) * 64 + j] = fw3[(size_t)j * 6144 + od * WMIX + cg * 24 + cl]; }
        f32x4 h2[16];
#pragma unroll
        for (int i = 0; i < 16; ++i) h2[i] = *(const f32x4*)(H2 + (size_t)t * 64 + 4 * i);
        __syncthreads();
        const float tl = (float)t / (float)(SEQ - 1);
#pragma unroll 1
        for (int cp = 0; cp < 12; ++cp) { float acc[8];
#pragma unroll
            for (int q = 0; q < 8; ++q) { const LAS f32x4* wp = (const LAS f32x4*)(Wl + (cp * 8 + q) * 64); f32x4 a = {0.f, 0.f, 0.f, 0.f};
#pragma unroll
                for (int i = 0; i < 16; ++i) { a += h2[i] * wp[i]; if ((i & 3) == 3) asm volatile("" ::: "memory"); }
                acc[q] = (a.x + a.y) + (a.z + a.w); asm volatile("" : "+v"(acc[q]) :: "memory"); }
            const int c = cg * 24 + 2 * cp; const float d0 = __expf(tl * hy_delta(c)), d1 = __expf(tl * hy_delta(c + 1));
#pragma unroll
            for (int o = 0; o < 2; ++o) { f32x2* kt = (f32x2*)KT + ((size_t)o * (WMIX / 2) + (c >> 1)) * FFTN;
                const f32x2 hf = {acc[o * 2] * d0, acc[4 + o * 2] * d1}, hb = {acc[o * 2 + 1] * d0, acc[4 + o * 2 + 1] * d1};
                if (t == 0) { kt[0] = hf + hb; kt[SEQ] = (f32x2){0.f, 0.f}; } else { kt[t] = hf; kt[FFTN - t] = hb; } } }
    }
    __syncthreads();
}
__device__ __forceinline__ void filt_taps_ctx(const Frame& F_, const Args& A, int layer) {
    const Frame F = fresh(F_);
    const float* H2C = WSP(float, WS_H2C); float* KC = WSP(float, WS_KC); const float* fw3 = inp(A, I_HFW3) + (size_t)layer * 64 * 6144;
    for (int u = F.gw; u < CTXL * 48; u += F.ngw) { const int t = u / 48, oc = (u - t * 48) * 64 + F.lane, o = oc / WMIX, c = oc - o * WMIX;
        const float hrow = H2C[t * 64 + F.lane];
        const float* wf = fw3 + o * 2 * WMIX + c; float hf = 0.f, hb = 0.f;
#pragma unroll 32
        for (int j = 0; j < 64; ++j) { const float h = lane_bcast(hrow, j); hf += h * wf[(size_t)j * 6144]; hb += h * wf[(size_t)j * 6144 + WMIX]; }
        const float dec = __expf(((float)t / (float)(CTXL - 1)) * hy_delta(c)); hf *= dec; hb *= dec;
        float* kc = KC + (size_t)o * 512 * WMIX + c;
        if (t == 0) kc[(size_t)255 * WMIX] = hf + hb; else { kc[(size_t)(255 + t) * WMIX] = hf; kc[(size_t)(255 - t) * WMIX] = hb; } }
}
__device__ __forceinline__ void filt_norm_ctx(const Frame& F_, const Args& A) {
    const Frame F = fresh(F_);
    const float* KC = WSP(float, WS_KC); float* KCN = WSP(float, WS_KCN); LAS float* red = (LAS float*)F.lds;
    for (int u = F.bid; u < 48; u += F.G) { const int o = u / 24, c = (u - o * 24) * 64 + F.lane; const float* kc = KC + (size_t)o * 512 * WMIX + c; float s = 0.f;
#pragma unroll 16
        for (int i = 0; i < 64; ++i) { const int l = F.wave + 8 * i; const float k = (l < 511) ? kc[(size_t)l * WMIX] : 0.f; s += k * k; }
        __syncthreads(); red[F.wave * 64 + F.lane] = s; __syncthreads();
        if (F.wave == 0) { float t = 0.f;
#pragma unroll
            for (int w = 0; w < 8; ++w) t += red[w * 64 + F.lane];
            KCN[o * WMIX + c] = rsqrtf(t + EPSN); }
    }
    __syncthreads();
}

#define DFT_BF0(A_, B_) do { const f32x2 a_ = (A_), t_ = (B_); (A_) = a_ + t_; (B_) = a_ - t_; } while (0)
#define DFT_BF8(A_, B_) do { const f32x2 a_ = (A_), b_ = (B_); const f32x2 t_ = {b_.y, -b_.x}; (A_) = a_ + t_; (B_) = a_ - t_; } while (0)
#define DFT_BFW(A_, B_, C_, S_) do { const f32x2 a_ = (A_), b_ = (B_); const f32x2 t_ = {b_.x * (C_) - b_.y * (S_), b_.x * (S_) + b_.y * (C_)}; (A_) = a_ + t_; (B_) = a_ - t_; } while (0)
template <int OFF> __device__ __forceinline__ void dft32(f32x2 (&v)[32]) {
    { const f32x2 t = v[OFF + 1]; v[OFF + 1] = v[OFF + 16]; v[OFF + 16] = t; }
    { const f32x2 t = v[OFF + 2]; v[OFF + 2] = v[OFF + 8]; v[OFF + 8] = t; }
    { const f32x2 t = v[OFF + 3]; v[OFF + 3] = v[OFF + 24]; v[OFF + 24] = t; }
    { const f32x2 t = v[OFF + 5]; v[OFF + 5] = v[OFF + 20]; v[OFF + 20] = t; }
    { const f32x2 t = v[OFF + 6]; v[OFF + 6] = v[OFF + 12]; v[OFF + 12] = t; }
    { const f32x2 t = v[OFF + 7]; v[OFF + 7] = v[OFF + 28]; v[OFF + 28] = t; }
    { const f32x2 t = v[OFF + 9]; v[OFF + 9] = v[OFF + 18]; v[OFF + 18] = t; }
    { const f32x2 t = v[OFF + 11]; v[OFF + 11] = v[OFF + 26]; v[OFF + 26] = t; }
    { const f32x2 t = v[OFF + 13]; v[OFF + 13] = v[OFF + 22]; v[OFF + 22] = t; }
    { const f32x2 t = v[OFF + 15]; v[OFF + 15] = v[OFF + 30]; v[OFF + 30] = t; }
    { const f32x2 t = v[OFF + 19]; v[OFF + 19] = v[OFF + 25]; v[OFF + 25] = t; }
    { const f32x2 t = v[OFF + 23]; v[OFF + 23] = v[OFF + 29]; v[OFF + 29] = t; }
    DFT_BF0(v[OFF + 0], v[OFF + 1]);
    DFT_BF0(v[OFF + 2], v[OFF + 3]);
    DFT_BF0(v[OFF + 4], v[OFF + 5]);
    DFT_BF0(v[OFF + 6], v[OFF + 7]);
    DFT_BF0(v[OFF + 8], v[OFF + 9]);
    DFT_BF0(v[OFF + 10], v[OFF + 11]);
    DFT_BF0(v[OFF + 12], v[OFF + 13]);
    DFT_BF0(v[OFF + 14], v[OFF + 15]);
    DFT_BF0(v[OFF + 16], v[OFF + 17]);
    DFT_BF0(v[OFF + 18], v[OFF + 19]);
    DFT_BF0(v[OFF + 20], v[OFF + 21]);
    DFT_BF0(v[OFF + 22], v[OFF + 23]);
    DFT_BF0(v[OFF + 24], v[OFF + 25]);
    DFT_BF0(v[OFF + 26], v[OFF + 27]);
    DFT_BF0(v[OFF + 28], v[OFF + 29]);
    DFT_BF0(v[OFF + 30], v[OFF + 31]);
    DFT_BF0(v[OFF + 0], v[OFF + 2]);
    DFT_BF8(v[OFF + 1], v[OFF + 3]);
    DFT_BF0(v[OFF + 4], v[OFF + 6]);
    DFT_BF8(v[OFF + 5], v[OFF + 7]);
    DFT_BF0(v[OFF + 8], v[OFF + 10]);
    DFT_BF8(v[OFF + 9], v[OFF + 11]);
    DFT_BF0(v[OFF + 12], v[OFF + 14]);
    DFT_BF8(v[OFF + 13], v[OFF + 15]);
    DFT_BF0(v[OFF + 16], v[OFF + 18]);
    DFT_BF8(v[OFF + 17], v[OFF + 19]);
    DFT_BF0(v[OFF + 20], v[OFF + 22]);
    DFT_BF8(v[OFF + 21], v[OFF + 23]);
    DFT_BF0(v[OFF + 24], v[OFF + 26]);
    DFT_BF8(v[OFF + 25], v[OFF + 27]);
    DFT_BF0(v[OFF + 28], v[OFF + 30]);
    DFT_BF8(v[OFF + 29], v[OFF + 31]);
    DFT_BF0(v[OFF + 0], v[OFF + 4]);
    DFT_BFW(v[OFF + 1], v[OFF + 5], 0.70710678118654757f, -0.70710678118654746f);
    DFT_BF8(v[OFF + 2], v[OFF + 6]);
    DFT_BFW(v[OFF + 3], v[OFF + 7], -0.70710678118654746f, -0.70710678118654757f);
    DFT_BF0(v[OFF + 8], v[OFF + 12]);
    DFT_BFW(v[OFF + 9], v[OFF + 13], 0.70710678118654757f, -0.70710678118654746f);
    DFT_BF8(v[OFF + 10], v[OFF + 14]);
    DFT_BFW(v[OFF + 11], v[OFF + 15], -0.70710678118654746f, -0.70710678118654757f);
    DFT_BF0(v[OFF + 16], v[OFF + 20]);
    DFT_BFW(v[OFF + 17], v[OFF + 21], 0.70710678118654757f, -0.70710678118654746f);
    DFT_BF8(v[OFF + 18], v[OFF + 22]);
    DFT_BFW(v[OFF + 19], v[OFF + 23], -0.70710678118654746f, -0.70710678118654757f);
    DFT_BF0(v[OFF + 24], v[OFF + 28]);
    DFT_BFW(v[OFF + 25], v[OFF + 29], 0.70710678118654757f, -0.70710678118654746f);
    DFT_BF8(v[OFF + 26], v[OFF + 30]);
    DFT_BFW(v[OFF + 27], v[OFF + 31], -0.70710678118654746f, -0.70710678118654757f);
    DFT_BF0(v[OFF + 0], v[OFF + 8]);
    DFT_BFW(v[OFF + 1], v[OFF + 9], 0.92387953251128674f, -0.38268343236508978f);
    DFT_BFW(v[OFF + 2], v[OFF + 10], 0.70710678118654757f, -0.70710678118654746f);
    DFT_BFW(v[OFF + 3], v[OFF + 11], 0.38268343236508984f, -0.92387953251128674f);
    DFT_BF8(v[OFF + 4], v[OFF + 12]);
    DFT_BFW(v[OFF + 5], v[OFF + 13], -0.38268343236508973f, -0.92387953251128674f);
    DFT_BFW(v[OFF + 6], v[OFF + 14], -0.70710678118654746f, -0.70710678118654757f);
    DFT_BFW(v[OFF + 7], v[OFF + 15], -0.92387953251128674f, -0.38268343236508989f);
    DFT_BF0(v[OFF + 16], v[OFF + 24]);
    DFT_BFW(v[OFF + 17], v[OFF + 25], 0.92387953251128674f, -0.38268343236508978f);
    DFT_BFW(v[OFF + 18], v[OFF + 26], 0.70710678118654757f, -0.70710678118654746f);
    DFT_BFW(v[OFF + 19], v[OFF + 27], 0.38268343236508984f, -0.92387953251128674f);
    DFT_BF8(v[OFF + 20], v[OFF + 28]);
    DFT_BFW(v[OFF + 21], v[OFF + 29], -0.38268343236508973f, -0.92387953251128674f);
    DFT_BFW(v[OFF + 22], v[OFF + 30], -0.70710678118654746f, -0.70710678118654757f);
    DFT_BFW(v[OFF + 23], v[OFF + 31], -0.92387953251128674f, -0.38268343236508989f);
    DFT_BF0(v[OFF + 0], v[OFF + 16]);
    DFT_BFW(v[OFF + 1], v[OFF + 17], 0.98078528040323043f, -0.19509032201612825f);
    DFT_BFW(v[OFF + 2], v[OFF + 18], 0.92387953251128674f, -0.38268343236508978f);
    DFT_BFW(v[OFF + 3], v[OFF + 19], 0.83146961230254524f, -0.55557023301960218f);
    DFT_BFW(v[OFF + 4], v[OFF + 20], 0.70710678118654757f, -0.70710678118654746f);
    DFT_BFW(v[OFF + 5], v[OFF + 21], 0.55557023301960229f, -0.83146961230254524f);
    DFT_BFW(v[OFF + 6], v[OFF + 22], 0.38268343236508984f, -0.92387953251128674f);
    DFT_BFW(v[OFF + 7], v[OFF + 23], 0.19509032201612833f, -0.98078528040323043f);
    DFT_BF8(v[OFF + 8], v[OFF + 24]);
    DFT_BFW(v[OFF + 9], v[OFF + 25], -0.19509032201612819f, -0.98078528040323043f);
    DFT_BFW(v[OFF + 10], v[OFF + 26], -0.38268343236508973f, -0.92387953251128674f);
    DFT_BFW(v[OFF + 11], v[OFF + 27], -0.55557023301960196f, -0.83146961230254546f);
    DFT_BFW(v[OFF + 12], v[OFF + 28], -0.70710678118654746f, -0.70710678118654757f);
    DFT_BFW(v[OFF + 13], v[OFF + 29], -0.83146961230254535f, -0.55557023301960218f);
    DFT_BFW(v[OFF + 14], v[OFF + 30], -0.92387953251128674f, -0.38268343236508989f);
    DFT_BFW(v[OFF + 15], v[OFF + 31], -0.98078528040323043f, -0.19509032201612861f);
}
template <int OFF> __device__ __forceinline__ void dft16(f32x2 (&v)[32]) {
    { const f32x2 t = v[OFF + 1]; v[OFF + 1] = v[OFF + 8]; v[OFF + 8] = t; }
    { const f32x2 t = v[OFF + 2]; v[OFF + 2] = v[OFF + 4]; v[OFF + 4] = t; }
    { const f32x2 t = v[OFF + 3]; v[OFF + 3] = v[OFF + 12]; v[OFF + 12] = t; }
    { const f32x2 t = v[OFF + 5]; v[OFF + 5] = v[OFF + 10]; v[OFF + 10] = t; }
    { const f32x2 t = v[OFF + 7]; v[OFF + 7] = v[OFF + 14]; v[OFF + 14] = t; }
    { const f32x2 t = v[OFF + 11]; v[OFF + 11] = v[OFF + 13]; v[OFF + 13] = t; }
    DFT_BF0(v[OFF + 0], v[OFF + 1]);
    DFT_BF0(v[OFF + 2], v[OFF + 3]);
    DFT_BF0(v[OFF + 4], v[OFF + 5]);
    DFT_BF0(v[OFF + 6], v[OFF + 7]);
    DFT_BF0(v[OFF + 8], v[OFF + 9]);
    DFT_BF0(v[OFF + 10], v[OFF + 11]);
    DFT_BF0(v[OFF + 12], v[OFF + 13]);
    DFT_BF0(v[OFF + 14], v[OFF + 15]);
    DFT_BF0(v[OFF + 0], v[OFF + 2]);
    DFT_BF8(v[OFF + 1], v[OFF + 3]);
    DFT_BF0(v[OFF + 4], v[OFF + 6]);
    DFT_BF8(v[OFF + 5], v[OFF + 7]);
    DFT_BF0(v[OFF + 8], v[OFF + 10]);
    DFT_BF8(v[OFF + 9], v[OFF + 11]);
    DFT_BF0(v[OFF + 12], v[OFF + 14]);
    DFT_BF8(v[OFF + 13], v[OFF + 15]);
    DFT_BF0(v[OFF + 0], v[OFF + 4]);
    DFT_BFW(v[OFF + 1], v[OFF + 5], 0.70710678118654757f, -0.70710678118654746f);
    DFT_BF8(v[OFF + 2], v[OFF + 6]);
    DFT_BFW(v[OFF + 3], v[OFF + 7], -0.70710678118654746f, -0.70710678118654757f);
    DFT_BF0(v[OFF + 8], v[OFF + 12]);
    DFT_BFW(v[OFF + 9], v[OFF + 13], 0.70710678118654757f, -0.70710678118654746f);
    DFT_BF8(v[OFF + 10], v[OFF + 14]);
    DFT_BFW(v[OFF + 11], v[OFF + 15], -0.70710678118654746f, -0.70710678118654757f);
    DFT_BF0(v[OFF + 0], v[OFF + 8]);
    DFT_BFW(v[OFF + 1], v[OFF + 9], 0.92387953251128674f, -0.38268343236508978f);
    DFT_BFW(v[OFF + 2], v[OFF + 10], 0.70710678118654757f, -0.70710678118654746f);
    DFT_BFW(v[OFF + 3], v[OFF + 11], 0.38268343236508984f, -0.92387953251128674f);
    DFT_BF8(v[OFF + 4], v[OFF + 12]);
    DFT_BFW(v[OFF + 5], v[OFF + 13], -0.38268343236508973f, -0.92387953251128674f);
    DFT_BFW(v[OFF + 6], v[OFF + 14], -0.70710678118654746f, -0.70710678118654757f);
    DFT_BFW(v[OFF + 7], v[OFF + 15], -0.92387953251128674f, -0.38268343236508989f);
}

__device__ __forceinline__ f32x2 cmul(f32x2 a, f32x2 b) { return (f32x2){a.x * b.x - a.y * b.y, a.x * b.y + a.y * b.x}; }
__device__ __forceinline__ int pidx(int i) { return i + (i >> 5); }
template <int R, int OFF> __device__ __forceinline__ void twiddle_reg(f32x2 (&v)[32], int num, float inv_den) {
    float s, c; __sincosf(-6.283185307179586f * (float)num * inv_den, &s, &c); const f32x2 w = {c, s}; f32x2 wr = w;
#pragma unroll
    for (int r = 1; r < R; ++r) { v[OFF + r] = cmul(v[OFF + r], wr); wr = cmul(wr, w); }
}
template <bool IN_REGS, bool HALF_ZERO, bool OUT_REGS> __device__ __forceinline__ void fft16k(LAS f32x2* Z, f32x2 (&v)[32], int tid) {
    asm volatile("" : "+v"(tid));
    LAS f32x2* Zt = Z + pidx(tid);
    if (!IN_REGS) {
#pragma unroll
        for (int r = 0; r < 32; ++r) v[r] = (HALF_ZERO && r >= 16) ? (f32x2){0.f, 0.f} : Zt[528 * r];
        __syncthreads(); }
    dft32<0>(v);
    { LAS f32x2* Zw = Z + 33 * tid;
#pragma unroll
      for (int q = 0; q < 32; ++q) Zw[q] = v[q]; }
    __syncthreads();
#pragma unroll
    for (int r = 0; r < 32; ++r) v[r] = Zt[528 * r];
    __syncthreads();
    twiddle_reg<32, 0>(v, tid & 31, 1.0f / 1024.0f); dft32<0>(v);
    { LAS f32x2* Zw = Z + (tid >> 5) * 1056 + (tid & 31);
#pragma unroll
      for (int q = 0; q < 32; ++q) Zw[33 * q] = v[q]; }
    __syncthreads();
#pragma unroll
    for (int h = 0; h < 2; ++h)
#pragma unroll
        for (int r = 0; r < 16; ++r) v[h * 16 + r] = Zt[528 * h + 1056 * r];
    __syncthreads();
    twiddle_reg<16, 0>(v, tid, 1.0f / 16384.0f); twiddle_reg<16, 16>(v, tid + 512, 1.0f / 16384.0f); dft16<0>(v); dft16<16>(v);
    if (!OUT_REGS) {
#pragma unroll
        for (int h = 0; h < 2; ++h)
#pragma unroll
            for (int q = 0; q < 16; ++q) Zt[528 * h + 1056 * q] = v[h * 16 + q];
        __syncthreads(); }
}
__device__ __forceinline__ void filt_spectra_unit(const Frame& F_, const Args& A, int u) {
    const Frame F = fresh(F_);
    const float* KT = WSP(float, WS_KT); f32x2* PM = WSP(f32x2, WS_PM); LAS f32x2* Z = (LAS f32x2*)F.lds; LAS float* red = (LAS float*)(F.lds + RED_OFF); constexpr int PMS = 8704;
    { const int o = u / 768, p = u - o * 768;
        const f32x2* kab = (const f32x2*)KT + ((size_t)o * (WMIX / 2) + p) * FFTN + F.tid;
        f32x2 v[32]; float sa = 0.f, sb = 0.f;
#pragma unroll
        for (int r = 0; r < 32; ++r) { v[r] = kab[512 * r]; sa += v[r].x * v[r].x; sb += v[r].y * v[r].y; }
        sa = wave_sum(sa); sb = wave_sum(sb);
        __syncthreads();
        if (F.lane == 0) { red[F.wave * 2] = sa; red[F.wave * 2 + 1] = sb; }
        __syncthreads();
        float ta = 0.f, tb = 0.f;
#pragma unroll
        for (int w = 0; w < 8; ++w) { ta += red[w * 2]; tb += red[w * 2 + 1]; }
        const float na = rsqrtf(ta + EPSN) * 0.5f, nb = rsqrtf(tb + EPSN) * 0.5f;
#pragma unroll
        for (int r = 0; r < 32; ++r) { const float a = v[r].x * na, b = v[r].y * nb; v[r] = (f32x2){a + b, a - b}; }
        fft16k<true, false, false>(Z, v, F.tid);
        f32x4* pm4 = (f32x4*)PM + (size_t)(o * 768 + p) * PMS;
#pragma unroll 4
        for (int i = 0; i < 16; ++i) { const int k = F.tid + 512 * i, km = (FFTN - k) & (FFTN - 1); const f32x2 wk = Z[pidx(k)], wm = Z[pidx(km)];
            pm4[k] = (f32x4){0.5f * (wk.x + wm.x), 0.5f * (wk.y - wm.y), 0.5f * (wk.y + wm.y), -0.5f * (wk.x - wm.x)}; }
        if (F.tid == 0) { const f32x2 wk = Z[pidx(FFTN / 2)]; pm4[FFTN / 2] = (f32x4){wk.x, 0.f, wk.y, 0.f}; }
    }
    __syncthreads();
}
__device__ __forceinline__ void filler(const Frame& F, const Args& A, int kind, int flayer, int base, int j, int nidle, int quota) {
    if (j < 0) return;
    const int total = (kind == 1) ? 1024 : 1536;
#pragma unroll 1
    for (int m = 0; m < quota; ++m) { const int u = base + j + nidle * m; if (u >= total || u >= base + nidle * quota) break;
        if (kind == 1) filt_taps_unit(F, A, flayer, u); else filt_spectra_unit(F, A, u); }
}
__device__ __forceinline__ void hyena_conv_unit(const Frame& F_, const Args& A, int layer, int p) {
    const Frame F = fresh(F_);
    const unsigned* VT2 = WSP(unsigned, WS_VT)  ; unsigned* YBT2 = WSP(unsigned, WS_YBT)  ; const f32x4* PM4 = WSP(f32x4, WS_PM); LAS f32x2* Z = (LAS f32x2*)F.lds; constexpr int PMS = 8704;
    const int tid = F.tid; const float* skip = inp(A, I_HSKIP) + (size_t)layer * 2 * WMIX;
    LAS f32x2* Zt = Z + pidx(tid);
    f32x2 v[32];
    __syncthreads();
    { const unsigned* v0 = VT2 + (size_t)p * SEQ + tid;
#pragma unroll
      for (int r = 0; r < 16; ++r) { const unsigned w = v0[512 * r]; Zt[528 * r] = (f32x2){bflo(w), bfhi(w)}; } }
    __syncthreads();
#pragma unroll 1
    for (int o = 0; o < 2; ++o) {
        const f32x4* pmp = PM4 + (size_t)(o * 768 + p) * PMS;
        f32x4 pm[16];
#pragma unroll
        for (int i = 0; i < 16; ++i) pm[i] = pmp[tid + 512 * i];
        const f32x4 pmh = pmp[FFTN / 2];
        fft16k<false, true, false>(Z, v, tid);
#pragma unroll
        for (int i = 0; i < 16; ++i) { const int k = tid + 512 * i, km = (FFTN - k) & (FFTN - 1); const f32x2 zk = Zt[528 * i], zm = Z[pidx(km)];
            const f32x2 pk = {pm[i].x, pm[i].y}, mk = {pm[i].z, pm[i].w};
            const f32x2 cyk = cmul((f32x2){zk.x, -zk.y}, (f32x2){pk.x, -pk.y}) + cmul(zm, (f32x2){mk.x, -mk.y});
            const f32x2 cym = cmul((f32x2){zm.x, -zm.y}, pk) + cmul(zk, mk);
            Zt[528 * i] = cyk; if (km != k) Z[pidx(km)] = cym; }
        if (tid == 0) { const int k = FFTN / 2; const f32x2 zk = Z[pidx(k)]; const f32x2 pk = {pmh.x, pmh.y}, mk = {pmh.z, pmh.w};
            Z[pidx(k)] = cmul((f32x2){zk.x, -zk.y}, (f32x2){pk.x, -pk.y}) + cmul(zk, (f32x2){mk.x, -mk.y}); }
        __syncthreads();
        const unsigned* gp = VT2 + ((size_t)(o + 1) * (WMIX / 2) + p) * SEQ + tid;
        const unsigned* zp = ((o == 0) ? VT2 : (const unsigned*)YBT2) + (size_t)p * SEQ + tid;
        unsigned gg[16], zz[16];
#pragma unroll
        for (int h = 0; h < 2; ++h)
#pragma unroll
            for (int q = 0; q < 8; ++q) { const int dt = 512 * h + 1024 * q; gg[h * 8 + q] = gp[dt]; zz[h * 8 + q] = zp[dt]; }
        fft16k<false, false, true>(Z, v, tid);
        const float ska = skip[o * WMIX + 2 * p], skb = skip[o * WMIX + 2 * p + 1];
        unsigned* yo = YBT2 + (size_t)p * SEQ + tid;
#pragma unroll
        for (int h = 0; h < 2; ++h)
#pragma unroll
            for (int q = 0; q < 8; ++q) { const f32x2 R = v[h * 16 + q], g = {bflo(gg[h * 8 + q]), bfhi(gg[h * 8 + q])}, z = {bflo(zz[h * 8 + q]), bfhi(zz[h * 8 + q])};
                const f32x2 zn = {g.x * (R.x * (1.0f / FFTN) + ska * z.x), g.y * (-R.y * (1.0f / FFTN) + skb * z.y)};
                const unsigned zw = pk2(zn.x, zn.y); yo[512 * h + 1024 * q] = zw; if (o == 0) Zt[528 * h + 1056 * q] = (f32x2){bflo(zw), bfhi(zw)}; }
        __syncthreads();
    }
}
#ifdef PROBE_FFT
__device__ __forceinline__ void hyena_fft_dummy(const Frame& F_) {
    const Frame F = fresh(F_); LAS f32x2* Z = (LAS f32x2*)F.lds; f32x2 v[32];
    __syncthreads();
#pragma unroll 1
    for (int o = 0; o < 2; ++o) { fft16k<false, true, false>(Z, v, F.tid); fft16k<false, false, true>(Z, v, F.tid);
        if (v[0].x == 123456.789f) Z[0] = v[5];
        __syncthreads(); }
}
#endif
__device__ __forceinline__ void hyena_ctx_unit(const Frame& F_, const Args& A, int layer, int u) {
    const Frame F = fresh(F_);
    const float* UC = WSP(float, WS_UC); const float* KC = WSP(float, WS_KC); const float* KCN = WSP(float, WS_KCN); bf16* YB = WSP(bf16, WS_YB);
    LAS float* zb0 = (LAS float*)F.lds; LAS float* zb1 = zb0 + 256 * 32;
    const int cl = F.tid & 31, tb = F.tid >> 5, c = u * 32 + cl, t0 = tb * 16; const float* skip = inp(A, I_HSKIP) + (size_t)layer * 2 * WMIX;
    float zc[16], g1[16], g2[16];
    __syncthreads();
#pragma unroll
    for (int i = 0; i < 16; ++i) { zc[i] = UC[((size_t)0 * CTXL + t0 + i) * WMIX + c]; g1[i] = UC[((size_t)1 * CTXL + t0 + i) * WMIX + c]; g2[i] = UC[((size_t)2 * CTXL + t0 + i) * WMIX + c]; zb0[(t0 + i) * 32 + cl] = zc[i]; }
    __syncthreads();
#pragma unroll
    for (int o = 0; o < 2; ++o) { const LAS float* zb = o ? zb1 : zb0; const float* kc = KC + (size_t)o * 512 * WMIX + c; float acc[16];
#pragma unroll
        for (int i = 0; i < 16; ++i) acc[i] = 0.f;
#pragma unroll 1
        for (int s0 = 0; s0 < CTXL; s0 += 16) { float w[31]; const float* kb = kc + (size_t)(255 + t0 - s0 - 15) * WMIX;
#pragma unroll
            for (int q = 0; q < 31; ++q) w[q] = kb[(size_t)q * WMIX];
#pragma unroll
            for (int j = 0; j < 16; ++j) { const float zs = zb[(s0 + j) * 32 + cl];
#pragma unroll
                for (int i = 0; i < 16; ++i) acc[i] += w[15 + i - j] * zs; } }
        const float kn = KCN[o * WMIX + c], sk = skip[o * WMIX + c];
#pragma unroll
        for (int i = 0; i < 16; ++i) { const float zn = (o ? g2[i] : g1[i]) * (acc[i] * kn + sk * zc[i]);
            if (o == 0) { zc[i] = zn; zb1[(t0 + i) * 32 + cl] = zn; } else YB[(size_t)(t0 + i) * WMIX + c] = (bf16)f2bf(zn); }
        __syncthreads(); }
}
__device__ __forceinline__ void lru_chunk_agg(const Frame& F_, const Args& A) {
    const Frame F = fresh(F_);
    const unsigned* LAB = WSP(unsigned, WS_LA); float* CA = WSP(float, WS_CA); float* CB = WSP(float, WS_CB);
    for (int u = F.gw; u < NCHUNK * 12; u += F.ngw) { const int chunk = u / 12, rem = u - chunk * 12, dir = rem / 6, c = (rem - dir * 6) * 256 + 4 * F.lane;
        const unsigned* pab = LAB + (((size_t)dir * NCHUNK + chunk) * 6 + (c >> 8)) * 64 * 256 + (c & 255);
        f32x4 Aa = {1.f, 1.f, 1.f, 1.f}, B = {0.f, 0.f, 0.f, 0.f};
#pragma unroll 32
        for (int i = 0; i < 64; ++i) { const int rr = dir ? 63 - i : i; const v4u w = *(const v4u*)(pab + rr * 256);
            const f32x4 a = {__expf(bflo(w.x)), __expf(bflo(w.y)), __expf(bflo(w.z)), __expf(bflo(w.w))}, b = {bfhi(w.x), bfhi(w.y), bfhi(w.z), bfhi(w.w)}; B = a * B + b; Aa = Aa * a; }
        *(f32x4*)(CA + ((size_t)dir * NCHUNK + chunk) * WMIX + c) = Aa; *(f32x4*)(CB + ((size_t)dir * NCHUNK + chunk) * WMIX + c) = B; }
}
__device__ __forceinline__ void lru_carries(const Frame& F_, const Args& A) {
    const Frame F = fresh(F_);
    const float* CA = WSP(float, WS_CA); const float* CB = WSP(float, WS_CB); float* CIN = WSP(float, WS_CIN);
    const int slot = F.bid >> 3; if ((F.bid & 7) != 1 || slot < 4 || slot >= 10) return;
    { const int u = (slot - 4) * 8 + F.wave; const int dir = u / 24, c = (u - dir * 24) * 64 + F.lane; float H = 0.f;
#pragma unroll 1
        for (int i0 = 0; i0 < NCHUNK; i0 += 22) { float ca[22], cb[22];
#pragma unroll
            for (int j = 0; j < 22; ++j) { const int i = i0 + j, chunk = dir ? ((i < 4) ? 3 - i : NCHUNK + 3 - i) : i; const size_t ix = ((size_t)dir * NCHUNK + chunk) * WMIX + c; ca[j] = CA[ix]; cb[j] = CB[ix]; }
#pragma unroll
            for (int j = 0; j < 22; ++j) { const int i = i0 + j, chunk = dir ? ((i < 4) ? 3 - i : NCHUNK + 3 - i) : i; const size_t ix = ((size_t)dir * NCHUNK + chunk) * WMIX + c; CIN[ix] = H; H = ca[j] * H + cb[j]; } } }
}
__device__ __forceinline__ void lru_out(const Frame& F_, const Args& A) {
    const Frame F = fresh(F_);
    const unsigned* LAB = WSP(unsigned, WS_LA); const float* CIN = WSP(float, WS_CIN); const bf16* P = WSP(bf16, WS_P); bf16* YA = WSP(bf16, WS_YA);
    for (int u = F.gw; u < NCHUNK * 12; u += F.ngw) { const int chunk = u / 12, c = (u - chunk * 12) * 128 + 2 * F.lane, base = chunk * 64;
        const unsigned* pf = LAB + (((size_t)chunk) * 6 + (c >> 8)) * 64 * 256 + (c & 255); const unsigned* pr = pf + (size_t)NCHUNK * 6 * 64 * 256;
        f32x2 hf[64]; f32x2 H = *(const f32x2*)(CIN + ((size_t)chunk) * WMIX + c);
#pragma unroll
        for (int i = 0; i < 64; ++i) { const v2u w = *(const v2u*)(pf + i * 256); H = (f32x2){__expf(bflo(w.x)), __expf(bflo(w.y))} * H + (f32x2){bfhi(w.x), bfhi(w.y)}; hf[i] = H; }
        H = *(const f32x2*)(CIN + ((size_t)NCHUNK + chunk) * WMIX + c);
#pragma unroll
        for (int i = 63; i >= 0; --i) { const v2u w = *(const v2u*)(pr + i * 256); H = (f32x2){__expf(bflo(w.x)), __expf(bflo(w.y))} * H + (f32x2){bfhi(w.x), bfhi(w.y)};
            const unsigned gw = *(const unsigned*)(P + (size_t)(base + i) * NIN + COL_AG + c); const f32x2 y = (hf[i] + H) * (f32x2){bflo(gw), bfhi(gw)};
            *(unsigned*)(YA + (size_t)(base + i) * WMIX + c) = pk2(y.x, y.y); } }
}
__device__ __forceinline__ void yb_transpose(const Frame& F_, const Args& A) {
    const Frame F = fresh(F_);
    const float* YBT = WSP(float, WS_YBT); bf16* YB = WSP(bf16, WS_YB); LAS float* scr = (LAS float*)(F.lds + F.wave * WSCR_BYTES);
    for (int u = F.gw; u < (SEQ / 64) * 24; u += F.ngw) { const int tb = u / 24, c0 = (u - tb * 24) * 64, t0 = tb * 64;
#pragma unroll
        for (int i = 0; i < 32; ++i) { const unsigned y = ((const unsigned*)YBT)[(size_t)((c0 >> 1) + i) * SEQ + t0 + F.lane]; scr[(2 * i) * 65 + F.lane] = bflo(y); scr[(2 * i + 1) * 65 + F.lane] = bfhi(y); }
        LDS_WAIT(); asm volatile("" ::: "memory");
#pragma unroll
        for (int g8 = 0; g8 < 8; ++g8) { const int tt = 8 * g8 + (F.lane >> 3), c8 = (F.lane & 7) * 8; const LAS float* sp = scr + c8 * 65 + tt;
            *(v4u*)(YB + (size_t)(CTXL + t0 + tt) * WMIX + c0 + c8) = (v4u){pk2(sp[0], sp[65]), pk2(sp[130], sp[195]), pk2(sp[260], sp[325]), pk2(sp[390], sp[455])}; }
        LDS_WAIT(); asm volatile("" ::: "memory"); }
}
__device__ __forceinline__ void attn_phase(const Frame& F_, const Args& A, bool with_ctx, char* lds) {
    const Frame F = fresh(F_);
    const att::bf16* QN = WSP(att::bf16, WS_QN); const att::bf16* KN = WSP(att::bf16, WS_KN); const att::bf16* VN = WSP(att::bf16, WS_VN); bf16* YC = WSP(bf16, WS_YC);
    const int x = F.bid & 7, slot = F.bid >> 3, kvh = x >> 1, per = F.G >> 2;
    const int nunits = 3 * (with_ctx ? 33 : 32);
    for (int idx = (x & 1) * (F.G >> 3) + slot; idx < nunits; idx += per) { const int qh = kvh * 3 + idx % 3, qb = idx / 3;
        const int row0 = (qb < 32) ? CTXL + qb * 256 : 0, seq = (qb < 32) ? MROWS : CTXL;
        __syncthreads();
        att::attn_dense_body<att::bf16>(QN + (size_t)row0 * WMIX + qh * 128, KN + kvh * 128, VN + kvh * 128, YC + (size_t)row0 * WMIX + qh * 128, seq, lds, F.tid);
    }
    __syncthreads();
}
#ifndef GEMM_SP2
#define GEMM_SP2 true
#endif
#ifndef GEMM_ALIGN
#define GEMM_ALIGN true
#endif
#ifndef WIN_WGM
#define WIN_WGM 4
#endif
#ifndef KH_CTX
#define KH_CTX 1
#endif
#ifndef KH_LAST
#define KH_LAST 0
#endif
#ifndef WIN_NS
#define WIN_NS 1
#endif
#ifndef UP1_QUOTA
#define UP1_QUOTA 2
#endif
#ifndef WIN_SLABS
#define WIN_SLABS 2
#endif
#ifndef MERGE_ALIGN
#define MERGE_ALIGN GEMM_ALIGN
#endif
#ifndef RESID_ALIGN
#define RESID_ALIGN GEMM_ALIGN
#endif
#ifndef MK_PER_PHASE
#define MK_PER_PHASE 0
#endif
constexpr int PH_PER_LAYER = 15, PH_LAYER0 = 2, PH_FINAL = PH_LAYER0 + DEPTH * PH_PER_LAYER, N_PHASES = PH_FINAL + 1;

__global__ void __launch_bounds__(NWAVES * 64, 2) mk_fwd(Args A) {
    extern __shared__ __attribute__((aligned(16))) unsigned char lds[];
    Frame F;
    F.lds = (LAS unsigned char*)lds; F.ws = (unsigned char*)(GAS unsigned char*)A.ws; F.out = (float*)(GAS float*)A.out;
    F.tid = threadIdx.x; F.lane = F.tid & 63; F.wave = __builtin_amdgcn_readfirstlane((int)threadIdx.x >> 6);
    F.G = gridDim.x; F.bid = blockIdx.x; F.gw = blockIdx.x * NWAVES + F.wave; F.ngw = F.G * NWAVES;
    volatile LAS unsigned* MISC = (volatile LAS unsigned*)(F.lds + MISC_OFF);
    for (int u = F.tid; u < (LDS_BYTES - LDSCTL_OFF) / 4; u += NWAVES * 64) ((LAS unsigned*)(F.lds + LDSCTL_OFF))[u] = 0u;
    __syncthreads();
    gu32* ctl = (gu32*)(F.ws + WS_CTL);
    XcdBarrier bar = xcd_barrier_post((unsigned*)(ctl + CW_BAR), MISC + 8);
    const int lo = A.ph_lo, hi = A.ph_hi;
#define IN(k) (lo <= (k) && (k) < hi)
#ifndef EN_MASK
#define EN_MASK 0xffffffffu
#endif
#define EN(b) ((EN_MASK >> (b)) & 1u)
#ifndef REP_MASK
#define REP_MASK 0u
#endif
#define REPS(b) (((REP_MASK >> (b)) & 1u) ? 2 : 1)
#ifdef PROBE_BAR
#define SEAM(k) do { if (IN(k) && IN((k) + 1)) { xcd_barrier(bar); xcd_barrier(bar); } } while (0)
#else
#define SEAM(k) do { if (IN(k) && IN((k) + 1)) xcd_barrier(bar); } while (0)
#endif
    LAS unsigned char* ring = F.lds + RING_OFF;

    if (EN(0) && IN(0)) { for (int rep_ = 0; rep_ < REPS(0); ++rep_) prologue_a(F, A); filt_mlp(F, A, 0, true); }
    SEAM(0);
    if (EN(1) && IN(1)) { prologue_b(F, A); { const Frame L = fresh(F); for (int u = L.bid; u < 1024; u += L.G) filt_taps_unit(F, A, 0, u); } filt_taps_ctx(F, A, 0); }
    SEAM(1);

    for (int layer = 0; layer < DEPTH; ++layer) {
        const int pb = PH_LAYER0 + layer * PH_PER_LAYER;
        if (!(lo < pb + PH_PER_LAYER && pb < hi)) continue;
        const bool ctx_out = layer < DEPTH - 1;
        const int roff = ctx_out ? 0 : CTXL;
        unsigned char* wb = F.ws + WS_W + (size_t)layer * W_LAYER;
        const float* modL = WSP(float, WS_MOD) + (size_t)(layer * 2 + 0) * NMOD * DM; const float* modC = modL + (size_t)NMOD * DM;
        bf16* U = WSP(bf16, WS_U); bf16* H = WSP(bf16, WS_H); float* X = WSP(float, WS_X); bf16* P = WSP(bf16, WS_P);
        for (int half = 0; half < 2; ++half) {
            const int p0 = pb + (half ? 12 : 0), im = half ? 6 : 0;
            if (EN(2) && IN(p0)) { for (int rep_ = 0; rep_ < REPS(2); ++rep_) { __syncthreads(); norm_phase(F, A, inp(A, half ? I_NF2 : I_NF1) + (size_t)layer * DM, modL, modC, im + 0, im + 1, half ? roff : (layer == 0 ? MROWS : 0));
                if (!half && layer == 0) { const Frame L = fresh(F); for (int u = L.bid; u < 480; u += L.G) filt_spectra_unit(F, A, u); }
                if (half && layer + 1 < DEPTH - 1) filt_taps_ctx(F, A, layer + 1); } }
            SEAM(p0);
            const int hro = half ? roff : 0; const size_t hoff = (size_t)hro * DM;
            if (EN(3) && IN(p0 + 1)) { for (int rep_ = 0; rep_ < REPS(3); ++rep_) { __syncthreads(); pg8::Gemm g{U + hoff, (const bf16*)(wb + (half ? WO_GU2 : WO_GU1)), MROWS - hro, 2 * DFF, DM}; pg8::StaticOrder S; S.init(MROWS - hro, 2 * DFF, F.G, fresh(F).bid);
                pg8::EpiSwiglu E{H + hoff, DFF}; pg8::gemm_phase<pg8::EpiSwiglu, pg8::StaticOrder, GEMM_ALIGN, GEMM_SP2>(ring, g, S, E, fresh(F).tid);
                if (!half) filler(F, A, 2, layer, 480, fresh(F).bid - 32, 224, UP1_QUOTA); else if (layer + 1 < DEPTH) filler(F, A, 1, layer + 1, 960, fresh(F).bid - 32, 224, 1); } }
            SEAM(p0 + 1);
            if (EN(4) && IN(p0 + 2)) for (int rep_ = 0; rep_ < REPS(4); ++rep_) { __syncthreads(); pg8::Gemm g{H + hoff, (const bf16*)(wb + (half ? WO_D2 : WO_D1)), MROWS - hro, DM, DFF}; pg8::StaticOrder S; S.init(MROWS - hro, DM, F.G, fresh(F).bid);
                pg8::EpiResid E{WSP(bf16, WS_M32) + hoff, DM, modL + (im + 2) * DM, (hro ? modL : modC) + (im + 2) * DM, 0.5f}; pg8::gemm_phase<pg8::EpiResid, pg8::StaticOrder, RESID_ALIGN, GEMM_SP2>(ring, g, S, E, fresh(F).tid);
                if (!half) filler(F, A, 2, layer, 928, fresh(F).bid - 16, 240, 2); else if (layer + 1 < DEPTH) filler(F, A, 2, layer + 1, 0, fresh(F).bid - 16, 240, 2); }
            if (half) { SEAM(p0 + 2); continue; }
            SEAM(p0 + 2);
            if (EN(5) && IN(pb + 3)) { for (int rep_ = 0; rep_ < REPS(5); ++rep_) { __syncthreads(); norm_phase(F, A, inp(A, I_NMIX) + (size_t)layer * DM, modL, modC, 3, 4, 0); } }
            SEAM(pb + 3);
            if (EN(6) && IN(pb + 4)) { for (int rep_ = 0; rep_ < REPS(6); ++rep_) { __syncthreads();
                constexpr int NSL = WIN_SLABS, NT_SL = (NIN / 256) / NSL, R_SL = (33 * NT_SL) % 256;
#pragma unroll 1
                for (int sl = 0; sl < NSL; ++sl) { pg8::Gemm g{U, (const bf16*)(wb + WO_IN) + (size_t)sl * (NT_SL * 256) * DM, MROWS, NT_SL * 256, DM}; pg8::StaticOrder S; S.init(MROWS, NT_SL * 256, F.G, fresh(F).bid); S.wgm = WIN_WGM;
                    pg8::EpiWin E{P, NIN, sl * NT_SL}; pg8::gemm_phase<pg8::EpiWin, pg8::StaticOrder, GEMM_ALIGN, GEMM_SP2>(ring, g, S, E, fresh(F).tid); }
                filler(F, A, 2, layer, 1408, fresh(F).bid - R_SL, 256 - R_SL, (168 + 255 - R_SL) / (256 - R_SL)); } }
            SEAM(pb + 4);
            if (EN(7) && IN(pb + 5)) { for (int rep_ = 0; rep_ < REPS(7); ++rep_) { __syncthreads(); prep_lru_conv(F, A, layer); prep_qkv(F, A, layer); prep_hyena_t(F, A, layer); if (ctx_out) { prep_hyena_ctx(F, A, layer); filt_norm_ctx(F, A); } } }
            SEAM(pb + 5);
            if (EN(8) && IN(pb + 6)) { for (int rep_ = 0; rep_ < REPS(8); ++rep_) { __syncthreads(); int klru = 256; asm volatile("" : "+s"(klru));
                pg8::Gemm g{WSP(bf16, WS_XA), (const bf16*)(wb + WO_LRU), 6 * MROWS, 6 * 1024, klru}; pg8::LruOrder S; S.init(F.G, fresh(F).bid);
                pg8::EpiLru E{WSP(float, WS_LA), WSP(float, WS_LB), WSP(bf16, WS_XA), inp(A, I_LBA) + (size_t)layer * 2 * WMIX, inp(A, I_LBX) + (size_t)layer * 2 * WMIX, WSP(float, WS_MOD + 1536 * 1024) + (size_t)layer * 2 * WMIX, MROWS, WSP(float, WS_CA), WSP(float, WS_CB)};
                pg8::gemm_phase<pg8::EpiLru, pg8::LruOrder, GEMM_ALIGN, GEMM_SP2>(ring, g, S, E, fresh(F).tid); } }
            SEAM(pb + 6);
            if (EN(9) && IN(pb + 7)) {   }
            if (EN(10) && IN(pb + 8)) { for (int rep_ = 0; rep_ < REPS(10); ++rep_) { __syncthreads();
                lru_carries(F, A);
                if (EN(17)) for (int r2_ = 0; r2_ < REPS(17); ++r2_) attn_phase(F, A, ctx_out, (char*)lds);
                { const Frame L = fresh(F); const int x = L.bid & 7, slot = L.bid >> 3, nunits = 3 * (ctx_out ? 33 : 32), thr = nunits - 96, KH = ctx_out ? KH_CTX : KH_LAST;
                  const bool light = (x & 1) && slot >= thr; const int nh = 128 + 4 * thr, nl = 4 * (32 - thr), total = 768 + (ctx_out ? 48 : 0);
                  const int hi_ = (x & 1) ? 128 + (x >> 1) * thr + slot : (x >> 1) * 32 + slot, li = (x >> 1) * (32 - thr) + (slot - thr);
                  for (int r2_ = 0; r2_ < REPS(18); ++r2_)
                  for (int m = 0; ; ++m) { int u; if (light) { u = KH * nh + li + nl * m; if (u >= total) break; } else { if (m >= KH) break; u = hi_ + nh * m; if (u >= total) break; }
                      if (u < 768) { if (EN(18)) hyena_conv_unit(F, A, layer, u);
#ifdef PROBE_FFT
                          hyena_fft_dummy(F);
#endif
                      } else { if (EN(19)) hyena_ctx_unit(F, A, layer, u - 768); } } }
            } }
            SEAM(pb + 8);
            if (EN(11) && IN(pb + 9)) { for (int rep_ = 0; rep_ < REPS(11); ++rep_) { __syncthreads(); lru_out(F, A); yb_transpose(F, A); if (layer + 1 < DEPTH) filt_mlp(F, A, layer + 1, layer + 1 < DEPTH - 1); } }
            SEAM(pb + 9);
            if (EN(12) && IN(pb + 10)) { for (int rep_ = 0; rep_ < REPS(12); ++rep_) { __syncthreads(); const bf16* WB = (const bf16*)(wb + WO_BR); float* M32 = WSP(float, WS_M32) + (size_t)roff * DM; pg8::StaticOrder S; S.init(MROWS - roff, DM, F.G, fresh(F).bid);
                const size_t yo = (size_t)roff * WMIX; bf16* Hm = H + (size_t)roff * DM; const bf16* Pg = P + (size_t)roff * NIN + COL_G; const int Mm = MROWS - roff;
                { pg8::Gemm g{WSP(bf16, WS_YA) + yo, WB, Mm, DM, WMIX}; pg8::EpiMerge<0> E{M32, Hm, Pg, NIN}; pg8::gemm_phase<pg8::EpiMerge<0>, pg8::StaticOrder, MERGE_ALIGN, GEMM_SP2>(ring, g, S, E, fresh(F).tid); }
                { pg8::Gemm g{WSP(bf16, WS_YB) + yo, WB + (size_t)DM * WMIX, Mm, DM, WMIX}; pg8::EpiMerge<1> E{M32, Hm, Pg + DM, NIN}; pg8::gemm_phase<pg8::EpiMerge<1>, pg8::StaticOrder, MERGE_ALIGN, GEMM_SP2>(ring, g, S, E, fresh(F).tid); }
                { pg8::Gemm g{WSP(bf16, WS_YC) + yo, WB + (size_t)2 * DM * WMIX, Mm, DM, WMIX}; pg8::EpiMerge<2> E{M32, Hm, Pg + 2 * DM, NIN}; pg8::gemm_phase<pg8::EpiMerge<2>, pg8::StaticOrder, MERGE_ALIGN, GEMM_SP2>(ring, g, S, E, fresh(F).tid); }
                if (layer + 1 < DEPTH) filler(F, A, 1, layer + 1, 0, fresh(F).bid - 16, 240, 2); } }
            SEAM(pb + 10);
            if (EN(13) && IN(pb + 11)) for (int rep_ = 0; rep_ < REPS(13); ++rep_) { __syncthreads(); pg8::Gemm g{H + (size_t)roff * DM, (const bf16*)(wb + WO_OUT), MROWS - roff, DM, DM}; pg8::StaticOrder S; S.init(MROWS - roff, DM, F.G, fresh(F).bid);
                pg8::EpiResid E{WSP(bf16, WS_M32) + (size_t)roff * DM, DM, modL + 5 * DM, (roff ? modL : modC) + 5 * DM, 1.0f}; pg8::gemm_phase<pg8::EpiResid, pg8::StaticOrder, RESID_ALIGN, GEMM_SP2>(ring, g, S, E, fresh(F).tid);
                if (layer + 1 < DEPTH) filler(F, A, 1, layer + 1, 480, fresh(F).bid - 16, 240, 2); }
            SEAM(pb + 11);
        }
    }
#ifdef DUMP
    if (IN(PH_FINAL)) dump_phase(F, A);
#else
    if (EN(14) && IN(PH_FINAL)) final_norm_phase(F, A);
#endif
#undef IN
#undef SEAM
}

extern "C" void kernel_launch(void* const* d_in, const int* in_sizes, int n_in, void* d_out, int out_size, void* d_ws, size_t ws_size, hipStream_t stream) {
    static int grid = 0;
    if (grid == 0) {
        if (n_in != N_IN_TENSORS || in_sizes[0] != SEQ * DM || out_size != SEQ * DM || ws_size < WS_END) {
            fprintf(stderr, "kernel_launch: shape mismatch: n_in %d in0 %d out %d ws %zu (need %zu)\n", n_in, n_in > 0 ? in_sizes[0] : -1, out_size, ws_size, (size_t)WS_END); grid = -1; return; }
        int dev = 0, cus = 0, per_cu = 0;
        if (hipGetDevice(&dev) != hipSuccess || hipDeviceGetAttribute(&cus, hipDeviceAttributeMultiprocessorCount, dev) != hipSuccess) { fprintf(stderr, "kernel_launch: device query failed\n"); grid = -1; return; }
        if (hipFuncSetAttribute((const void*)mk_fwd, hipFuncAttributeMaxDynamicSharedMemorySize, LDS_BYTES) != hipSuccess) { fprintf(stderr, "kernel_launch: hipFuncSetAttribute failed\n"); grid = -1; return; }
        if (hipOccupancyMaxActiveBlocksPerMultiprocessor(&per_cu, (const void*)mk_fwd, NWAVES * 64, LDS_BYTES) != hipSuccess || per_cu < 1)
            fprintf(stderr, "kernel_launch: note: occupancy query reports %d workgroups per CU\n", per_cu);
        (void)hipGetLastError();
        grid = cus;
        if (grid != 256) { fprintf(stderr, "kernel_launch: built for 256 CUs, found %d\n", cus); grid = -1; return; }
    }
    if (grid < 0) return;
    if (hipMemsetAsync((char*)d_ws + WS_CTL, 0, CTL_ZERO_BYTES, stream) != hipSuccess) { fprintf(stderr, "kernel_launch: memset failed\n"); return; }
    Args a{};
    for (int i = 0; i < N_IN_TENSORS; ++i) a.in[i] = (const float*)d_in[i];
    a.out = (float*)d_out; a.ws = (unsigned char*)d_ws;
#if MK_PER_PHASE
#ifndef STOP_PHASE
#define STOP_PHASE PH_FINAL
#endif
    for (int ph = 0; ph < N_PHASES; ++ph) { if (ph >= STOP_PHASE && ph != PH_FINAL) continue; a.ph_lo = ph; a.ph_hi = ph + 1; hipLaunchKernelGGL(mk_fwd, dim3(grid), dim3(NWAVES * 64), LDS_BYTES, stream, a); }
#else
    a.ph_lo = 0; a.ph_hi = N_PHASES; hipLaunchKernelGGL(mk_fwd, dim3(grid), dim3(NWAVES * 64), LDS_BYTES, stream, a);
#endif
    const hipError_t le = hipPeekAtLastError();
    if (le != hipSuccess) fprintf(stderr, "kernel_launch: launch failed: %s\n", hipGetErrorName(le));
}
```

```cpp
#include <hip/hip_runtime.h>
#include <hip/hip_bf16.h>
#include <cstdio>
#include <cstdint>
namespace pg8 {
#define PG8_LAS __attribute__((address_space(3)))
typedef unsigned short bf16_t;
typedef short bf16x8 __attribute__((ext_vector_type(8)));
typedef float f32x4 __attribute__((ext_vector_type(4)));
typedef unsigned u32x4 __attribute__((ext_vector_type(4)));
constexpr int BM = 256, BK = 64, HALF = 128, HTB = HALF * BK * 2  , STAGE_BYTES = 8 * HTB, NXCD = 8, WGM = 8;

__host__ __device__ __forceinline__ int lds_byte(int r, int c) { const int st = (r >> 4) * 2 + (c >> 5), rr = r & 15, cc = c & 31, ob = rr * 64 + cc * 2; return st * 1024 + (ob ^ (((ob >> 9) & 1) << 5)); }
__host__ __device__ __forceinline__ void stage_rc(int b, int& R, int& C) { const int st = b / 1024, sb = b % 1024, swz = sb ^ (((sb >> 9) & 1) << 5); R = (st >> 1) * 16 + swz / 64; C = (st & 1) * 32 + (swz % 64) / 2; }
__host__ __device__ __forceinline__ int perm32(int rho) { const int n = rho >> 4, i = rho & 15; return 8 * (i >> 2) + 4 * n + (i & 3); }

struct Unit { int pm, pn; };
struct Gemm { const bf16_t* A; const bf16_t* Bt; int M, N, K; };

struct StaticOrder {
    int nM, nN, nwg, G, c, wgm = WGM;
    __host__ __device__ void init(int M, int N, int G_, int c_) { nM = M / BM; nN = N / BM; nwg = nM * nN; G = G_; c = c_; }
    __host__ __device__ bool next(int i, Unit& u) const {
        const long L = (long)i * G + c; if (L >= nwg) return false;
        int wgid = (int)L; { const int q = nwg / NXCD, r = nwg % NXCD, xcd = wgid % NXCD, off = wgid / NXCD; wgid = (xcd < r ? xcd * (q + 1) : r * (q + 1) + (xcd - r) * q) + off; }
        const int nig = wgm * nN, gid = wgid / nig, fm = gid * wgm, gsz = (nM - fm) < wgm ? (nM - fm) : wgm;
        u.pm = fm + ((wgid % nig) % gsz); u.pn = (wgid % nig) / gsz; return true;
    }
    __device__ __forceinline__ void a_ready(const Unit&) const {}
    __device__ __forceinline__ void done(const Unit&) const {}
};
struct SplitNOrder {
    int nM, nNs, ns, nwg, G, c, wgm;
    __host__ __device__ void init(int M, int N, int NS, int G_, int c_, int wgm_) { nM = M / BM; ns = NS; nNs = (N / BM) / NS; nwg = nM * nNs * NS; G = G_; c = c_; wgm = wgm_; }
    __host__ __device__ bool next(int i, Unit& u) const {
        const long L = (long)i * G + c; if (L >= nwg) return false;
        int wgid = (int)L; { const int q = nwg / NXCD, r = nwg % NXCD, xcd = wgid % NXCD, off = wgid / NXCD; wgid = (xcd < r ? xcd * (q + 1) : r * (q + 1) + (xcd - r) * q) + off; }
        const int nMv = nM * ns, nig = wgm * nNs, gid = wgid / nig, fm = gid * wgm, gsz = (nMv - fm) < wgm ? (nMv - fm) : wgm;
        const int pv = fm + ((wgid % nig) % gsz), pnl = (wgid % nig) / gsz, slab = pv / nM;
        u.pm = pv - slab * nM; u.pn = slab * nNs + pnl; return true;
    }
    __device__ __forceinline__ void a_ready(const Unit&) const {}
    __device__ __forceinline__ void done(const Unit&) const {}
};
__device__ __forceinline__ unsigned cvt_pk_bf16(float lo, float hi) { unsigned r; asm volatile("v_cvt_pk_bf16_f32 %0, %1, %2" : "=v"(r) : "v"(lo), "v"(hi)); return r; }
typedef float f32x2 __attribute__((ext_vector_type(2)));
template <int MASK> __device__ __forceinline__ float swz_xor(float v) { return __int_as_float(__builtin_amdgcn_ds_swizzle(__float_as_int(v), (MASK << 10) | 0x1f)); }
__device__ __forceinline__ float fast_sigmoid(float x) { return __builtin_amdgcn_rcpf(1.0f + __expf(-x)); }
__device__ __forceinline__ float gelu_tanh(float x) { const float u = 0.7978845608028654f * (x + 0.044715f * x * x * x); return x * fast_sigmoid(2.0f * u); }
__device__ __forceinline__ float bf_lo(unsigned w) { return __uint_as_float(w << 16); }
__device__ __forceinline__ float bf_hi(unsigned w) { return __uint_as_float(w & 0xffff0000u); }

struct EpiSwiglu {
    static constexpr bool PERM = true, AFTER_DRAIN = false;
    bf16_t* O; int ldo;
    __device__ __forceinline__ void operator()(const f32x4 (&acc)[2][2][4][2], const Unit& u, int wr, int wc, int fr, int fq) const {
        const int row0 = u.pm * BM + wr * 64 + fr, col0 = u.pn * HALF + wc * 32 + 8 * fq;
#pragma unroll
        for (int ai = 0; ai < 2; ++ai)
#pragma unroll
            for (int m = 0; m < 4; ++m) { bf16_t* rowp = O + (size_t)(row0 + ai * HALF + m * 16) * ldo + col0;
                float v[8];
#pragma unroll
                for (int n = 0; n < 2; ++n)
#pragma unroll
                    for (int j = 0; j < 4; ++j) { const float a = acc[ai][0][m][n][j], b = acc[ai][1][m][n][j]; v[n * 4 + j] = a * fast_sigmoid(a) * b; }
                u32x4 w; w.x = cvt_pk_bf16(v[0], v[1]); w.y = cvt_pk_bf16(v[2], v[3]); w.z = cvt_pk_bf16(v[4], v[5]); w.w = cvt_pk_bf16(v[6], v[7]);
                *(u32x4*)rowp = w; }
    }
};
struct EpiResid {
    static constexpr bool PERM = true, AFTER_DRAIN = false;
    bf16_t* Dd; int ldd; const float* gate_lat; const float* gate_ctx; float coef;
    __device__ __forceinline__ void operator()(const f32x4 (&acc)[2][2][4][2], const Unit& u, int wr, int wc, int fr, int fq) const {
        const int row0 = u.pm * BM + wr * 64 + fr, col0 = u.pn * BM + wc * 32 + 8 * fq;
        const float* gate = (u.pm == 0) ? gate_ctx : gate_lat;
        f32x4 gv[2][2];
#pragma unroll
        for (int bj = 0; bj < 2; ++bj)
#pragma unroll
            for (int n = 0; n < 2; ++n) gv[bj][n] = *(const f32x4*)(gate + col0 + bj * HALF + 4 * n) * coef;
#pragma unroll
        for (int ai = 0; ai < 2; ++ai)
#pragma unroll
            for (int m = 0; m < 4; ++m) { bf16_t* rowp = Dd + (size_t)(row0 + ai * HALF + m * 16) * ldd + col0;
#pragma unroll
                for (int bj = 0; bj < 2; ++bj) { const f32x4 v0 = gv[bj][0] * acc[ai][bj][m][0], v1 = gv[bj][1] * acc[ai][bj][m][1];
                    u32x4 w; w.x = cvt_pk_bf16(v0[0], v0[1]); w.y = cvt_pk_bf16(v0[2], v0[3]); w.z = cvt_pk_bf16(v1[0], v1[1]); w.w = cvt_pk_bf16(v1[2], v1[3]);
                    *(u32x4*)(rowp + bj * HALF) = w; } }
    }
};
struct EpiWin {
    static constexpr bool PERM = true, AFTER_DRAIN = false;
    bf16_t* O; int ldo; int pn0;
    __device__ __forceinline__ void operator()(const f32x4 (&acc)[2][2][4][2], const Unit& u, int wr, int wc, int fr, int fq) const {
        const int pn = u.pn + pn0, row0 = u.pm * BM + wr * 64 + fr, col0 = pn * BM + wc * 32 + 8 * fq;
        const bool sig = pn >= 40, gel = (pn >= 10 && pn < 16);
        const float kx = sig ? 1.0f : (gel ? 2.0f * 0.7978845608028654f : 0.0f), k3 = gel ? 2.0f * 0.7978845608028654f * 0.044715f : 0.0f, k0 = (sig || gel) ? 0.0f : 80.0f;
#pragma unroll
        for (int ai = 0; ai < 2; ++ai)
#pragma unroll
            for (int m = 0; m < 4; ++m) { bf16_t* rowp = O + (size_t)(row0 + ai * HALF + m * 16) * ldo + col0;
#pragma unroll
                for (int bj = 0; bj < 2; ++bj) { float v[8];
#pragma unroll
                    for (int n = 0; n < 2; ++n)
#pragma unroll
                        for (int j = 0; j < 4; ++j) { const float x = acc[ai][bj][m][n][j]; const float t = k0 + x * (kx + k3 * x * x);
                            const float r = __builtin_amdgcn_rcpf(1.0f + __expf(-t)); v[n * 4 + j] = sig ? r : x * r; }
                    u32x4 w; w.x = cvt_pk_bf16(v[0], v[1]); w.y = cvt_pk_bf16(v[2], v[3]); w.z = cvt_pk_bf16(v[4], v[5]); w.w = cvt_pk_bf16(v[6], v[7]);
                    *(u32x4*)(rowp + bj * HALF) = w; } }
    }
};
struct LruOrder {
    int G, c;
    __host__ __device__ void init(int G_, int c_) { G = G_; c = c_; }
    __host__ __device__ bool next(int i, Unit& u) const { const int L = i * G + c; if (L >= 6 * 33 * 4) return false; const int pmv = L >> 2; u.pm = pmv; u.pn = (pmv / 33) * 4 + (L & 3); return true; }
    __device__ __forceinline__ void a_ready(const Unit&) const {}
    __device__ __forceinline__ void done(const Unit&) const {}
};
struct EpiLru {
    static constexpr bool PERM = true, AFTER_DRAIN = false;
    float* LA; float* LB; const bf16_t* XA; const float* b_a; const float* b_x; const float* lam;
    int M; float* CA; float* CB;
    __device__ __forceinline__ void operator()(const f32x4 (&acc)[2][2][4][2], const Unit& u, int wr, int wc, int fr, int fq) const {
        const int jb = u.pm / 33, pmr = u.pm - jb * 33, pnn = u.pn & 3, d = pnn >> 1, blk = 2 * jb + (pnn & 1);
        const int row0 = pmr * BM + wr * 64 + fr, c0 = blk * HALF + wc * 32 + 8 * fq;
        const float* pba = b_a + d * 1536 + c0; const float* pbx = b_x + d * 1536 + c0; const float* psp = lam + d * 1536 + c0;
#pragma unroll
        for (int ai = 0; ai < 2; ++ai) { float RA[8], RB[8];
#pragma unroll
            for (int m = 0; m < 4; ++m) { const size_t row = (size_t)(row0 + ai * HALF + m * 16);
                const bf16_t* xp = XA + ((size_t)jb * M + row) * 256 + (c0 - 256 * jb);
                unsigned* pab = (unsigned*)LA + ((((size_t)d * (M >> 6) + (row >> 6)) * 6 + (c0 >> 8)) * 64 + (row & 63)) * 256 + (c0 & 255);
#pragma unroll
                for (int n = 0; n < 2; ++n) { const f32x4 ba = *(const f32x4*)(pba + 4 * n), bx = *(const f32x4*)(pbx + 4 * n), sp = *(const f32x4*)(psp + 4 * n);
                    const unsigned long long xw = *(const unsigned long long*)(xp + 4 * n); const unsigned x01 = (unsigned)xw, x23 = (unsigned)(xw >> 32);
                    const float xa[4] = {bf_lo(x01), bf_hi(x01), bf_lo(x23), bf_hi(x23)};
                    u32x4 ab;
#pragma unroll
                    for (int j = 0; j < 4; ++j) {
                        const float r = fast_sigmoid(acc[ai][0][m][n][j] + ba[j]), ig = fast_sigmoid(acc[ai][1][m][n][j] + bx[j]);
                        const float la = -sp[j] * r, x2 = 2.0f * la;
                        const float em = (x2 > -0.5f) ? -x2 * (1.0f + x2 * (0.5f + x2 * (0.16666667f + x2 * (0.041666668f + x2 * (0.0083333338f + x2 * 0.0013888889f))))) : 1.0f - __expf(x2);
                        ab[j] = cvt_pk_bf16(la, sqrtf(fmaxf(em, 0.0f)) * (ig * xa[j])); }
                    *(u32x4*)(pab + 4 * n) = ab;
#pragma unroll
                    for (int j = 0; j < 4; ++j) { float a = __expf(bf_lo(ab[j])), b = bf_hi(ab[j]);
#define LRU_STEP(S_) { const float pa = swz_xor<S_>(a), pb = swz_xor<S_>(b); const bool mine_first = (((fr & S_) == 0) != (d == 1)); b = mine_first ? (pa * b + pb) : (a * pb + b); a = a * pa; }
                        LRU_STEP(1) LRU_STEP(2) LRU_STEP(4) LRU_STEP(8)
#undef LRU_STEP
                        const int e = n * 4 + j;
                        if (m == 0) { RA[e] = a; RB[e] = b; } else { const float f0 = a * RB[e] + b, f1 = RA[e] * b + RB[e]; RB[e] = (d == 0) ? f0 : f1; RA[e] = RA[e] * a; } }
                    asm volatile("" ::: "memory"); }
                asm volatile("" ::: "memory"); }
            { const size_t ci = ((size_t)d * (M >> 6) + ((row0 + ai * HALF) >> 6)) * 1536 + c0;
                *(f32x4*)(CA + ci) = (f32x4){RA[0], RA[1], RA[2], RA[3]}; *(f32x4*)(CA + ci + 4) = (f32x4){RA[4], RA[5], RA[6], RA[7]};
                *(f32x4*)(CB + ci) = (f32x4){RB[0], RB[1], RB[2], RB[3]}; *(f32x4*)(CB + ci + 4) = (f32x4){RB[4], RB[5], RB[6], RB[7]}; } }
    }
};
template <int STEP> struct EpiMerge {
    static constexpr bool PERM = true, AFTER_DRAIN = false;
    float* M32; bf16_t* Mb; const bf16_t* G; int ldg;
    __device__ __forceinline__ void operator()(const f32x4 (&acc)[2][2][4][2], const Unit& u, int wr, int wc, int fr, int fq) const {
        const int row0 = u.pm * BM + wr * 64 + fr, col0 = u.pn * BM + wc * 32 + 8 * fq;
#pragma unroll
        for (int ai = 0; ai < 2; ++ai) { u32x4 gw[4][2], ow[4][2];
#pragma unroll
            for (int m = 0; m < 4; ++m) { const size_t row = (size_t)(row0 + ai * HALF + m * 16);
#pragma unroll
                for (int bj = 0; bj < 2; ++bj) { const int col = col0 + bj * HALF; gw[m][bj] = *(const u32x4*)(G + row * ldg + col); if (STEP >= 1) ow[m][bj] = *(const u32x4*)(Mb + row * 4096 + col); } }
#pragma unroll
            for (int m = 0; m < 4; ++m) { const size_t row = (size_t)(row0 + ai * HALF + m * 16);
#pragma unroll
                for (int bj = 0; bj < 2; ++bj) { const int col = col0 + bj * HALF; const u32x4 g4 = gw[m][bj];
                    const float g[8] = {bf_lo(g4.x), bf_hi(g4.x), bf_lo(g4.y), bf_hi(g4.y), bf_lo(g4.z), bf_hi(g4.z), bf_lo(g4.w), bf_hi(g4.w)};
                    float v[8];
#pragma unroll
                    for (int n = 0; n < 2; ++n)
#pragma unroll
                        for (int j = 0; j < 4; ++j) v[n * 4 + j] = g[n * 4 + j] * acc[ai][bj][m][n][j];
                    if (STEP >= 1) { const u32x4 o = ow[m][bj];
                        v[0] += bf_lo(o.x); v[1] += bf_hi(o.x); v[2] += bf_lo(o.y); v[3] += bf_hi(o.y); v[4] += bf_lo(o.z); v[5] += bf_hi(o.z); v[6] += bf_lo(o.w); v[7] += bf_hi(o.w); }
                    u32x4 w; w.x = cvt_pk_bf16(v[0], v[1]); w.y = cvt_pk_bf16(v[2], v[3]); w.z = cvt_pk_bf16(v[4], v[5]); w.w = cvt_pk_bf16(v[6], v[7]);
                    *(u32x4*)(Mb + row * 4096 + col) = w; } }
            asm volatile("" ::: "memory"); }
    }
};
template <class Epi, class Sched, bool ALIGN_EPI = false, bool SP2 = false>
__device__ __forceinline__ void gemm_phase(PG8_LAS unsigned char* lds, const Gemm g, const Sched& S, const Epi& E, int tid_in) {
    int tid_ = tid_in; asm volatile("" : "+v"(tid_));
    const int tid = tid_, wid = __builtin_amdgcn_readfirstlane(tid >> 6), lane = tid & 63, wr = wid >> 2, wc = wid & 3, fr = lane & 15, fq = lane >> 4;
    const int K = g.K, nt = K / BK;
    unsigned voffA[2], voffB[2];
#pragma unroll
    for (int i = 0; i < 2; ++i) { int R, C; stage_rc(tid * 16 + i * 8192, R, C); const int Rb = Epi::PERM ? ((R & ~31) + perm32(R & 31)) : R;
        voffA[i] = (unsigned)(R * K + C) * 2u; voffB[i] = (unsigned)(Rb * K + C) * 2u; }
    const size_t kstep = (size_t)(BK * 2);
    const size_t hstep = (size_t)HALF * K * 2;
    const size_t tstep = 2 * hstep;
    const unsigned ldsw = (unsigned)wid * 1024u;
    const int aoff = lds_byte(wr * 64 + fr, fq * 8), boff = lds_byte(wc * 32 + fr, fq * 8);
#define PG8_SA(b, h) (((b) * 2 + (h)) * HTB)
#define PG8_SB(b, h) ((4 + (b) * 2 + (h)) * HTB)
#define PG8_STAGE(bufoff, gbase, voff) do { _Pragma("unroll") for (int _i = 0; _i < 2; ++_i) \
        __builtin_amdgcn_global_load_lds((const unsigned*)((const char*)(gbase) + (voff)[_i]), (PG8_LAS unsigned*)(lds + (bufoff) + ldsw + _i * 8192), 16, 0, 0); } while (0)
#define PG8_LDA(dst, b, h) do { _Pragma("unroll") for (int m = 0; m < 4; ++m) _Pragma("unroll") for (int k = 0; k < 2; ++k) dst[m][k] = *(const PG8_LAS bf16x8*)(lds + PG8_SA(b, h) + aoff + m * 2048 + k * 1024); } while (0)
#define PG8_LDB(dst, b, h) do { _Pragma("unroll") for (int n = 0; n < 2; ++n) _Pragma("unroll") for (int k = 0; k < 2; ++k) dst[n][k] = *(const PG8_LAS bf16x8*)(lds + PG8_SB(b, h) + boff + n * 2048 + k * 1024); } while (0)
#define PG8_MMA(ai, bj, At, Bt) do { __builtin_amdgcn_s_setprio(1); _Pragma("unroll") for (int m = 0; m < 4; ++m) _Pragma("unroll") for (int n = 0; n < 2; ++n) _Pragma("unroll") for (int k = 0; k < 2; ++k) \
        acc[ai][bj][m][n] = __builtin_amdgcn_mfma_f32_16x16x32_bf16(Bt[n][k], At[m][k], acc[ai][bj][m][n], 0, 0, 0); __builtin_amdgcn_s_setprio(0); } while (0)
#define PG8_WAIT_V(n) asm volatile("s_waitcnt vmcnt(" #n ")" ::: "memory")
#define PG8_WAIT_L(n) asm volatile("s_waitcnt lgkmcnt(" #n ")" ::: "memory")
#define PG8_BAR __builtin_amdgcn_s_barrier()
#define PG8_SCHED __builtin_amdgcn_sched_barrier(0)
    Unit cur, nxt; int ui = 0;
    if (!S.next(0, cur)) return;
    f32x4 acc[2][2][4][2];
#pragma unroll
    for (int a = 0; a < 2; ++a)
#pragma unroll
        for (int b = 0; b < 2; ++b)
#pragma unroll
            for (int m = 0; m < 4; ++m)
#pragma unroll
                for (int n = 0; n < 2; ++n) acc[a][b][m][n] = (f32x4){0.f, 0.f, 0.f, 0.f};
    bf16x8 At[4][2], B0[2][2], B1[2][2];
    const char* cA = (const char*)g.A + (size_t)cur.pm * tstep; const char* cB = (const char*)g.Bt + (size_t)cur.pn * tstep;
    S.a_ready(cur);
    if constexpr (SP2) {
        PG8_STAGE(PG8_SB(0, 0), cB, voffB); PG8_STAGE(PG8_SB(0, 1), cB + hstep, voffB); PG8_STAGE(PG8_SA(0, 0), cA, voffA); PG8_STAGE(PG8_SA(0, 1), cA + hstep, voffA);
        if (wr == 1) PG8_BAR;
        PG8_WAIT_V(2); PG8_BAR;
        PG8_STAGE(PG8_SB(1, 0), cB + kstep, voffB); PG8_STAGE(PG8_SA(1, 0), cA + kstep, voffA); PG8_STAGE(PG8_SB(1, 1), cB + hstep + kstep, voffB);
        PG8_WAIT_V(6); PG8_BAR;
    } else {
        PG8_STAGE(PG8_SB(0, 0), cB, voffB); PG8_STAGE(PG8_SA(0, 0), cA, voffA); PG8_STAGE(PG8_SB(0, 1), cB + hstep, voffB); PG8_STAGE(PG8_SA(0, 1), cA + hstep, voffA);
        if (wr == 1) PG8_BAR;
        PG8_WAIT_V(4); PG8_BAR;
        PG8_STAGE(PG8_SB(1, 0), cB + kstep, voffB); PG8_STAGE(PG8_SA(1, 0), cA + kstep, voffA); PG8_STAGE(PG8_SB(1, 1), cB + hstep + kstep, voffB);
        PG8_WAIT_V(6); PG8_BAR;
    }
    for (;;) {
        const bool has_next = S.next(ui + 1, nxt);
        const char* nA = has_next ? (const char*)g.A + (size_t)nxt.pm * tstep : cA; const char* nB = has_next ? (const char*)g.Bt + (size_t)nxt.pn * tstep : cB;
        for (int t = 0; t < nt; t += 2) {
            const bool last = (t == nt - 2);
            const char* a1 = cA + (size_t)(t + 1) * kstep;
            const char* a2 = last ? nA : cA + (size_t)(t + 2) * kstep; const char* b2 = last ? nB : cB + (size_t)(t + 2) * kstep;
            const char* a3 = a2 + kstep; const char* b3 = b2 + kstep;
            if (last && has_next) S.a_ready(nxt);
            if constexpr (SP2) {
            PG8_LDB(B0, 0, 0); PG8_LDB(B1, 0, 1); PG8_SCHED; PG8_LDA(At, 0, 0); PG8_STAGE(PG8_SA(1, 1), a1 + hstep, voffA);
            PG8_WAIT_V(8); PG8_WAIT_L(0); PG8_BAR; PG8_MMA(0, 0, At, B0); PG8_MMA(0, 1, At, B1); PG8_BAR; PG8_SCHED;
            PG8_LDA(At, 0, 1); PG8_STAGE(PG8_SB(0, 0), b2, voffB); PG8_STAGE(PG8_SB(0, 1), b2 + hstep, voffB); PG8_STAGE(PG8_SA(0, 0), a2, voffA);
            PG8_WAIT_V(8); PG8_WAIT_L(0); PG8_BAR; PG8_MMA(1, 0, At, B0); PG8_MMA(1, 1, At, B1); PG8_BAR; PG8_SCHED;
            PG8_LDB(B0, 1, 0); PG8_LDB(B1, 1, 1); PG8_SCHED; PG8_LDA(At, 1, 0); PG8_STAGE(PG8_SA(0, 1), a2 + hstep, voffA);
            PG8_WAIT_V(8); PG8_WAIT_L(0); PG8_BAR; PG8_MMA(0, 0, At, B0); PG8_MMA(0, 1, At, B1); PG8_BAR; PG8_SCHED;
            PG8_LDA(At, 1, 1); PG8_STAGE(PG8_SB(1, 0), b3, voffB); PG8_STAGE(PG8_SB(1, 1), b3 + hstep, voffB); PG8_STAGE(PG8_SA(1, 0), a3, voffA);
            PG8_WAIT_V(8); PG8_WAIT_L(0); PG8_BAR; PG8_MMA(1, 0, At, B0); PG8_MMA(1, 1, At, B1); PG8_BAR; PG8_SCHED;
            } else {
            PG8_LDB(B0, 0, 0); PG8_SCHED; PG8_LDA(At, 0, 0); PG8_STAGE(PG8_SA(1, 1), a1 + hstep, voffA);
            PG8_WAIT_L(8); PG8_BAR; PG8_WAIT_L(0); PG8_MMA(0, 0, At, B0); PG8_BAR; PG8_SCHED;
            PG8_LDB(B1, 0, 1); PG8_STAGE(PG8_SB(0, 0), b2, voffB);
            PG8_BAR; PG8_WAIT_L(0); PG8_MMA(0, 1, At, B1); PG8_BAR;
            PG8_LDA(At, 0, 1); PG8_STAGE(PG8_SA(0, 0), a2, voffA);
            PG8_BAR; PG8_WAIT_L(0); PG8_MMA(1, 0, At, B0); PG8_BAR; PG8_SCHED;
            PG8_STAGE(PG8_SB(0, 1), b2 + hstep, voffB);
            PG8_WAIT_V(6); PG8_BAR; PG8_MMA(1, 1, At, B1); PG8_BAR;
            PG8_LDB(B0, 1, 0); PG8_SCHED; PG8_LDA(At, 1, 0); PG8_STAGE(PG8_SA(0, 1), a2 + hstep, voffA);
            PG8_WAIT_L(8); PG8_BAR; PG8_WAIT_L(0); PG8_MMA(0, 0, At, B0); PG8_BAR; PG8_SCHED;
            PG8_LDB(B1, 1, 1); PG8_STAGE(PG8_SB(1, 0), b3, voffB);
            PG8_BAR; PG8_WAIT_L(0); PG8_MMA(0, 1, At, B1); PG8_BAR;
            PG8_LDA(At, 1, 1); PG8_STAGE(PG8_SA(1, 0), a3, voffA);
            PG8_BAR; PG8_WAIT_L(0); PG8_MMA(1, 0, At, B0); PG8_BAR; PG8_SCHED;
            PG8_STAGE(PG8_SB(1, 1), b3 + hstep, voffB);
            PG8_WAIT_V(6); PG8_BAR; PG8_MMA(1, 1, At, B1); PG8_BAR;
            }
        }
        if constexpr (ALIGN_EPI) { if (wr == 0) PG8_BAR; }
        if constexpr (!Epi::AFTER_DRAIN) { E(acc, cur, wr, wc, fr, fq); S.done(cur); }
        if (!has_next) break;
#pragma unroll
        for (int a = 0; a < 2; ++a)
#pragma unroll
            for (int b = 0; b < 2; ++b)
#pragma unroll
                for (int m = 0; m < 4; ++m)
#pragma unroll
                    for (int n = 0; n < 2; ++n) acc[a][b][m][n] = (f32x4){0.f, 0.f, 0.f, 0.f};
        cur = nxt; cA = nA; cB = nB; ++ui;
        if constexpr (ALIGN_EPI) { if (wr == 1) PG8_BAR; }
    }
    PG8_WAIT_V(0);
    if constexpr (!ALIGN_EPI) { if (wr == 0) PG8_BAR; }
    PG8_BAR;
    if constexpr (Epi::AFTER_DRAIN) { E.fused(acc, cur, wr, wc, fr, fq, lds, wid, lane); S.done(cur); }
#undef PG8_SA
#undef PG8_SB
#undef PG8_STAGE
#undef PG8_LDA
#undef PG8_LDB
#undef PG8_MMA
#undef PG8_WAIT_V
#undef PG8_WAIT_L
#undef PG8_BAR
#undef PG8_SCHED
}
}
namespace att {
using bf16 = __hip_bfloat16;
constexpr int   D = 128, NW = 8, QBLK = 32, KVBLK = 64;
constexpr float SCALE = 0.088388347648318440f;
constexpr float THR = 8.f;
constexpr int SDEPTH = 2;
constexpr int LDQ = 1536, LDK = 512, LDO = 1536;
constexpr size_t SHM_V = KVBLK * D * 2, SHM_K = KVBLK * D * 2, SHM_ATTN = 2 * SHM_V + 2 * SHM_K + NW * 64 * 4;
__device__ __forceinline__ unsigned short f2bf_att(float f) { unsigned u = __builtin_bit_cast(unsigned, f); return (unsigned short)((u + 0x7fffu + ((u >> 16) & 1u)) >> 16); }
using bf16x8 = __attribute__((ext_vector_type(8))) short;
using s16x4  = __attribute__((ext_vector_type(4))) short;
using f32x16 = __attribute__((ext_vector_type(16))) float;
using f32x8  = __attribute__((ext_vector_type(8))) float;
using u32x4  = __attribute__((ext_vector_type(4))) unsigned;
#define KSWZ(row, colB) ((row) * 256 + ((colB) ^ (((row) & 7) << 4)))
#define SBAR() __builtin_amdgcn_sched_barrier(0)
__device__ __forceinline__ int crow(int r, int hi) { return (r & 3) + 8 * (r >> 2) + 4 * hi; }
__device__ __forceinline__ unsigned cvtpk(float lo, float hi) {
  unsigned r; asm volatile("v_cvt_pk_bf16_f32 %0, %1, %2" : "=v"(r) : "v"(lo), "v"(hi)); return r;
}
template <typename TIn> struct Stage;
template <> struct Stage<bf16>  { using T = bf16x8;
  __device__ static __forceinline__ T ld8(const bf16* p) { return *reinterpret_cast<const bf16x8*>(p); }
  __device__ static __forceinline__ bf16x8 tobf(T x) { return x; } };
template <> struct Stage<float> { using T = f32x8;
  __device__ static __forceinline__ T ld8(const float* p) { return *reinterpret_cast<const f32x8*>(p); }
  __device__ static __forceinline__ bf16x8 tobf(T x) {
    u32x4 w = {cvtpk(x[0], x[1]), cvtpk(x[2], x[3]), cvtpk(x[4], x[5]), cvtpk(x[6], x[7])}; return *reinterpret_cast<bf16x8*>(&w); } };

__device__ __forceinline__ void partialSM(f32x16& p0, f32x16& p1, float& m_reg, float& mn, float& alpha) {
  constexpr float C = SCALE * 1.4426950408889634f;
  float pmax = p0[0]; for (int r = 1; r < 16; ++r) pmax = fmaxf(pmax, p0[r]); for (int r = 0; r < 16; ++r) pmax = fmaxf(pmax, p1[r]);
  { auto rr = __builtin_amdgcn_permlane32_swap(__float_as_uint(pmax), __float_as_uint(pmax), false, false);
    pmax = fmaxf(__uint_as_float(rr[0]), __uint_as_float(rr[1])); }
  if (__builtin_expect(__all(pmax - m_reg <= THR / SCALE), 1)) { mn = m_reg; alpha = 1.f; }
  else { mn = fmaxf(m_reg, pmax); alpha = __builtin_amdgcn_exp2f((m_reg - mn) * C); m_reg = mn; }
  float mnC = -mn * C;
  for (int r = 0; r < 16; ++r) p0[r] = fmaf(p0[r], C, mnC); for (int r = 0; r < 16; ++r) p1[r] = fmaf(p1[r], C, mnC);
  for (int r = 0; r < 16; ++r) p0[r] = __builtin_amdgcn_exp2f(p0[r]);
}
__device__ __forceinline__ void finishSM(f32x16& p0, f32x16& p1, float alpha, float& l_reg, bf16x8& pa0, bf16x8& pa1, bf16x8& pa2, bf16x8& pa3) {
  for (int r = 0; r < 16; ++r) p1[r] = __builtin_amdgcn_exp2f(p1[r]);
  float ps = 0; for (int r = 0; r < 16; ++r) ps += p0[r]; for (int r = 0; r < 16; ++r) ps += p1[r];
  { auto rr = __builtin_amdgcn_permlane32_swap(__float_as_uint(ps), __float_as_uint(ps), false, false);
    ps = __uint_as_float(rr[0]) + __uint_as_float(rr[1]); }
  l_reg = l_reg * alpha + ps;
#define PK4(P, BASE, OUT) do { unsigned a0 = cvtpk(P[BASE + 0], P[BASE + 1]), a1 = cvtpk(P[BASE + 2], P[BASE + 3]);   \
    unsigned b0 = cvtpk(P[BASE + 4], P[BASE + 5]), b1 = cvtpk(P[BASE + 6], P[BASE + 7]);                              \
    auto r0 = __builtin_amdgcn_permlane32_swap(a0, b0, false, false); auto r1 = __builtin_amdgcn_permlane32_swap(a1, b1, false, false); \
    u32x4 w = {r0[0], r1[0], r0[1], r1[1]}; OUT = *reinterpret_cast<bf16x8*>(&w); } while (0)
  PK4(p0, 0, pa0); PK4(p0, 8, pa1); PK4(p1, 0, pa2); PK4(p1, 8, pa3);
#undef PK4
}
__device__ __forceinline__ void qkt(f32x16& p0, f32x16& p1, const bf16* Ks, const bf16x8* qr, int r32, int hi) {
  p0 = f32x16{}; p1 = f32x16{};
  for (int d0 = 0; d0 < 8; ++d0) { int cb = (d0 * 16 + hi * 8) * 2;
    bf16x8 b0 = *reinterpret_cast<const bf16x8*>((const char*)Ks + KSWZ(r32, cb));
    bf16x8 b1 = *reinterpret_cast<const bf16x8*>((const char*)Ks + KSWZ(32 + r32, cb));
    p0 = __builtin_amdgcn_mfma_f32_32x32x16_bf16(b0, qr[d0], p0, 0, 0, 0);
    p1 = __builtin_amdgcn_mfma_f32_32x32x16_bf16(b1, qr[d0], p1, 0, 0, 0); }
}
__device__ __forceinline__ int v_st(int k, int c) { const int kk = (k & ~0xC) | ((k & 4) << 1) | ((k & 8) >> 1); return ((kk >> 3) * 4 + (c >> 5)) * 512 + ((kk & 7) * 32 + (c & 31)) * 2; }
__device__ __forceinline__ int v_rd_base(int lane) { return ((lane & 3) << 3) | (((lane >> 2) & 3) << 6) | (((lane >> 4) & 1) << 5) | (((lane >> 5) & 1) << 8); }
constexpr int v_rd_off(int d0, int ks, int half) { return d0 * 512 + ks * 4096 + half * 2048; }
template <int OFF> __device__ __forceinline__ s16x4 tr_read(int vb) {
  s16x4 r; asm volatile("ds_read_b64_tr_b16 %0, %1 offset:%2" : "=&v"(r) : "v"(vb), "i"(OFF) : "memory"); return r;
}
template <int D0> __device__ __forceinline__ void pv_one(f32x16& od, int vb, bf16x8 pa0, bf16x8 pa1, bf16x8 pa2, bf16x8 pa3) {
  const s16x4 l0 = tr_read<v_rd_off(D0, 0, 0)>(vb), h0 = tr_read<v_rd_off(D0, 0, 1)>(vb), l1 = tr_read<v_rd_off(D0, 1, 0)>(vb), h1 = tr_read<v_rd_off(D0, 1, 1)>(vb);
  const s16x4 l2 = tr_read<v_rd_off(D0, 2, 0)>(vb), h2 = tr_read<v_rd_off(D0, 2, 1)>(vb), l3 = tr_read<v_rd_off(D0, 3, 0)>(vb), h3 = tr_read<v_rd_off(D0, 3, 1)>(vb);
  asm volatile("s_waitcnt lgkmcnt(0)" ::: "memory"); SBAR();
#define PK(L, H) (bf16x8){L[0], L[1], L[2], L[3], H[0], H[1], H[2], H[3]}
  od = __builtin_amdgcn_mfma_f32_32x32x16_bf16(pa0, PK(l0, h0), od, 0, 0, 0);
  od = __builtin_amdgcn_mfma_f32_32x32x16_bf16(pa1, PK(l1, h1), od, 0, 0, 0);
  od = __builtin_amdgcn_mfma_f32_32x32x16_bf16(pa2, PK(l2, h2), od, 0, 0, 0);
  od = __builtin_amdgcn_mfma_f32_32x32x16_bf16(pa3, PK(l3, h3), od, 0, 0, 0);
#undef PK
}
__device__ __forceinline__ void pv_d0(f32x16* o, int vb, bf16x8 pa0, bf16x8 pa1, bf16x8 pa2, bf16x8 pa3) {
  pv_one<0>(o[0], vb, pa0, pa1, pa2, pa3); pv_one<1>(o[1], vb, pa0, pa1, pa2, pa3); pv_one<2>(o[2], vb, pa0, pa1, pa2, pa3); pv_one<3>(o[3], vb, pa0, pa1, pa2, pa3);
}

template <typename TQ>
__device__ __forceinline__ void attn_dense_body(const TQ* __restrict__ Qb, const bf16* __restrict__ Kh, const bf16* __restrict__ Vh,
                                                unsigned short* __restrict__ Ob, int seq, char* lds, int tid_in) {
  using St = Stage<bf16>; using SQ = Stage<TQ>;
  int tid_ = tid_in; asm volatile("" : "+v"(tid_));
  const int tid = tid_, wid = tid >> 6, lane = tid & 63, r32 = lane & 31, hi = lane >> 5;
  bf16* V_lds = (bf16*)lds; bf16* K_lds = (bf16*)(lds + 2 * SHM_V);
  float* ws = (float*)(lds + 2 * SHM_V + 2 * SHM_K) + wid * 64; float* li_l = ws; float* al_l = ws + 32;
  float m_reg = -1e30f, l_reg = 0; f32x16 o[4] = {}; bf16x8 qr[8];
  const TQ* Qw = Qb + (long)(wid * QBLK + r32) * LDQ + hi * 8;
#pragma unroll
  for (int d0 = 0; d0 < 8; ++d0) qr[d0] = SQ::tobf(SQ::ld8(Qw + d0 * 16));
  const int sr = tid >> 4, sc = (tid & 15) * 8, vst0 = v_st(sr, sc), vst1 = v_st(32 + sr, sc);
  const int vb0 = (int)(uintptr_t)V_lds + v_rd_base(lane);
  struct { typename St::T vs0, vs1, ks0, ks1; } sr_[SDEPTH];
  const unsigned lo0 = (unsigned)(sr * LDK + sc) * 2u, lo1 = lo0 + 32u * LDK * 2u;
#define SLOAD(i, k0) do { const char* vt_ = (const char*)Vh + (size_t)(k0) * (LDK * 2); const char* kt_ = (const char*)Kh + (size_t)(k0) * (LDK * 2); \
    sr_[i].vs0 = *(const bf16x8*)(vt_ + lo0); sr_[i].vs1 = *(const bf16x8*)(vt_ + lo1); \
    sr_[i].ks0 = *(const bf16x8*)(kt_ + lo0); sr_[i].ks1 = *(const bf16x8*)(kt_ + lo1); } while (0)
#define SWRITE(b, i) do { *(bf16x8*)((char*)V_lds + (b) * SHM_V + vst0) = St::tobf(sr_[i].vs0);          \
    *(bf16x8*)((char*)V_lds + (b) * SHM_V + vst1) = St::tobf(sr_[i].vs1); int kc = sc * 2;               \
    *(bf16x8*)((char*)K_lds + (b) * SHM_K + KSWZ(sr, kc)) = St::tobf(sr_[i].ks0);                       \
    *(bf16x8*)((char*)K_lds + (b) * SHM_K + KSWZ(32 + sr, kc)) = St::tobf(sr_[i].ks1); } while (0)
#define SWAIT() do { if constexpr (SDEPTH == 2) asm volatile("s_waitcnt vmcnt(4)" ::: "memory"); else asm volatile("s_waitcnt vmcnt(0)" ::: "memory"); } while (0)
#define RESC(a) do { if (__any((a) < 1.f)) { if (hi == 0) al_l[r32] = (a); asm volatile("s_waitcnt lgkmcnt(0)" ::: "memory"); \
    for (int d = 0; d < 4; ++d) for (int r = 0; r < 16; ++r) o[d][r] *= al_l[crow(r, hi)]; } } while (0)
  f32x16 pA0, pA1, pB0, pB1; float mnA, mnB, alA, alB; bf16x8 pa0, pa1, pa2, pa3; const int NT = seq / KVBLK;
  constexpr int SE = 0, SO = SDEPTH - 1;
  SLOAD(SE, 0); asm volatile("s_waitcnt vmcnt(0)" ::: "memory"); SWRITE(0, SE); __syncthreads();
  qkt(pA0, pA1, K_lds, qr, r32, hi); partialSM(pA0, pA1, m_reg, mnA, alA);
  SLOAD(SO, KVBLK); if constexpr (SDEPTH == 2) { if (2 < NT) SLOAD(SE, 2 * KVBLK); }
  SWAIT(); SWRITE(1, SO); __syncthreads();
  for (int j = 1; j + 1 < NT; j += 2) {
    SBAR(); qkt(pB0, pB1, (bf16*)((char*)K_lds + SHM_K), qr, r32, hi);
    finishSM(pA0, pA1, alA, l_reg, pa0, pa1, pa2, pa3); SBAR();
    SLOAD(SO, (j + SDEPTH) * KVBLK); SBAR();
    pv_d0(o, vb0, pa0, pa1, pa2, pa3); partialSM(pB0, pB1, m_reg, mnB, alB);
    __syncthreads(); SWAIT(); SWRITE(0, SE);
    RESC(alB); __syncthreads();
    SBAR(); qkt(pA0, pA1, K_lds, qr, r32, hi);
    finishSM(pB0, pB1, alB, l_reg, pa0, pa1, pa2, pa3); SBAR();
    if (SDEPTH == 1 || j + 3 < NT) SLOAD(SE, (j + 1 + SDEPTH) * KVBLK); SBAR();
    pv_d0(o, vb0 + (int)SHM_V, pa0, pa1, pa2, pa3); partialSM(pA0, pA1, m_reg, mnA, alA);
    __syncthreads(); SWAIT(); SWRITE(1, SO);
    RESC(alA); __syncthreads();
  }
  SBAR(); qkt(pB0, pB1, (bf16*)((char*)K_lds + SHM_K), qr, r32, hi);
  finishSM(pA0, pA1, alA, l_reg, pa0, pa1, pa2, pa3); SBAR();
  pv_d0(o, vb0, pa0, pa1, pa2, pa3); partialSM(pB0, pB1, m_reg, mnB, alB);
  __syncthreads(); RESC(alB);
  finishSM(pB0, pB1, alB, l_reg, pa0, pa1, pa2, pa3); SBAR();
  pv_d0(o, vb0 + (int)SHM_V, pa0, pa1, pa2, pa3);
  if (hi == 0) li_l[r32] = l_reg; asm volatile("s_waitcnt lgkmcnt(0)" ::: "memory");
  float rli[16];
#pragma unroll
  for (int r = 0; r < 16; ++r) rli[r] = __builtin_amdgcn_rcpf(li_l[crow(r, hi)]);
  unsigned short* Ow = Ob + (long)(wid * QBLK) * LDO;
#pragma unroll
  for (int r = 0; r < 16; ++r) { int orow = crow(r, hi);
    for (int d0 = 0; d0 < 4; ++d0) Ow[(long)orow * LDO + d0 * 32 + r32] = f2bf_att(o[d0][r] * rli[r]); }
#undef SLOAD
#undef SWRITE
#undef SWAIT
#undef RESC
}

#undef KSWZ
#undef SBAR
}
constexpr int NWAVES = 8;
constexpr int DM = 4096, SEQ = 8192, CTXL = 256, MROWS = SEQ + CTXL, DEPTH = 4;
constexpr int WMIX = 1536, KVW = 512, NIN = 22528, DFF = 4096, MODR = 256, NMOD = 9;
constexpr int COL_AX = 0, COL_CK = 1536, COL_CV = 2048, COL_AG = 2560, COL_B = 4096, COL_CQ = 8704, COL_G = 10240;
constexpr int NCHUNK = MROWS / 64;
constexpr int FFTN = 16384;
constexpr float EPSN = 1e-6f;
constexpr int N_IN_TENSORS = 36;
enum { I_X = 0, I_C, I_CTX, I_CCTX, I_WMD, I_WMU, I_BMOD, I_NF1, I_NMIX, I_NF2, I_F1IN, I_F1OUT, I_F2IN, I_F2OUT, I_WIN, I_LCONV, I_LWA, I_LBA, I_LWX, I_LBX, I_LLAM,
       I_HCONV, I_HFW1, I_HFB1, I_HFREQ, I_HFW2, I_HFB2, I_HFW3, I_HSKIP, I_QN, I_KN, I_WBA, I_WBB, I_WBC, I_WOUT, I_FNORM };

constexpr size_t MiB = 1u << 20;
constexpr size_t WS_CTL = 0, CTL_ZERO_BYTES = 1 * MiB;
constexpr size_t WS_MOD = 2 * MiB;
constexpr size_t WS_W = 4 * MiB;
constexpr size_t WO_GU1 = 0, WO_D1 = 64 * MiB, WO_GU2 = 96 * MiB, WO_D2 = 160 * MiB, WO_IN = 192 * MiB, WO_BR = 368 * MiB, WO_OUT = 404 * MiB, WO_LRU = 436 * MiB, W_LAYER = 454 * MiB;
constexpr size_t WS_X = WS_W + DEPTH * W_LAYER;
constexpr size_t WS_U = WS_X + 132 * MiB;
constexpr size_t WS_H = WS_U + 66 * MiB;
constexpr size_t WS_P = WS_H + 66 * MiB;
constexpr size_t WS_XA = WS_P + 363 * MiB;
constexpr size_t WS_LA = WS_XA + 25 * MiB;
constexpr size_t WS_LB = WS_LA + 99 * MiB;
constexpr size_t WS_CA = WS_LB + 99 * MiB;
constexpr size_t WS_CB = WS_CA + 2 * MiB;
constexpr size_t WS_CIN = WS_CB + 2 * MiB;
constexpr size_t WS_QN = WS_CIN + 2 * MiB;
constexpr size_t WS_KN = WS_QN + 25 * MiB;
constexpr size_t WS_VN = WS_KN + 9 * MiB;
constexpr size_t WS_YA = WS_VN + 9 * MiB;
constexpr size_t WS_YB = WS_YA + 25 * MiB;
constexpr size_t WS_YC = WS_YB + 25 * MiB;
constexpr size_t WS_M32 = WS_YC + 25 * MiB;
constexpr size_t WS_VT = WS_M32 + 132 * MiB;
constexpr size_t WS_YBT = WS_VT + 144 * MiB;
constexpr size_t WS_KT = WS_YBT + 48 * MiB;
constexpr size_t WS_PM = WS_KT + 192 * MiB;
constexpr size_t WS_H2 = WS_PM + 384 * MiB;
constexpr size_t WS_H2C = WS_H2 + 2 * MiB;
constexpr size_t WS_KC = WS_H2C + 1 * MiB;
constexpr size_t WS_KCN = WS_KC + 6 * MiB;
constexpr size_t WS_UC = WS_KCN + 1 * MiB;
constexpr size_t WS_END = WS_UC + 5 * MiB;
constexpr int CW_TMO = 0, CW_CODE = 1;
constexpr int CW_BAR = 4096;
constexpr int CW_T1 = 16384;

constexpr int RING_OFF = 0, RING_BYTES = 131072;
constexpr int FFT_BYTES = (FFTN + FFTN / 32) * 8;
constexpr int RED_OFF = FFT_BYTES;
constexpr int WSCR_BYTES = 66 * 65 * 4;
constexpr int LDSCTL_OFF = 143360, MISC_OFF = LDSCTL_OFF + 320;
constexpr int LDS_BYTES = 147456;
static_assert(RED_OFF + 1024 <= LDSCTL_OFF && NWAVES * WSCR_BYTES <= LDSCTL_OFF && MISC_OFF + 128 <= LDS_BYTES, "LDS map");

#define GAS __attribute__((address_space(1)))
#define LAS __attribute__((address_space(3)))
typedef unsigned short bf16;
typedef unsigned v4u __attribute__((ext_vector_type(4)));
typedef unsigned v2u __attribute__((ext_vector_type(2)));
typedef float f32x4 __attribute__((ext_vector_type(4)));
typedef float f32x2 __attribute__((ext_vector_type(2)));
typedef GAS unsigned gu32;
#define RLX_AGENT __ATOMIC_RELAXED, __HIP_MEMORY_SCOPE_AGENT
#define LDS_WAIT() asm volatile("s_waitcnt lgkmcnt(0)" ::: "memory")
#define VM_WAIT() asm volatile("s_waitcnt vmcnt(0)" ::: "memory")
__device__ __forceinline__ unsigned f2bf(float f) { unsigned u = __builtin_bit_cast(unsigned, f); return (u + 0x7fffu + ((u >> 16) & 1u)) >> 16; }
__device__ __forceinline__ unsigned pk2(float lo, float hi) { return f2bf(lo) | (f2bf(hi) << 16); }
__device__ __forceinline__ float bflo(unsigned w) { return __uint_as_float(w << 16); }
__device__ __forceinline__ float bfhi(unsigned w) { return __uint_as_float(w & 0xffff0000u); }
__device__ __forceinline__ float bf1(bf16 h) { return __uint_as_float(((unsigned)h) << 16); }
template <int MASK> __device__ __forceinline__ float swz_xor(float v) { return __int_as_float(__builtin_amdgcn_ds_swizzle(__float_as_int(v), (MASK << 10) | 0x1f)); }
__device__ __forceinline__ float lane_bcast(float v, int l) { return __int_as_float(__builtin_amdgcn_readlane(__float_as_int(v), l)); }
__device__ __forceinline__ float wave_sum(float v) {
    v += swz_xor<1>(v); v += swz_xor<2>(v); v += swz_xor<4>(v); v += swz_xor<8>(v); v += swz_xor<16>(v);
    const auto rr = __builtin_amdgcn_permlane32_swap(__float_as_uint(v), __float_as_uint(v), false, false);
    return __uint_as_float(rr[0]) + __uint_as_float(rr[1]);
}
__device__ __forceinline__ float sigmoidf_(float x) { return 1.0f / (1.0f + __expf(-x)); }
#define XB_TMO      128
#define XB_XCNT(j)  (256  + 64 * (j))
#define XB_XSUB(j)  (1280 + 64 * (j))
#define XB_XGEN(j)  (2304 + 64 * (j))
#define XB_TOP      3328
#define XB_TOPGEN   3392
#define XCD_BAR_WORDS 3456
#define XB_SPIN_CAP (1u << 18)

__device__ __forceinline__ unsigned xb_ld(unsigned* p)              { return __hip_atomic_load(p, __ATOMIC_RELAXED, __HIP_MEMORY_SCOPE_AGENT); }
__device__ __forceinline__ unsigned xb_add(unsigned* p, unsigned v) { return __hip_atomic_fetch_add(p, v, __ATOMIC_RELAXED, __HIP_MEMORY_SCOPE_AGENT); }
__device__ __forceinline__ unsigned xb_xcc_id() { return (unsigned)__builtin_amdgcn_s_getreg((3 << 11) | 20) & 0xFu; }
#define XB_SPIN(cond, bar) do { unsigned _sp = 0; while (cond) { __builtin_amdgcn_s_sleep(1); \
    if ((++_sp & 255u) == 0u) { if (xb_ld(&(bar)[XB_TMO])) break; if (_sp > XB_SPIN_CAP) { atomicAdd(&(bar)[XB_TMO], 1u); break; } } } } while (0)

struct XcdBarrier {
    unsigned* bar; unsigned x;
    volatile LAS unsigned* st;
};

__device__ __forceinline__ XcdBarrier xcd_barrier_post(unsigned* bar, volatile LAS unsigned* st) {
    XcdBarrier b; b.bar = bar; b.x = xb_xcc_id(); b.st = st;
    if (threadIdx.x == 0) (void)xb_add(&bar[XB_XCNT(b.x)], 1u);
    return b;
}
__device__ __forceinline__ void xcd_barrier_complete(unsigned* bar, unsigned x, unsigned& nloc, unsigned& nx) {
    const unsigned G = gridDim.x * gridDim.y * gridDim.z;
    unsigned sum, cnt, mine, sp = 0u;
    for (;;) {
        sum = 0u; cnt = 0u; mine = 0u;
#pragma unroll
        for (unsigned j = 0; j < 16; ++j) { const unsigned c = xb_ld(&bar[XB_XCNT(j)]); sum += c; cnt += (c > 0u) ? 1u : 0u; mine = (j == x) ? c : mine; }
        if (sum == G) break;
        __builtin_amdgcn_s_sleep(1);
        if ((++sp & 255u) == 0u) { if (xb_ld(&bar[XB_TMO])) break; if (sp > XB_SPIN_CAP) { atomicAdd(&bar[XB_TMO], 1u); break; } }
    }
    nloc = mine > 0u ? mine : 1u; nx = cnt > 0u ? cnt : 1u;
}

__device__ __forceinline__ void xcd_barrier(const XcdBarrier& b) {
    asm volatile("s_waitcnt vmcnt(0)" ::: "memory");
    __syncthreads();
    if (threadIdx.x == 0) {
        unsigned* bar = b.bar;
        __builtin_amdgcn_s_waitcnt(0);
        unsigned nloc = b.st[0], nx = b.st[1];
        if (nloc == 0u) { xcd_barrier_complete(bar, b.x, nloc, nx); b.st[0] = nloc; b.st[1] = nx; }
        const unsigned old = xb_add(&bar[XB_XSUB(b.x)], 1u);
        const unsigned gen = old / nloc;
        if (old + 1u == (gen + 1u) * nloc) {
            __builtin_amdgcn_fence(__ATOMIC_RELEASE, "agent");
            asm volatile("s_waitcnt vmcnt(0)" ::: "memory");
            const unsigned og = xb_add(&bar[XB_TOP], 1u);
            const unsigned tg = og / nx;
            if (og + 1u == (tg + 1u) * nx) xb_add(&bar[XB_TOPGEN], 1u);
            else XB_SPIN(xb_ld(&bar[XB_TOPGEN]) == tg, bar);
            __builtin_amdgcn_fence(__ATOMIC_ACQUIRE, "agent");
            xb_add(&bar[XB_XGEN(b.x)], 1u);
            asm volatile("s_waitcnt vmcnt(0)" ::: "memory");
        } else {
            XB_SPIN(xb_ld(&bar[XB_XGEN(b.x)]) == gen, bar);
            __builtin_amdgcn_fence(__ATOMIC_ACQUIRE, "agent");
            asm volatile("s_waitcnt vmcnt(0)" ::: "memory");
        }
    }
    __syncthreads();
}
struct Args { const float* in[N_IN_TENSORS]; float* out; unsigned char* ws; int ph_lo, ph_hi; };
static_assert(sizeof(Args) == N_IN_TENSORS * 8 + 8 + 8 + 8, "Args has no padding");
__device__ __forceinline__ const float* inp(const Args& A, int i) { asm volatile("" : "+s"(i)); return (const float*)(const GAS float*)A.in[i]; }
struct Frame {
    LAS unsigned char* lds;
    unsigned char* ws;
    float* out;
    int tid, lane, wave, G, gw, ngw, bid;
};
__device__ __forceinline__ Frame fresh(const Frame& F) { Frame L = F; unsigned z = 0u; asm volatile("" : "+v"(z)); int wv = F.wave; asm volatile("" : "+s"(wv)); int b = F.bid; asm volatile("" : "+s"(b));
    unsigned long long w = (unsigned long long)F.ws; asm volatile("" : "+s"(w)); L.ws = (unsigned char*)(GAS unsigned char*)w;
    L.lane = (int)__builtin_amdgcn_mbcnt_hi(~0u, __builtin_amdgcn_mbcnt_lo(~0u, z));
    L.wave = wv; L.tid = wv * 64 + L.lane; L.bid = b; L.gw = b * NWAVES + wv; return L; }
#define WSP(T, off) ((T*)(F.ws + (off)))

__device__ __forceinline__ void transpose_item(const float* W, int K, int N, bf16* WT, int k0, int n0, int drow0, LAS float* scr, int lane) {
    const float* src = W + (size_t)k0 * N + n0 + lane;
#pragma unroll 16
    for (int kk = 0; kk < 64; ++kk) scr[kk * 65 + lane] = src[(size_t)kk * N];
    LDS_WAIT(); asm volatile("" ::: "memory");
    const int c = lane & 7;
#pragma unroll
    for (int j = 0; j < 8; ++j) { const int n = (lane >> 3) + 8 * j; const LAS float* s = scr + (8 * c) * 65 + n;
        v4u o; o.x = pk2(s[0 * 65], s[1 * 65]); o.y = pk2(s[2 * 65], s[3 * 65]); o.z = pk2(s[4 * 65], s[5 * 65]); o.w = pk2(s[6 * 65], s[7 * 65]);
        *(GAS v4u*)(WT + (size_t)(drow0 + n) * K + k0 + 8 * c) = o; }
    LDS_WAIT(); asm volatile("" ::: "memory");
}
template <int SWI> __device__ __forceinline__ void transpose_matrix(const Frame& F_, const Args& A, const float* W, int K, int N, bf16* WT, LAS float* scr) {
    const Frame F = fresh(F_);
    const int nblk = N / 64, nitems = (K / 64) * nblk;
    for (int it = F.gw; it < nitems; it += F.ngw) { const int kb = it / nblk, nb = it - kb * nblk, n0 = 64 * nb; int drow0 = n0;
        if (SWI) { const int h = n0 / 4096, c = n0 - h * 4096; drow0 = 256 * (c / 128) + 128 * h + (c & 127); }
        transpose_item(W, K, N, WT, 64 * kb, n0, drow0, scr, F.lane); }
}
__device__ __forceinline__ void prologue_a(const Frame& F_, const Args& A) {
    const Frame F = fresh(F_);
    LAS float* scr = (LAS float*)(F.lds + F.wave * 16640);
    { float* T1 = WSP(float, WS_CTL) + CW_T1; const float* cl = inp(A, I_C); const float* cc = inp(A, I_CCTX);
      for (int u = F.gw; u < DEPTH * 64; u += F.ngw) { const int layer = u >> 6, jg = u & 63;
          f32x4 al = {0.f, 0.f, 0.f, 0.f}, ac = {0.f, 0.f, 0.f, 0.f};
#pragma unroll 8
          for (int i = 0; i < 64; ++i) { const int d = F.lane + 64 * i; const float xl = cl[d], xc = cc[d]; const float sl = xl * sigmoidf_(xl), sc = xc * sigmoidf_(xc);
              const f32x4 w = *(const f32x4*)(inp(A, I_WMD) + ((size_t)layer * DM + d) * MODR + 4 * jg); al += w * sl; ac += w * sc; }
#pragma unroll
          for (int e = 0; e < 4; ++e) { const float tl = wave_sum(al[e]), tc = wave_sum(ac[e]);
              if (F.lane == 0) { T1[(layer * 2 + 0) * MODR + 4 * jg + e] = tl; T1[(layer * 2 + 1) * MODR + 4 * jg + e] = tc; } } } }
    { float* SPT = WSP(float, WS_MOD + 1536 * 1024); const float* lam = inp(A, I_LLAM);
      for (int i = F.bid * 512 + F.tid; i < DEPTH * 2 * WMIX; i += F.G * 512) SPT[i] = 8.0f * log1pf(__expf(-lam[i])); }
    { v2u* X = WSP(v2u, WS_X); const f32x4* xc = (const f32x4*)inp(A, I_CTX); const f32x4* xl = (const f32x4*)inp(A, I_X); const size_t nc = (size_t)CTXL * DM / 4, nt = (size_t)MROWS * DM / 4;
      for (size_t i = (size_t)F.bid * 512 + F.tid; i < nt; i += (size_t)F.G * 512) { const f32x4 v = (i < nc) ? xc[i] : xl[i - nc]; X[i] = (v2u){pk2(v.x, v.y), pk2(v.z, v.w)}; } }
    for (int layer = 0; layer < DEPTH; ++layer) { unsigned char* wb = F.ws + WS_W + (size_t)layer * W_LAYER;
        transpose_matrix<1>(F, A, inp(A, I_F1IN) + (size_t)layer * DM * 2 * DFF, DM, 2 * DFF, (bf16*)(wb + WO_GU1), scr);
        transpose_matrix<0>(F, A, inp(A, I_F1OUT) + (size_t)layer * DFF * DM, DFF, DM, (bf16*)(wb + WO_D1), scr);
        transpose_matrix<1>(F, A, inp(A, I_F2IN) + (size_t)layer * DM * 2 * DFF, DM, 2 * DFF, (bf16*)(wb + WO_GU2), scr);
        transpose_matrix<0>(F, A, inp(A, I_F2OUT) + (size_t)layer * DFF * DM, DFF, DM, (bf16*)(wb + WO_D2), scr);
        transpose_matrix<0>(F, A, inp(A, I_WIN) + (size_t)layer * DM * NIN, DM, NIN, (bf16*)(wb + WO_IN), scr);
        transpose_matrix<0>(F, A, inp(A, I_WBA) + (size_t)layer * WMIX * DM, WMIX, DM, (bf16*)(wb + WO_BR), scr);
        transpose_matrix<0>(F, A, inp(A, I_WBB) + (size_t)layer * WMIX * DM, WMIX, DM, (bf16*)(wb + WO_BR) + (size_t)DM * WMIX, scr);
        transpose_matrix<0>(F, A, inp(A, I_WBC) + (size_t)layer * WMIX * DM, WMIX, DM, (bf16*)(wb + WO_BR) + (size_t)2 * DM * WMIX, scr);
        transpose_matrix<0>(F, A, inp(A, I_WOUT) + (size_t)layer * DM * DM, DM, DM, (bf16*)(wb + WO_OUT), scr);
        { bf16* WL = (bf16*)(wb + WO_LRU); const float* wa = inp(A, I_LWA) + (size_t)layer * 2 * 12 * 128 * 128; const float* wx = inp(A, I_LWX) + (size_t)layer * 2 * 12 * 128 * 128;
          for (int row = F.gw; row < 6144; row += F.ngw) { const int jb = row >> 10, pnn = (row >> 8) & 3, h = (row >> 7) & 1, e = row & 127, dir = pnn >> 1, blk = 2 * jb + (pnn & 1);
              const float* src = (h ? wx : wa) + ((size_t)(dir * 12 + blk) * 128) * 128 + e;
              if (F.lane < 32) { const int k0 = F.lane * 8; v4u o = {0u, 0u, 0u, 0u};
                  if ((k0 >> 7) == (pnn & 1)) { const int dd = k0 & 127; float v[8];
#pragma unroll
                      for (int j = 0; j < 8; ++j) v[j] = src[(size_t)(dd + j) * 128];
                      o.x = pk2(v[0], v[1]); o.y = pk2(v[2], v[3]); o.z = pk2(v[4], v[5]); o.w = pk2(v[6], v[7]); }
                  *(GAS v4u*)(WL + (size_t)row * 256 + k0) = o; } } }
    }
}
__device__ __forceinline__ void prologue_b(const Frame& F_, const Args& A) {
    const Frame F = fresh(F_);
    const float* T1 = WSP(float, WS_CTL) + CW_T1; float* MOD = WSP(float, WS_MOD); constexpr int NM = NMOD * DM;
    for (int u = F.gw; u < DEPTH * 2 * (NM / 256); u += F.ngw) { const int lw = u / (NM / 256), nc = u - lw * (NM / 256), layer = lw >> 1, n0 = nc * 256 + 4 * F.lane;
        f32x4 acc = *(const f32x4*)(inp(A, I_BMOD) + (size_t)layer * NM + n0); const float* t1 = T1 + lw * MODR; const float* wu = inp(A, I_WMU) + (size_t)layer * MODR * NM + n0;
#pragma unroll 8
        for (int j = 0; j < MODR; ++j) acc += *(const f32x4*)(wu + (size_t)j * NM) * t1[j];
        *(f32x4*)(MOD + (size_t)lw * NM + n0) = acc; }
}
__device__ __forceinline__ void norm_phase(const Frame& F_, const Args& A, const float* g, const float* modL, const float* modC, int ishift, int iscale, int dfrom) {
    const Frame F = fresh(F_);
    bf16* X = WSP(bf16, WS_X); bf16* U = WSP(bf16, WS_U); const bf16* Dd = WSP(bf16, WS_M32); LAS f32x4* L4 = (LAS f32x4*)F.lds;
    __syncthreads();
    for (int i = F.tid; i < DM / 4; i += NWAVES * 64) { L4[i] = *(const f32x4*)(g + 4 * i);
        L4[1024 + i] = *(const f32x4*)(modL + ishift * DM + 4 * i); L4[2048 + i] = *(const f32x4*)(modL + iscale * DM + 4 * i) + 1.0f;
        L4[3072 + i] = *(const f32x4*)(modC + ishift * DM + 4 * i); L4[4096 + i] = *(const f32x4*)(modC + iscale * DM + 4 * i) + 1.0f; }
    __syncthreads();
    for (int r = F.gw; r < MROWS; r += F.ngw) { const int mo = (r < CTXL) ? 3072 : 1024; v4u* xr = (v4u*)(X + (size_t)r * DM) + F.lane;
        f32x4 v[8][2]; float s = 0.f;
#pragma unroll
        for (int i = 0; i < 8; ++i) { const v4u x = xr[64 * i]; v[i][0] = (f32x4){bflo(x.x), bfhi(x.x), bflo(x.y), bfhi(x.y)}; v[i][1] = (f32x4){bflo(x.z), bfhi(x.z), bflo(x.w), bfhi(x.w)}; }
        if (r >= dfrom) { const v4u* dr = (const v4u*)(Dd + (size_t)r * DM) + F.lane;
#pragma unroll
            for (int i = 0; i < 8; ++i) { const v4u d = dr[64 * i]; v[i][0] += (f32x4){bflo(d.x), bfhi(d.x), bflo(d.y), bfhi(d.y)}; v[i][1] += (f32x4){bflo(d.z), bfhi(d.z), bflo(d.w), bfhi(d.w)};
                xr[64 * i] = (v4u){pk2(v[i][0].x, v[i][0].y), pk2(v[i][0].z, v[i][0].w), pk2(v[i][1].x, v[i][1].y), pk2(v[i][1].z, v[i][1].w)}; } }
#pragma unroll
        for (int i = 0; i < 8; ++i)
#pragma unroll
            for (int h = 0; h < 2; ++h) s += (v[i][h].x * v[i][h].x + v[i][h].y * v[i][h].y) + (v[i][h].z * v[i][h].z + v[i][h].w * v[i][h].w);
        const float rms = rsqrtf(wave_sum(s) * (1.0f / DM) + EPSN);
        v4u* o16 = (v4u*)(U + (size_t)r * DM) + F.lane;
#pragma unroll
        for (int i = 0; i < 8; ++i) { f32x4 y[2];
#pragma unroll
            for (int h = 0; h < 2; ++h) { const int c4 = 2 * F.lane + 128 * i + h; const f32x4 gg = L4[c4], sh = L4[mo + c4], sc1 = L4[mo + 1024 + c4]; y[h] = (v[i][h] * rms * gg) * sc1 + sh; }
            o16[64 * i] = (v4u){pk2(y[0].x, y[0].y), pk2(y[0].z, y[0].w), pk2(y[1].x, y[1].y), pk2(y[1].z, y[1].w)}; } }
    __syncthreads();
}
__device__ __forceinline__ void final_norm_phase(const Frame& F_, const Args& A) {
    const Frame F = fresh(F_);
    const bf16* X = WSP(bf16, WS_X); const bf16* Dd = WSP(bf16, WS_M32); const float* g = inp(A, I_FNORM);
    for (int r = F.gw; r < SEQ; r += F.ngw) { const v2u* xr = (const v2u*)(X + (size_t)(r + CTXL) * DM) + F.lane; const v2u* dr = (const v2u*)(Dd + (size_t)(r + CTXL) * DM) + F.lane; f32x4 v[16]; float s = 0.f;
#pragma unroll
        for (int i = 0; i < 16; ++i) { const v2u x = xr[64 * i], d = dr[64 * i]; v[i] = (f32x4){bflo(x.x) + bflo(d.x), bfhi(x.x) + bfhi(d.x), bflo(x.y) + bflo(d.y), bfhi(x.y) + bfhi(d.y)}; s += (v[i].x * v[i].x + v[i].y * v[i].y) + (v[i].z * v[i].z + v[i].w * v[i].w); }
        const float rms = rsqrtf(wave_sum(s) * (1.0f / DM) + EPSN); f32x4* o = (f32x4*)(F.out + (size_t)r * DM) + F.lane;
#pragma unroll
        for (int i = 0; i < 16; ++i) o[64 * i] = v[i] * rms * *(const f32x4*)(g + 4 * F.lane + 256 * i); }
}

#ifdef DUMP
__device__ __forceinline__ void dump_phase(const Frame& F_, const Args& A) {
    const Frame F = fresh(F_);
    const bf16* YC = WSP(bf16, WS_YC); const bf16* YA = WSP(bf16, WS_YA); const bf16* YB = WSP(bf16, WS_YB);
#if DUMP >= 8
    { const bf16* P = WSP(bf16, WS_P); const size_t nctx = (size_t)CTXL * NIN;
      for (size_t i = (size_t)F.bid * 512 + F.tid; i < (size_t)SEQ * DM; i += (size_t)F.G * 512) { float v = 0.f;
          if (i < nctx) { if (DUMP & 8) v = bf1(P[i]); } else { const size_t k = i - nctx; const size_t r = k / DM, c = k % DM; if (DUMP & 16) v = bf1(P[(size_t)(r + CTXL) * NIN + c]); }
          F.out[i] = v; } return; }
#endif
    for (size_t i = (size_t)F.bid * 512 + F.tid; i < (size_t)SEQ * DM; i += (size_t)F.G * 512) { const int r = (int)(i / DM), c = (int)(i % DM); float v = 0.f;
        if (c < 1536) { if (DUMP & 1) v = bf1(YC[(size_t)(r + CTXL) * WMIX + c]); }
        else if (c < 3072) { if (DUMP & 2) v = bf1(YA[(size_t)(r + CTXL) * WMIX + c - 1536]); }
        else { if (DUMP & 4) v = bf1(YB[(size_t)(r + CTXL) * WMIX + c - 3072]); }
        F.out[i] = v; }
}
#endif
__device__ __forceinline__ bool same_seq(int r, int r2) { return r2 >= 0 && r2 < MROWS && ((r < CTXL) == (r2 < CTXL)); }
__device__ __forceinline__ void prep_lru_conv(const Frame& F_, const Args& A, int layer) {
    const Frame F = fresh(F_);
    const bf16* P = WSP(bf16, WS_P); bf16* XA = WSP(bf16, WS_XA); const float* w = inp(A, I_LCONV) + (size_t)layer * 4 * WMIX;
    const int nitems = (MROWS / 16) * (WMIX / 8);
    for (int it = F.bid * 512 + F.tid; it < nitems; it += F.G * 512) { const int run = it / (WMIX / 8), c0 = (it - run * (WMIX / 8)) * 8, r0 = run * 16;
        float wk[4][8];
#pragma unroll
        for (int k = 0; k < 4; ++k) { const f32x4 w0 = *(const f32x4*)(w + k * WMIX + c0), w1 = *(const f32x4*)(w + k * WMIX + c0 + 4);
            wk[k][0] = w0.x; wk[k][1] = w0.y; wk[k][2] = w0.z; wk[k][3] = w0.w; wk[k][4] = w1.x; wk[k][5] = w1.y; wk[k][6] = w1.z; wk[k][7] = w1.w; }
        v4u rows[19];
#pragma unroll
        for (int q = 0; q < 19; ++q) { const int r2 = r0 - 1 + q; rows[q] = same_seq(r0, r2) ? *(const v4u*)(P + (size_t)r2 * NIN + COL_AX + c0) : (v4u){0u, 0u, 0u, 0u}; }
#pragma unroll
        for (int t = 0; t < 16; ++t) { float acc[8] = {0.f, 0.f, 0.f, 0.f, 0.f, 0.f, 0.f, 0.f};
#pragma unroll
            for (int k = 0; k < 4; ++k) { const v4u pw = rows[t + k];
                acc[0] += wk[k][0] * bflo(pw.x); acc[1] += wk[k][1] * bfhi(pw.x); acc[2] += wk[k][2] * bflo(pw.y); acc[3] += wk[k][3] * bfhi(pw.y);
                acc[4] += wk[k][4] * bflo(pw.z); acc[5] += wk[k][5] * bfhi(pw.z); acc[6] += wk[k][6] * bflo(pw.w); acc[7] += wk[k][7] * bfhi(pw.w); }
            v4u o; o.x = pk2(acc[0], acc[1]); o.y = pk2(acc[2], acc[3]); o.z = pk2(acc[4], acc[5]); o.w = pk2(acc[6], acc[7]);
            *(v4u*)(XA + ((size_t)(c0 >> 8) * MROWS + r0 + t) * 256 + (c0 & 255)) = o; } }
}
__device__ __forceinline__ void prep_qkv(const Frame& F_, const Args& A, int layer) {
    const Frame F = fresh(F_);
    const bf16* P = WSP(bf16, WS_P); bf16* QN = WSP(bf16, WS_QN); bf16* KN = WSP(bf16, WS_KN); bf16* VN = WSP(bf16, WS_VN);
    const float* qg = inp(A, I_QN) + layer * 128; const float* kg = inp(A, I_KN) + layer * 128;
    const int d0 = (F.lane & 15) * 8, hl = F.lane >> 4;
    float gq[8], gk[8];
#pragma unroll
    for (int j = 0; j < 8; ++j) { gq[j] = qg[d0 + j]; gk[j] = kg[d0 + j]; }
    for (int r = F.gw; r < MROWS; r += F.ngw) { const bf16* pr = P + (size_t)r * NIN;
        float cs[4], sn[4]; const bool lat = r >= CTXL;
        if (lat) { const int s = r - CTXL, prow = s >> 6, pcol = s & 63;
#pragma unroll
            for (int j = 0; j < 4; ++j) { const int p = (d0 >> 1) + j;
                const float inv = exp2f(-(float)(p & 31) * (13.287712379549449f / 32.0f));
                const float ang = (float)((p < 32) ? prow : pcol) * inv; sincosf(ang, &sn[j], &cs[j]); } }
#pragma unroll
        for (int i = 0; i < 4; ++i) { const bool isq = i < 3; const int head = isq ? (hl + 4 * i) : hl;
            const bf16* src = pr + (isq ? (COL_CQ + head * 128) : (COL_CK + head * 128)) + d0;
            const v4u w = *(const v4u*)src; float v[8] = {bflo(w.x), bfhi(w.x), bflo(w.y), bfhi(w.y), bflo(w.z), bfhi(w.z), bflo(w.w), bfhi(w.w)};
            float ss = 0.f;
#pragma unroll
            for (int j = 0; j < 8; ++j) ss += v[j] * v[j];
            ss += swz_xor<1>(ss); ss += swz_xor<2>(ss); ss += swz_xor<4>(ss); ss += swz_xor<8>(ss);
            const float rms = rsqrtf(ss * (1.0f / 128.0f) + EPSN);
#pragma unroll
            for (int j = 0; j < 8; ++j) v[j] = v[j] * rms * (isq ? gq[j] : gk[j]);
            if (lat) {
#pragma unroll
                for (int j = 0; j < 4; ++j) { const float t0 = v[2 * j], t1 = v[2 * j + 1]; v[2 * j] = t0 * cs[j] - t1 * sn[j]; v[2 * j + 1] = t0 * sn[j] + t1 * cs[j]; } }
            v4u o; o.x = pk2(v[0], v[1]); o.y = pk2(v[2], v[3]); o.z = pk2(v[4], v[5]); o.w = pk2(v[6], v[7]);
            if (isq) *(v4u*)(QN + (size_t)r * WMIX + head * 128 + d0) = o; else *(v4u*)(KN + (size_t)r * KVW + head * 128 + d0) = o; }
        *(v4u*)(VN + (size_t)r * KVW + F.lane * 8) = *(const v4u*)(pr + COL_CV + F.lane * 8); }
}
__device__ __forceinline__ void prep_hyena_t(const Frame& F_, const Args& A, int layer) {
    const Frame F = fresh(F_);
    const bf16* P = WSP(bf16, WS_P); float* VT = WSP(float, WS_VT); const float* w = inp(A, I_HCONV) + (size_t)layer * 3 * (3 * WMIX);
    LAS float* scr = (LAS float*)(F.lds + F.wave * WSCR_BYTES);
    constexpr int NCB = 3 * WMIX / 64;
    for (int u = F.gw; u < (SEQ / 64) * NCB; u += F.ngw) { const int tb = u / NCB, cb = u - tb * NCB, t0 = tb * 64, c0 = cb * 64;
#pragma unroll
        for (int ps = 0; ps < 9; ++ps) { const int rr = ps * 8 + (F.lane >> 3), cc = (F.lane & 7) * 8; if (rr < 66) { const int t = t0 - 1 + rr; v4u pw = {0u, 0u, 0u, 0u};
                if (t >= 0 && t < SEQ) pw = *(const v4u*)(P + (size_t)(t + CTXL) * NIN + COL_B + c0 + cc);
                LAS float* d = scr + rr * 65 + cc; d[0] = bflo(pw.x); d[1] = bfhi(pw.x); d[2] = bflo(pw.y); d[3] = bfhi(pw.y); d[4] = bflo(pw.z); d[5] = bfhi(pw.z); d[6] = bflo(pw.w); d[7] = bfhi(pw.w); } }
        LDS_WAIT(); asm volatile("" ::: "memory");
        { const int part = c0 / WMIX, pr0 = (c0 - part * WMIX) >> 1;
          const int tl = 4 * (F.lane & 15), pl = F.lane >> 4;
#pragma unroll 2
          for (int pg = 0; pg < 8; ++pg) { const int pi = 4 * pg + pl, c = 2 * pi, ch = c0 + c; v4u o;
              const float w00 = w[ch], w01 = w[3 * WMIX + ch], w02 = w[2 * 3 * WMIX + ch], w10 = w[ch + 1], w11 = w[3 * WMIX + ch + 1], w12 = w[2 * 3 * WMIX + ch + 1];
              float xe[6], xo[6];
#pragma unroll
              for (int q = 0; q < 6; ++q) { xe[q] = scr[(tl + q) * 65 + c]; xo[q] = scr[(tl + q) * 65 + c + 1]; }
              o.x = pk2(w00 * xe[0] + w01 * xe[1] + w02 * xe[2], w10 * xo[0] + w11 * xo[1] + w12 * xo[2]);
              o.y = pk2(w00 * xe[1] + w01 * xe[2] + w02 * xe[3], w10 * xo[1] + w11 * xo[2] + w12 * xo[3]);
              o.z = pk2(w00 * xe[2] + w01 * xe[3] + w02 * xe[4], w10 * xo[2] + w11 * xo[3] + w12 * xo[4]);
              o.w = pk2(w00 * xe[3] + w01 * xe[4] + w02 * xe[5], w10 * xo[3] + w11 * xo[4] + w12 * xo[5]);
              *(v4u*)((unsigned*)VT + ((size_t)part * (WMIX / 2) + pr0 + pi) * SEQ + t0 + tl) = o; } }
        LDS_WAIT(); asm volatile("" ::: "memory"); }
}
__device__ __forceinline__ void prep_hyena_ctx(const Frame& F_, const Args& A, int layer) {
    const Frame F = fresh(F_);
    const bf16* P = WSP(bf16, WS_P); float* UC = WSP(float, WS_UC); const float* w = inp(A, I_HCONV) + (size_t)layer * 3 * (3 * WMIX);
    for (int it = F.bid * 512 + F.tid; it < CTXL * 3 * WMIX; it += F.G * 512) { const int t = it / (3 * WMIX), ch = it - t * (3 * WMIX);
        float v = w[3 * WMIX + ch] * bf1(P[(size_t)t * NIN + COL_B + ch]);
        if (t > 0) v += w[ch] * bf1(P[(size_t)(t - 1) * NIN + COL_B + ch]);
        if (t < CTXL - 1) v += w[2 * 3 * WMIX + ch] * bf1(P[(size_t)(t + 1) * NIN + COL_B + ch]);
        const int part = ch / WMIX, c = ch - part * WMIX; UC[((size_t)part * CTXL + t) * WMIX + c] = v; }
}
__device__ __forceinline__ void filt_mlp(const Frame& F_, const Args& A, int layer, bool with_ctx) {
    const Frame F = fresh(F_);
    float* H2 = WSP(float, WS_H2); float* H2C = WSP(float, WS_H2C);
    const float* fw1 = inp(A, I_HFW1) + (size_t)layer * 33 * 64; const float* fb1 = inp(A, I_HFB1) + layer * 64; const float* fr = inp(A, I_HFREQ) + layer * 64;
    const float* fw2 = inp(A, I_HFW2) + (size_t)layer * 64 * 64; const float* fb2 = inp(A, I_HFB2) + layer * 64;
    const int j = F.lane; const float frj = fr[j], b1 = fb1[j], b2 = fb2[j];
    const int total = SEQ + (with_ctx ? CTXL : 0);
    for (int u = F.gw; u < total; u += F.ngw) { const bool isc = u >= SEQ; const int t = isc ? u - SEQ : u, L = isc ? CTXL : SEQ;
        const float tl = (float)t / (float)(L - 1);
        const int b = j & 15; const float band = 1e-4f + (float)b * ((15.0f - 1e-4f) / 15.0f);
        const float ang = (6.283185307179586f / (float)L) * (float)t * band; float sn, cs; sincosf(ang, &sn, &cs); const float zc = cs, zs = -sn;
        float pre = b1 + tl * fw1[j];
#pragma unroll
        for (int i = 0; i < 16; ++i) { pre += lane_bcast(zc, i) * fw1[(1 + i) * 64 + j]; pre += lane_bcast(zs, i) * fw1[(17 + i) * 64 + j]; }
        const float h1 = sinf(frj * pre);
        float pre2 = b2;
#pragma unroll 16
        for (int i = 0; i < 64; ++i) pre2 += lane_bcast(h1, i) * fw2[i * 64 + j];
        const float h2 = sinf(frj * pre2);
        (isc ? H2C : H2)[(size_t)t * 64 + j] = h2; }
}
__device__ __forceinline__ float hy_delta(int c) {
    const float d0 = -4.605170185988091f / 1.5f, d1 = -4.605170185988091f / 0.3f; return d0 + (float)c * ((d1 - d0) / 1535.0f);
}
__device__ __forceinline__ void filt_taps_unit(const Frame& F_, const Args& A, int layer, int u) {
    const Frame F = fresh(F_);
    const float* H2 = WSP(float, WS_H2); float* KT = WSP(float, WS_KT); const float* fw3 = inp(A, I_HFW3) + (size_t)layer * 64 * 6144;
    LAS float* Wl = (LAS float*)F.lds;
    { const int cg = u >> 4, tsb = u & 15, t = tsb * 512 + F.tid;
        __syncthreads();
#pragma unroll 1
        for (int i = 0; i < 12; ++i) { const int e = F.tid + 512 * i, j = e / 96, rem = e - j * 96, od = rem / 24, cl = rem - od * 24;
            Wl[(cl * 4 + od) * 64 + j] = fw3[(size_t)j * 6144 + od * WMIX + cg * 24 + cl]; }
        f32x4 h2[16];
#pragma unroll
        for (int i = 0; i < 16; ++i) h2[i] = *(const f32x4*)(H2 + (size_t)t * 64 + 4 * i);
        __syncthreads();
        const float tl = (float)t / (float)(SEQ - 1);
#pragma unroll 1
        for (int cp = 0; cp < 12; ++cp) { float acc[8];
#pragma unroll
            for (int q = 0; q < 8; ++q) { const LAS f32x4* wp = (const LAS f32x4*)(Wl + (cp * 8 + q) * 64); f32x4 a = {0.f, 0.f, 0.f, 0.f};
#pragma unroll
                for (int i = 0; i < 16; ++i) { a += h2[i] * wp[i]; if ((i & 3) == 3) asm volatile("" ::: "memory"); }
                acc[q] = (a.x + a.y) + (a.z + a.w); asm volatile("" : "+v"(acc[q]) :: "memory"); }
            const int c = cg * 24 + 2 * cp; const float d0 = __expf(tl * hy_delta(c)), d1 = __expf(tl * hy_delta(c + 1));
#pragma unroll
            for (int o = 0; o < 2; ++o) { f32x2* kt = (f32x2*)KT + ((size_t)o * (WMIX / 2) + (c >> 1)) * FFTN;
                const f32x2 hf = {acc[o * 2] * d0, acc[4 + o * 2] * d1}, hb = {acc[o * 2 + 1] * d0, acc[4 + o * 2 + 1] * d1};
                if (t == 0) { kt[0] = hf + hb; kt[SEQ] = (f32x2){0.f, 0.f}; } else { kt[t] = hf; kt[FFTN - t] = hb; } } }
    }
    __syncthreads();
}
__device__ __forceinline__ void filt_taps_ctx(const Frame& F_, const Args& A, int layer) {
    const Frame F = fresh(F_);
    const float* H2C = WSP(float, WS_H2C); float* KC = WSP(float, WS_KC); const float* fw3 = inp(A, I_HFW3) + (size_t)layer * 64 * 6144;
    for (int u = F.gw; u < CTXL * 48; u += F.ngw) { const int t = u / 48, oc = (u - t * 48) * 64 + F.lane, o = oc / WMIX, c = oc - o * WMIX;
        const float hrow = H2C[t * 64 + F.lane];
        const float* wf = fw3 + o * 2 * WMIX + c; float hf = 0.f, hb = 0.f;
#pragma unroll 32
        for (int j = 0; j < 64; ++j) { const float h = lane_bcast(hrow, j); hf += h * wf[(size_t)j * 6144]; hb += h * wf[(size_t)j * 6144 + WMIX]; }
        const float dec = __expf(((float)t / (float)(CTXL - 1)) * hy_delta(c)); hf *= dec; hb *= dec;
        float* kc = KC + (size_t)o * 512 * WMIX + c;
        if (t == 0) kc[(size_t)255 * WMIX] = hf + hb; else { kc[(size_t)(255 + t) * WMIX] = hf; kc[(size_t)(255 - t) * WMIX] = hb; } }
}
__device__ __forceinline__ void filt_norm_ctx(const Frame& F_, const Args& A) {
    const Frame F = fresh(F_);
    const float* KC = WSP(float, WS_KC); float* KCN = WSP(float, WS_KCN); LAS float* red = (LAS float*)F.lds;
    for (int u = F.bid; u < 48; u += F.G) { const int o = u / 24, c = (u - o * 24) * 64 + F.lane; const float* kc = KC + (size_t)o * 512 * WMIX + c; float s = 0.f;
#pragma unroll 16
        for (int i = 0; i < 64; ++i) { const int l = F.wave + 8 * i; const float k = (l < 511) ? kc[(size_t)l * WMIX] : 0.f; s += k * k; }
        __syncthreads(); red[F.wave * 64 + F.lane] = s; __syncthreads();
        if (F.wave == 0) { float t = 0.f;
#pragma unroll
            for (int w = 0; w < 8; ++w) t += red[w * 64 + F.lane];
            KCN[o * WMIX + c] = rsqrtf(t + EPSN); }
    }
    __syncthreads();
}

#define DFT_BF0(A_, B_) do { const f32x2 a_ = (A_), t_ = (B_); (A_) = a_ + t_; (B_) = a_ - t_; } while (0)
#define DFT_BF8(A_, B_) do { const f32x2 a_ = (A_), b_ = (B_); const f32x2 t_ = {b_.y, -b_.x}; (A_) = a_ + t_; (B_) = a_ - t_; } while (0)
#define DFT_BFW(A_, B_, C_, S_) do { const f32x2 a_ = (A_), b_ = (B_); const f32x2 t_ = {b_.x * (C_) - b_.y * (S_), b_.x * (S_) + b_.y * (C_)}; (A_) = a_ + t_; (B_) = a_ - t_; } while (0)
template <int OFF> __device__ __forceinline__ void dft32(f32x2 (&v)[32]) {
    { const f32x2 t = v[OFF + 1]; v[OFF + 1] = v[OFF + 16]; v[OFF + 16] = t; }
    { const f32x2 t = v[OFF + 2]; v[OFF + 2] = v[OFF + 8]; v[OFF + 8] = t; }
    { const f32x2 t = v[OFF + 3]; v[OFF + 3] = v[OFF + 24]; v[OFF + 24] = t; }
    { const f32x2 t = v[OFF + 5]; v[OFF + 5] = v[OFF + 20]; v[OFF + 20] = t; }
    { const f32x2 t = v[OFF + 6]; v[OFF + 6] = v[OFF + 12]; v[OFF + 12] = t; }
    { const f32x2 t = v[OFF + 7]; v[OFF + 7] = v[OFF + 28]; v[OFF + 28] = t; }
    { const f32x2 t = v[OFF + 9]; v[OFF + 9] = v[OFF + 18]; v[OFF + 18] = t; }
    { const f32x2 t = v[OFF + 11]; v[OFF + 11] = v[OFF + 26]; v[OFF + 26] = t; }
    { const f32x2 t = v[OFF + 13]; v[OFF + 13] = v[OFF + 22]; v[OFF + 22] = t; }
    { const f32x2 t = v[OFF + 15]; v[OFF + 15] = v[OFF + 30]; v[OFF + 30] = t; }
    { const f32x2 t = v[OFF + 19]; v[OFF + 19] = v[OFF + 25]; v[OFF + 25] = t; }
    { const f32x2 t = v[OFF + 23]; v[OFF + 23] = v[OFF + 29]; v[OFF + 29] = t; }
    DFT_BF0(v[OFF + 0], v[OFF + 1]);
    DFT_BF0(v[OFF + 2], v[OFF + 3]);
    DFT_BF0(v[OFF + 4], v[OFF + 5]);
    DFT_BF0(v[OFF + 6], v[OFF + 7]);
    DFT_BF0(v[OFF + 8], v[OFF + 9]);
    DFT_BF0(v[OFF + 10], v[OFF + 11]);
    DFT_BF0(v[OFF + 12], v[OFF + 13]);
    DFT_BF0(v[OFF + 14], v[OFF + 15]);
    DFT_BF0(v[OFF + 16], v[OFF + 17]);
    DFT_BF0(v[OFF + 18], v[OFF + 19]);
    DFT_BF0(v[OFF + 20], v[OFF + 21]);
    DFT_BF0(v[OFF + 22], v[OFF + 23]);
    DFT_BF0(v[OFF + 24], v[OFF + 25]);
    DFT_BF0(v[OFF + 26], v[OFF + 27]);
    DFT_BF0(v[OFF + 28], v[OFF + 29]);
    DFT_BF0(v[OFF + 30], v[OFF + 31]);
    DFT_BF0(v[OFF + 0], v[OFF + 2]);
    DFT_BF8(v[OFF + 1], v[OFF + 3]);
    DFT_BF0(v[OFF + 4], v[OFF + 6]);
    DFT_BF8(v[OFF + 5], v[OFF + 7]);
    DFT_BF0(v[OFF + 8], v[OFF + 10]);
    DFT_BF8(v[OFF + 9], v[OFF + 11]);
    DFT_BF0(v[OFF + 12], v[OFF + 14]);
    DFT_BF8(v[OFF + 13], v[OFF + 15]);
    DFT_BF0(v[OFF + 16], v[OFF + 18]);
    DFT_BF8(v[OFF + 17], v[OFF + 19]);
    DFT_BF0(v[OFF + 20], v[OFF + 22]);
    DFT_BF8(v[OFF + 21], v[OFF + 23]);
    DFT_BF0(v[OFF + 24], v[OFF + 26]);
    DFT_BF8(v[OFF + 25], v[OFF + 27]);
    DFT_BF0(v[OFF + 28], v[OFF + 30]);
    DFT_BF8(v[OFF + 29], v[OFF + 31]);
    DFT_BF0(v[OFF + 0], v[OFF + 4]);
    DFT_BFW(v[OFF + 1], v[OFF + 5], 0.70710678118654757f, -0.70710678118654746f);
    DFT_BF8(v[OFF + 2], v[OFF + 6]);
    DFT_BFW(v[OFF + 3], v[OFF + 7], -0.70710678118654746f, -0.70710678118654757f);
    DFT_BF0(v[OFF + 8], v[OFF + 12]);
    DFT_BFW(v[OFF + 9], v[OFF + 13], 0.70710678118654757f, -0.70710678118654746f);
    DFT_BF8(v[OFF + 10], v[OFF + 14]);
    DFT_BFW(v[OFF + 11], v[OFF + 15], -0.70710678118654746f, -0.70710678118654757f);
    DFT_BF0(v[OFF + 16], v[OFF + 20]);
    DFT_BFW(v[OFF + 17], v[OFF + 21], 0.70710678118654757f, -0.70710678118654746f);
    DFT_BF8(v[OFF + 18], v[OFF + 22]);
    DFT_BFW(v[OFF + 19], v[OFF + 23], -0.70710678118654746f, -0.70710678118654757f);
    DFT_BF0(v[OFF + 24], v[OFF + 28]);
    DFT_BFW(v[OFF + 25], v[OFF + 29], 0.70710678118654757f, -0.70710678118654746f);
    DFT_BF8(v[OFF + 26], v[OFF + 30]);
    DFT_BFW(v[OFF + 27], v[OFF + 31], -0.70710678118654746f, -0.70710678118654757f);
    DFT_BF0(v[OFF + 0], v[OFF + 8]);
    DFT_BFW(v[OFF + 1], v[OFF + 9], 0.92387953251128674f, -0.38268343236508978f);
    DFT_BFW(v[OFF + 2], v[OFF + 10], 0.70710678118654757f, -0.70710678118654746f);
    DFT_BFW(v[OFF + 3], v[OFF + 11], 0.38268343236508984f, -0.92387953251128674f);
    DFT_BF8(v[OFF + 4], v[OFF + 12]);
    DFT_BFW(v[OFF + 5], v[OFF + 13], -0.38268343236508973f, -0.92387953251128674f);
    DFT_BFW(v[OFF + 6], v[OFF + 14], -0.70710678118654746f, -0.70710678118654757f);
    DFT_BFW(v[OFF + 7], v[OFF + 15], -0.92387953251128674f, -0.38268343236508989f);
    DFT_BF0(v[OFF + 16], v[OFF + 24]);
    DFT_BFW(v[OFF + 17], v[OFF + 25], 0.92387953251128674f, -0.38268343236508978f);
    DFT_BFW(v[OFF + 18], v[OFF + 26], 0.70710678118654757f, -0.70710678118654746f);
    DFT_BFW(v[OFF + 19], v[OFF + 27], 0.38268343236508984f, -0.92387953251128674f);
    DFT_BF8(v[OFF + 20], v[OFF + 28]);
    DFT_BFW(v[OFF + 21], v[OFF + 29], -0.38268343236508973f, -0.92387953251128674f);
    DFT_BFW(v[OFF + 22], v[OFF + 30], -0.70710678118654746f, -0.70710678118654757f);
    DFT_BFW(v[OFF + 23], v[OFF + 31], -0.92387953251128674f, -0.38268343236508989f);
    DFT_BF0(v[OFF + 0], v[OFF + 16]);
    DFT_BFW(v[OFF + 1], v[OFF + 17], 0.98078528040323043f, -0.19509032201612825f);
    DFT_BFW(v[OFF + 2], v[OFF + 18], 0.92387953251128674f, -0.38268343236508978f);
    DFT_BFW(v[OFF + 3], v[OFF + 19], 0.83146961230254524f, -0.55557023301960218f);
    DFT_BFW(v[OFF + 4], v[OFF + 20], 0.70710678118654757f, -0.70710678118654746f);
    DFT_BFW(v[OFF + 5], v[OFF + 21], 0.55557023301960229f, -0.83146961230254524f);
    DFT_BFW(v[OFF + 6], v[OFF + 22], 0.38268343236508984f, -0.92387953251128674f);
    DFT_BFW(v[OFF + 7], v[OFF + 23], 0.19509032201612833f, -0.98078528040323043f);
    DFT_BF8(v[OFF + 8], v[OFF + 24]);
    DFT_BFW(v[OFF + 9], v[OFF + 25], -0.19509032201612819f, -0.98078528040323043f);
    DFT_BFW(v[OFF + 10], v[OFF + 26], -0.38268343236508973f, -0.92387953251128674f);
    DFT_BFW(v[OFF + 11], v[OFF + 27], -0.55557023301960196f, -0.83146961230254546f);
    DFT_BFW(v[OFF + 12], v[OFF + 28], -0.70710678118654746f, -0.70710678118654757f);
    DFT_BFW(v[OFF + 13], v[OFF + 29], -0.83146961230254535f, -0.55557023301960218f);
    DFT_BFW(v[OFF + 14], v[OFF + 30], -0.92387953251128674f, -0.38268343236508989f);
    DFT_BFW(v[OFF + 15], v[OFF + 31], -0.98078528040323043f, -0.19509032201612861f);
}
template <int OFF> __device__ __forceinline__ void dft16(f32x2 (&v)[32]) {
    { const f32x2 t = v[OFF + 1]; v[OFF + 1] = v[OFF + 8]; v[OFF + 8] = t; }
    { const f32x2 t = v[OFF + 2]; v[OFF + 2] = v[OFF + 4]; v[OFF + 4] = t; }
    { const f32x2 t = v[OFF + 3]; v[OFF + 3] = v[OFF + 12]; v[OFF + 12] = t; }
    { const f32x2 t = v[OFF + 5]; v[OFF + 5] = v[OFF + 10]; v[OFF + 10] = t; }
    { const f32x2 t = v[OFF + 7]; v[OFF + 7] = v[OFF + 14]; v[OFF + 14] = t; }
    { const f32x2 t = v[OFF + 11]; v[OFF + 11] = v[OFF + 13]; v[OFF + 13] = t; }
    DFT_BF0(v[OFF + 0], v[OFF + 1]);
    DFT_BF0(v[OFF + 2], v[OFF + 3]);
    DFT_BF0(v[OFF + 4], v[OFF + 5]);
    DFT_BF0(v[OFF + 6], v[OFF + 7]);
    DFT_BF0(v[OFF + 8], v[OFF + 9]);
    DFT_BF0(v[OFF + 10], v[OFF + 11]);
    DFT_BF0(v[OFF + 12], v[OFF + 13]);
    DFT_BF0(v[OFF + 14], v[OFF + 15]);
    DFT_BF0(v[OFF + 0], v[OFF + 2]);
    DFT_BF8(v[OFF + 1], v[OFF + 3]);
    DFT_BF0(v[OFF + 4], v[OFF + 6]);
    DFT_BF8(v[OFF + 5], v[OFF + 7]);
    DFT_BF0(v[OFF + 8], v[OFF + 10]);
    DFT_BF8(v[OFF + 9], v[OFF + 11]);
    DFT_BF0(v[OFF + 12], v[OFF + 14]);
    DFT_BF8(v[OFF + 13], v[OFF + 15]);
    DFT_BF0(v[OFF + 0], v[OFF + 4]);
    DFT_BFW(v[OFF + 1], v[OFF + 5], 0.70710678118654757f, -0.70710678118654746f);
    DFT_BF8(v[OFF + 2], v[OFF + 6]);
    DFT_BFW(v[OFF + 3], v[OFF + 7], -0.70710678118654746f, -0.70710678118654757f);
    DFT_BF0(v[OFF + 8], v[OFF + 12]);
    DFT_BFW(v[OFF + 9], v[OFF + 13], 0.70710678118654757f, -0.70710678118654746f);
    DFT_BF8(v[OFF + 10], v[OFF + 14]);
    DFT_BFW(v[OFF + 11], v[OFF + 15], -0.70710678118654746f, -0.70710678118654757f);
    DFT_BF0(v[OFF + 0], v[OFF + 8]);
    DFT_BFW(v[OFF + 1], v[OFF + 9], 0.92387953251128674f, -0.38268343236508978f);
    DFT_BFW(v[OFF + 2], v[OFF + 10], 0.70710678118654757f, -0.70710678118654746f);
    DFT_BFW(v[OFF + 3], v[OFF + 11], 0.38268343236508984f, -0.92387953251128674f);
    DFT_BF8(v[OFF + 4], v[OFF + 12]);
    DFT_BFW(v[OFF + 5], v[OFF + 13], -0.38268343236508973f, -0.92387953251128674f);
    DFT_BFW(v[OFF + 6], v[OFF + 14], -0.70710678118654746f, -0.70710678118654757f);
    DFT_BFW(v[OFF + 7], v[OFF + 15], -0.92387953251128674f, -0.38268343236508989f);
}

__device__ __forceinline__ f32x2 cmul(f32x2 a, f32x2 b) { return (f32x2){a.x * b.x - a.y * b.y, a.x * b.y + a.y * b.x}; }
__device__ __forceinline__ int pidx(int i) { return i + (i >> 5); }
template <int R, int OFF> __device__ __forceinline__ void twiddle_reg(f32x2 (&v)[32], int num, float inv_den) {
    float s, c; __sincosf(-6.283185307179586f * (float)num * inv_den, &s, &c); const f32x2 w = {c, s}; f32x2 wr = w;
#pragma unroll
    for (int r = 1; r < R; ++r) { v[OFF + r] = cmul(v[OFF + r], wr); wr = cmul(wr, w); }
}
template <bool IN_REGS, bool HALF_ZERO, bool OUT_REGS> __device__ __forceinline__ void fft16k(LAS f32x2* Z, f32x2 (&v)[32], int tid) {
    asm volatile("" : "+v"(tid));
    LAS f32x2* Zt = Z + pidx(tid);
    if (!IN_REGS) {
#pragma unroll
        for (int r = 0; r < 32; ++r) v[r] = (HALF_ZERO && r >= 16) ? (f32x2){0.f, 0.f} : Zt[528 * r];
        __syncthreads(); }
    dft32<0>(v);
    { LAS f32x2* Zw = Z + 33 * tid;
#pragma unroll
      for (int q = 0; q < 32; ++q) Zw[q] = v[q]; }
    __syncthreads();
#pragma unroll
    for (int r = 0; r < 32; ++r) v[r] = Zt[528 * r];
    __syncthreads();
    twiddle_reg<32, 0>(v, tid & 31, 1.0f / 1024.0f); dft32<0>(v);
    { LAS f32x2* Zw = Z + (tid >> 5) * 1056 + (tid & 31);
#pragma unroll
      for (int q = 0; q < 32; ++q) Zw[33 * q] = v[q]; }
    __syncthreads();
#pragma unroll
    for (int h = 0; h < 2; ++h)
#pragma unroll
        for (int r = 0; r < 16; ++r) v[h * 16 + r] = Zt[528 * h + 1056 * r];
    __syncthreads();
    twiddle_reg<16, 0>(v, tid, 1.0f / 16384.0f); twiddle_reg<16, 16>(v, tid + 512, 1.0f / 16384.0f); dft16<0>(v); dft16<16>(v);
    if (!OUT_REGS) {
#pragma unroll
        for (int h = 0; h < 2; ++h)
#pragma unroll
            for (int q = 0; q < 16; ++q) Zt[528 * h + 1056 * q] = v[h * 16 + q];
        __syncthreads(); }
}
__device__ __forceinline__ void filt_spectra_unit(const Frame& F_, const Args& A, int u) {
    const Frame F = fresh(F_);
    const float* KT = WSP(float, WS_KT); f32x2* PM = WSP(f32x2, WS_PM); LAS f32x2* Z = (LAS f32x2*)F.lds; LAS float* red = (LAS float*)(F.lds + RED_OFF); constexpr int PMS = 8704;
    { const int o = u / 768, p = u - o * 768;
        const f32x2* kab = (const f32x2*)KT + ((size_t)o * (WMIX / 2) + p) * FFTN + F.tid;
        f32x2 v[32]; float sa = 0.f, sb = 0.f;
#pragma unroll
        for (int r = 0; r < 32; ++r) { v[r] = kab[512 * r]; sa += v[r].x * v[r].x; sb += v[r].y * v[r].y; }
        sa = wave_sum(sa); sb = wave_sum(sb);
        __syncthreads();
        if (F.lane == 0) { red[F.wave * 2] = sa; red[F.wave * 2 + 1] = sb; }
        __syncthreads();
        float ta = 0.f, tb = 0.f;
#pragma unroll
        for (int w = 0; w < 8; ++w) { ta += red[w * 2]; tb += red[w * 2 + 1]; }
        const float na = rsqrtf(ta + EPSN) * 0.5f, nb = rsqrtf(tb + EPSN) * 0.5f;
#pragma unroll
        for (int r = 0; r < 32; ++r) { const float a = v[r].x * na, b = v[r].y * nb; v[r] = (f32x2){a + b, a - b}; }
        fft16k<true, false, false>(Z, v, F.tid);
        f32x4* pm4 = (f32x4*)PM + (size_t)(o * 768 + p) * PMS;
#pragma unroll 4
        for (int i = 0; i < 16; ++i) { const int k = F.tid + 512 * i, km = (FFTN - k) & (FFTN - 1); const f32x2 wk = Z[pidx(k)], wm = Z[pidx(km)];
            pm4[k] = (f32x4){0.5f * (wk.x + wm.x), 0.5f * (wk.y - wm.y), 0.5f * (wk.y + wm.y), -0.5f * (wk.x - wm.x)}; }
        if (F.tid == 0) { const f32x2 wk = Z[pidx(FFTN / 2)]; pm4[FFTN / 2] = (f32x4){wk.x, 0.f, wk.y, 0.f}; }
    }
    __syncthreads();
}
__device__ __forceinline__ void filler(const Frame& F, const Args& A, int kind, int flayer, int base, int j, int nidle, int quota) {
    if (j < 0) return;
    const int total = (kind == 1) ? 1024 : 1536;
#pragma unroll 1
    for (int m = 0; m < quota; ++m) { const int u = base + j + nidle * m; if (u >= total || u >= base + nidle * quota) break;
        if (kind == 1) filt_taps_unit(F, A, flayer, u); else filt_spectra_unit(F, A, u); }
}
__device__ __forceinline__ void hyena_conv_unit(const Frame& F_, const Args& A, int layer, int p) {
    const Frame F = fresh(F_);
    const unsigned* VT2 = WSP(unsigned, WS_VT)  ; unsigned* YBT2 = WSP(unsigned, WS_YBT)  ; const f32x4* PM4 = WSP(f32x4, WS_PM); LAS f32x2* Z = (LAS f32x2*)F.lds; constexpr int PMS = 8704;
    const int tid = F.tid; const float* skip = inp(A, I_HSKIP) + (size_t)layer * 2 * WMIX;
    LAS f32x2* Zt = Z + pidx(tid);
    f32x2 v[32];
    __syncthreads();
    { const unsigned* v0 = VT2 + (size_t)p * SEQ + tid;
#pragma unroll
      for (int r = 0; r < 16; ++r) { const unsigned w = v0[512 * r]; Zt[528 * r] = (f32x2){bflo(w), bfhi(w)}; } }
    __syncthreads();
#pragma unroll 1
    for (int o = 0; o < 2; ++o) {
        const f32x4* pmp = PM4 + (size_t)(o * 768 + p) * PMS;
        f32x4 pm[16];
#pragma unroll
        for (int i = 0; i < 16; ++i) pm[i] = pmp[tid + 512 * i];
        const f32x4 pmh = pmp[FFTN / 2];
        fft16k<false, true, false>(Z, v, tid);
#pragma unroll
        for (int i = 0; i < 16; ++i) { const int k = tid + 512 * i, km = (FFTN - k) & (FFTN - 1); const f32x2 zk = Zt[528 * i], zm = Z[pidx(km)];
            const f32x2 pk = {pm[i].x, pm[i].y}, mk = {pm[i].z, pm[i].w};
            const f32x2 cyk = cmul((f32x2){zk.x, -zk.y}, (f32x2){pk.x, -pk.y}) + cmul(zm, (f32x2){mk.x, -mk.y});
            const f32x2 cym = cmul((f32x2){zm.x, -zm.y}, pk) + cmul(zk, mk);
            Zt[528 * i] = cyk; if (km != k) Z[pidx(km)] = cym; }
        if (tid == 0) { const int k = FFTN / 2; const f32x2 zk = Z[pidx(k)]; const f32x2 pk = {pmh.x, pmh.y}, mk = {pmh.z, pmh.w};
            Z[pidx(k)] = cmul((f32x2){zk.x, -zk.y}, (f32x2){pk.x, -pk.y}) + cmul(zk, (f32x2){mk.x, -mk.y}); }
        __syncthreads();
        const unsigned* gp = VT2 + ((size_t)(o + 1) * (WMIX / 2) + p) * SEQ + tid;
        const unsigned* zp = ((o == 0) ? VT2 : (const unsigned*)YBT2) + (size_t)p * SEQ + tid;
        unsigned gg[16], zz[16];
#pragma unroll
        for (int h = 0; h < 2; ++h)
#pragma unroll
            for (int q = 0; q < 8; ++q) { const int dt = 512 * h + 1024 * q; gg[h * 8 + q] = gp[dt]; zz[h * 8 + q] = zp[dt]; }
        fft16k<false, false, true>(Z, v, tid);
        const float ska = skip[o * WMIX + 2 * p], skb = skip[o * WMIX + 2 * p + 1];
        unsigned* yo = YBT2 + (size_t)p * SEQ + tid;
#pragma unroll
        for (int h = 0; h < 2; ++h)
#pragma unroll
            for (int q = 0; q < 8; ++q) { const f32x2 R = v[h * 16 + q], g = {bflo(gg[h * 8 + q]), bfhi(gg[h * 8 + q])}, z = {bflo(zz[h * 8 + q]), bfhi(zz[h * 8 + q])};
                const f32x2 zn = {g.x * (R.x * (1.0f / FFTN) + ska * z.x), g.y * (-R.y * (1.0f / FFTN) + skb * z.y)};
                const unsigned zw = pk2(zn.x, zn.y); yo[512 * h + 1024 * q] = zw; if (o == 0) Zt[528 * h + 1056 * q] = (f32x2){bflo(zw), bfhi(zw)}; }
        __syncthreads();
    }
}
#ifdef PROBE_FFT
__device__ __forceinline__ void hyena_fft_dummy(const Frame& F_) {
    const Frame F = fresh(F_); LAS f32x2* Z = (LAS f32x2*)F.lds; f32x2 v[32];
    __syncthreads();
#pragma unroll 1
    for (int o = 0; o < 2; ++o) { fft16k<false, true, false>(Z, v, F.tid); fft16k<false, false, true>(Z, v, F.tid);
        if (v[0].x == 123456.789f) Z[0] = v[5];
        __syncthreads(); }
}
#endif
__device__ __forceinline__ void hyena_ctx_unit(const Frame& F_, const Args& A, int layer, int u) {
    const Frame F = fresh(F_);
    const float* UC = WSP(float, WS_UC); const float* KC = WSP(float, WS_KC); const float* KCN = WSP(float, WS_KCN); bf16* YB = WSP(bf16, WS_YB);
    LAS float* zb0 = (LAS float*)F.lds; LAS float* zb1 = zb0 + 256 * 32;
    const int cl = F.tid & 31, tb = F.tid >> 5, c = u * 32 + cl, t0 = tb * 16; const float* skip = inp(A, I_HSKIP) + (size_t)layer * 2 * WMIX;
    float zc[16], g1[16], g2[16];
    __syncthreads();
#pragma unroll
    for (int i = 0; i < 16; ++i) { zc[i] = UC[((size_t)0 * CTXL + t0 + i) * WMIX + c]; g1[i] = UC[((size_t)1 * CTXL + t0 + i) * WMIX + c]; g2[i] = UC[((size_t)2 * CTXL + t0 + i) * WMIX + c]; zb0[(t0 + i) * 32 + cl] = zc[i]; }
    __syncthreads();
#pragma unroll
    for (int o = 0; o < 2; ++o) { const LAS float* zb = o ? zb1 : zb0; const float* kc = KC + (size_t)o * 512 * WMIX + c; float acc[16];
#pragma unroll
        for (int i = 0; i < 16; ++i) acc[i] = 0.f;
#pragma unroll 1
        for (int s0 = 0; s0 < CTXL; s0 += 16) { float w[31]; const float* kb = kc + (size_t)(255 + t0 - s0 - 15) * WMIX;
#pragma unroll
            for (int q = 0; q < 31; ++q) w[q] = kb[(size_t)q * WMIX];
#pragma unroll
            for (int j = 0; j < 16; ++j) { const float zs = zb[(s0 + j) * 32 + cl];
#pragma unroll
                for (int i = 0; i < 16; ++i) acc[i] += w[15 + i - j] * zs; } }
        const float kn = KCN[o * WMIX + c], sk = skip[o * WMIX + c];
#pragma unroll
        for (int i = 0; i < 16; ++i) { const float zn = (o ? g2[i] : g1[i]) * (acc[i] * kn + sk * zc[i]);
            if (o == 0) { zc[i] = zn; zb1[(t0 + i) * 32 + cl] = zn; } else YB[(size_t)(t0 + i) * WMIX + c] = (bf16)f2bf(zn); }
        __syncthreads(); }
}
__device__ __forceinline__ void lru_chunk_agg(const Frame& F_, const Args& A) {
    const Frame F = fresh(F_);
    const unsigned* LAB = WSP(unsigned, WS_LA); float* CA = WSP(float, WS_CA); float* CB = WSP(float, WS_CB);
    for (int u = F.gw; u < NCHUNK * 12; u += F.ngw) { const int chunk = u / 12, rem = u - chunk * 12, dir = rem / 6, c = (rem - dir * 6) * 256 + 4 * F.lane;
        const unsigned* pab = LAB + (((size_t)dir * NCHUNK + chunk) * 6 + (c >> 8)) * 64 * 256 + (c & 255);
        f32x4 Aa = {1.f, 1.f, 1.f, 1.f}, B = {0.f, 0.f, 0.f, 0.f};
#pragma unroll 32
        for (int i = 0; i < 64; ++i) { const int rr = dir ? 63 - i : i; const v4u w = *(const v4u*)(pab + rr * 256);
            const f32x4 a = {__expf(bflo(w.x)), __expf(bflo(w.y)), __expf(bflo(w.z)), __expf(bflo(w.w))}, b = {bfhi(w.x), bfhi(w.y), bfhi(w.z), bfhi(w.w)}; B = a * B + b; Aa = Aa * a; }
        *(f32x4*)(CA + ((size_t)dir * NCHUNK + chunk) * WMIX + c) = Aa; *(f32x4*)(CB + ((size_t)dir * NCHUNK + chunk) * WMIX + c) = B; }
}
__device__ __forceinline__ void lru_carries(const Frame& F_, const Args& A) {
    const Frame F = fresh(F_);
    const float* CA = WSP(float, WS_CA); const float* CB = WSP(float, WS_CB); float* CIN = WSP(float, WS_CIN);
    const int slot = F.bid >> 3; if ((F.bid & 7) != 1 || slot < 4 || slot >= 10) return;
    { const int u = (slot - 4) * 8 + F.wave; const int dir = u / 24, c = (u - dir * 24) * 64 + F.lane; float H = 0.f;
#pragma unroll 1
        for (int i0 = 0; i0 < NCHUNK; i0 += 22) { float ca[22], cb[22];
#pragma unroll
            for (int j = 0; j < 22; ++j) { const int i = i0 + j, chunk = dir ? ((i < 4) ? 3 - i : NCHUNK + 3 - i) : i; const size_t ix = ((size_t)dir * NCHUNK + chunk) * WMIX + c; ca[j] = CA[ix]; cb[j] = CB[ix]; }
#pragma unroll
            for (int j = 0; j < 22; ++j) { const int i = i0 + j, chunk = dir ? ((i < 4) ? 3 - i : NCHUNK + 3 - i) : i; const size_t ix = ((size_t)dir * NCHUNK + chunk) * WMIX + c; CIN[ix] = H; H = ca[j] * H + cb[j]; } } }
}
__device__ __forceinline__ void lru_out(const Frame& F_, const Args& A) {
    const Frame F = fresh(F_);
    const unsigned* LAB = WSP(unsigned, WS_LA); const float* CIN = WSP(float, WS_CIN); const bf16* P = WSP(bf16, WS_P); bf16* YA = WSP(bf16, WS_YA);
    for (int u = F.gw; u < NCHUNK * 12; u += F.ngw) { const int chunk = u / 12, c = (u - chunk * 12) * 128 + 2 * F.lane, base = chunk * 64;
        const unsigned* pf = LAB + (((size_t)chunk) * 6 + (c >> 8)) * 64 * 256 + (c & 255); const unsigned* pr = pf + (size_t)NCHUNK * 6 * 64 * 256;
        f32x2 hf[64]; f32x2 H = *(const f32x2*)(CIN + ((size_t)chunk) * WMIX + c);
#pragma unroll
        for (int i = 0; i < 64; ++i) { const v2u w = *(const v2u*)(pf + i * 256); H = (f32x2){__expf(bflo(w.x)), __expf(bflo(w.y))} * H + (f32x2){bfhi(w.x), bfhi(w.y)}; hf[i] = H; }
        H = *(const f32x2*)(CIN + ((size_t)NCHUNK + chunk) * WMIX + c);
#pragma unroll
        for (int i = 63; i >= 0; --i) { const v2u w = *(const v2u*)(pr + i * 256); H = (f32x2){__expf(bflo(w.x)), __expf(bflo(w.y))} * H + (f32x2){bfhi(w.x), bfhi(w.y)};
            const unsigned gw = *(const unsigned*)(P + (size_t)(base + i) * NIN + COL_AG + c); const f32x2 y = (hf[i] + H) * (f32x2){bflo(gw), bfhi(gw)};
            *(unsigned*)(YA + (size_t)(base + i) * WMIX + c) = pk2(y.x, y.y); } }
}
__device__ __forceinline__ void yb_transpose(const Frame& F_, const Args& A) {
    const Frame F = fresh(F_);
    const float* YBT = WSP(float, WS_YBT); bf16* YB = WSP(bf16, WS_YB); LAS float* scr = (LAS float*)(F.lds + F.wave * WSCR_BYTES);
    for (int u = F.gw; u < (SEQ / 64) * 24; u += F.ngw) { const int tb = u / 24, c0 = (u - tb * 24) * 64, t0 = tb * 64;
#pragma unroll
        for (int i = 0; i < 32; ++i) { const unsigned y = ((const unsigned*)YBT)[(size_t)((c0 >> 1) + i) * SEQ + t0 + F.lane]; scr[(2 * i) * 65 + F.lane] = bflo(y); scr[(2 * i + 1) * 65 + F.lane] = bfhi(y); }
        LDS_WAIT(); asm volatile("" ::: "memory");
#pragma unroll
        for (int g8 = 0; g8 < 8; ++g8) { const int tt = 8 * g8 + (F.lane >> 3), c8 = (F.lane & 7) * 8; const LAS float* sp = scr + c8 * 65 + tt;
            *(v4u*)(YB + (size_t)(CTXL + t0 + tt) * WMIX + c0 + c8) = (v4u){pk2(sp[0], sp[65]), pk2(sp[130], sp[195]), pk2(sp[260], sp[325]), pk2(sp[390], sp[455])}; }
        LDS_WAIT(); asm volatile("" ::: "memory"); }
}
__device__ __forceinline__ void attn_phase(const Frame& F_, const Args& A, bool with_ctx, char* lds) {
    const Frame F = fresh(F_);
    const att::bf16* QN = WSP(att::bf16, WS_QN); const att::bf16* KN = WSP(att::bf16, WS_KN); const att::bf16* VN = WSP(att::bf16, WS_VN); bf16* YC = WSP(bf16, WS_YC);
    const int x = F.bid & 7, slot = F.bid >> 3, kvh = x >> 1, per = F.G >> 2;
    const int nunits = 3 * (with_ctx ? 33 : 32);
    for (int idx = (x & 1) * (F.G >> 3) + slot; idx < nunits; idx += per) { const int qh = kvh * 3 + idx % 3, qb = idx / 3;
        const int row0 = (qb < 32) ? CTXL + qb * 256 : 0, seq = (qb < 32) ? MROWS : CTXL;
        __syncthreads();
        att::attn_dense_body<att::bf16>(QN + (size_t)row0 * WMIX + qh * 128, KN + kvh * 128, VN + kvh * 128, YC + (size_t)row0 * WMIX + qh * 128, seq, lds, F.tid);
    }
    __syncthreads();
}
#ifndef GEMM_SP2
#define GEMM_SP2 true
#endif
#ifndef GEMM_ALIGN
#define GEMM_ALIGN true
#endif
#ifndef WIN_WGM
#define WIN_WGM 4
#endif
#ifndef KH_CTX
#define KH_CTX 1
#endif
#ifndef KH_LAST
#define KH_LAST 0
#endif
#ifndef WIN_NS
#define WIN_NS 1
#endif
#ifndef UP1_QUOTA
#define UP1_QUOTA 2
#endif
#ifndef WIN_SLABS
#define WIN_SLABS 2
#endif
#ifndef MERGE_ALIGN
#define MERGE_ALIGN GEMM_ALIGN
#endif
#ifndef RESID_ALIGN
#define RESID_ALIGN GEMM_ALIGN
#endif
#ifndef MK_PER_PHASE
#define MK_PER_PHASE 0
#endif
constexpr int PH_PER_LAYER = 15, PH_LAYER0 = 2, PH_FINAL = PH_LAYER0 + DEPTH * PH_PER_LAYER, N_PHASES = PH_FINAL + 1;

__global__ void __launch_bounds__(NWAVES * 64, 2) mk_fwd(Args A) {
    extern __shared__ __attribute__((aligned(16))) unsigned char lds[];
    Frame F;
    F.lds = (LAS unsigned char*)lds; F.ws = (unsigned char*)(GAS unsigned char*)A.ws; F.out = (float*)(GAS float*)A.out;
    F.tid = threadIdx.x; F.lane = F.tid & 63; F.wave = __builtin_amdgcn_readfirstlane((int)threadIdx.x >> 6);
    F.G = gridDim.x; F.bid = blockIdx.x; F.gw = blockIdx.x * NWAVES + F.wave; F.ngw = F.G * NWAVES;
    volatile LAS unsigned* MISC = (volatile LAS unsigned*)(F.lds + MISC_OFF);
    for (int u = F.tid; u < (LDS_BYTES - LDSCTL_OFF) / 4; u += NWAVES * 64) ((LAS unsigned*)(F.lds + LDSCTL_OFF))[u] = 0u;
    __syncthreads();
    gu32* ctl = (gu32*)(F.ws + WS_CTL);
    XcdBarrier bar = xcd_barrier_post((unsigned*)(ctl + CW_BAR), MISC + 8);
    const int lo = A.ph_lo, hi = A.ph_hi;
#define IN(k) (lo <= (k) && (k) < hi)
#ifndef EN_MASK
#define EN_MASK 0xffffffffu
#endif
#define EN(b) ((EN_MASK >> (b)) & 1u)
#ifndef REP_MASK
#define REP_MASK 0u
#endif
#define REPS(b) (((REP_MASK >> (b)) & 1u) ? 2 : 1)
#ifdef PROBE_BAR
#define SEAM(k) do { if (IN(k) && IN((k) + 1)) { xcd_barrier(bar); xcd_barrier(bar); } } while (0)
#else
#define SEAM(k) do { if (IN(k) && IN((k) + 1)) xcd_barrier(bar); } while (0)
#endif
    LAS unsigned char* ring = F.lds + RING_OFF;

    if (EN(0) && IN(0)) { for (int rep_ = 0; rep_ < REPS(0); ++rep_) prologue_a(F, A); filt_mlp(F, A, 0, true); }
    SEAM(0);
    if (EN(1) && IN(1)) { prologue_b(F, A); { const Frame L = fresh(F); for (int u = L.bid; u < 1024; u += L.G) filt_taps_unit(F, A, 0, u); } filt_taps_ctx(F, A, 0); }
    SEAM(1);

    for (int layer = 0; layer < DEPTH; ++layer) {
        const int pb = PH_LAYER0 + layer * PH_PER_LAYER;
        if (!(lo < pb + PH_PER_LAYER && pb < hi)) continue;
        const bool ctx_out = layer < DEPTH - 1;
        const int roff = ctx_out ? 0 : CTXL;
        unsigned char* wb = F.ws + WS_W + (size_t)layer * W_LAYER;
        const float* modL = WSP(float, WS_MOD) + (size_t)(layer * 2 + 0) * NMOD * DM; const float* modC = modL + (size_t)NMOD * DM;
        bf16* U = WSP(bf16, WS_U); bf16* H = WSP(bf16, WS_H); float* X = WSP(float, WS_X); bf16* P = WSP(bf16, WS_P);
        for (int half = 0; half < 2; ++half) {
            const int p0 = pb + (half ? 12 : 0), im = half ? 6 : 0;
            if (EN(2) && IN(p0)) { for (int rep_ = 0; rep_ < REPS(2); ++rep_) { __syncthreads(); norm_phase(F, A, inp(A, half ? I_NF2 : I_NF1) + (size_t)layer * DM, modL, modC, im + 0, im + 1, half ? roff : (layer == 0 ? MROWS : 0));
                if (!half && layer == 0) { const Frame L = fresh(F); for (int u = L.bid; u < 480; u += L.G) filt_spectra_unit(F, A, u); }
                if (half && layer + 1 < DEPTH - 1) filt_taps_ctx(F, A, layer + 1); } }
            SEAM(p0);
            const int hro = half ? roff : 0; const size_t hoff = (size_t)hro * DM;
            if (EN(3) && IN(p0 + 1)) { for (int rep_ = 0; rep_ < REPS(3); ++rep_) { __syncthreads(); pg8::Gemm g{U + hoff, (const bf16*)(wb + (half ? WO_GU2 : WO_GU1)), MROWS - hro, 2 * DFF, DM}; pg8::StaticOrder S; S.init(MROWS - hro, 2 * DFF, F.G, fresh(F).bid);
                pg8::EpiSwiglu E{H + hoff, DFF}; pg8::gemm_phase<pg8::EpiSwiglu, pg8::StaticOrder, GEMM_ALIGN, GEMM_SP2>(ring, g, S, E, fresh(F).tid);
                if (!half) filler(F, A, 2, layer, 480, fresh(F).bid - 32, 224, UP1_QUOTA); else if (layer + 1 < DEPTH) filler(F, A, 1, layer + 1, 960, fresh(F).bid - 32, 224, 1); } }
            SEAM(p0 + 1);
            if (EN(4) && IN(p0 + 2)) for (int rep_ = 0; rep_ < REPS(4); ++rep_) { __syncthreads(); pg8::Gemm g{H + hoff, (const bf16*)(wb + (half ? WO_D2 : WO_D1)), MROWS - hro, DM, DFF}; pg8::StaticOrder S; S.init(MROWS - hro, DM, F.G, fresh(F).bid);
                pg8::EpiResid E{WSP(bf16, WS_M32) + hoff, DM, modL + (im + 2) * DM, (hro ? modL : modC) + (im + 2) * DM, 0.5f}; pg8::gemm_phase<pg8::EpiResid, pg8::StaticOrder, RESID_ALIGN, GEMM_SP2>(ring, g, S, E, fresh(F).tid);
                if (!half) filler(F, A, 2, layer, 928, fresh(F).bid - 16, 240, 2); else if (layer + 1 < DEPTH) filler(F, A, 2, layer + 1, 0, fresh(F).bid - 16, 240, 2); }
            if (half) { SEAM(p0 + 2); continue; }
            SEAM(p0 + 2);
            if (EN(5) && IN(pb + 3)) { for (int rep_ = 0; rep_ < REPS(5); ++rep_) { __syncthreads(); norm_phase(F, A, inp(A, I_NMIX) + (size_t)layer * DM, modL, modC, 3, 4, 0); } }
            SEAM(pb + 3);
            if (EN(6) && IN(pb + 4)) { for (int rep_ = 0; rep_ < REPS(6); ++rep_) { __syncthreads();
                constexpr int NSL = WIN_SLABS, NT_SL = (NIN / 256) / NSL, R_SL = (33 * NT_SL) % 256;
#pragma unroll 1
                for (int sl = 0; sl < NSL; ++sl) { pg8::Gemm g{U, (const bf16*)(wb + WO_IN) + (size_t)sl * (NT_SL * 256) * DM, MROWS, NT_SL * 256, DM}; pg8::StaticOrder S; S.init(MROWS, NT_SL * 256, F.G, fresh(F).bid); S.wgm = WIN_WGM;
                    pg8::EpiWin E{P, NIN, sl * NT_SL}; pg8::gemm_phase<pg8::EpiWin, pg8::StaticOrder, GEMM_ALIGN, GEMM_SP2>(ring, g, S, E, fresh(F).tid); }
                filler(F, A, 2, layer, 1408, fresh(F).bid - R_SL, 256 - R_SL, (168 + 255 - R_SL) / (256 - R_SL)); } }
            SEAM(pb + 4);
            if (EN(7) && IN(pb + 5)) { for (int rep_ = 0; rep_ < REPS(7); ++rep_) { __syncthreads(); prep_lru_conv(F, A, layer); prep_qkv(F, A, layer); prep_hyena_t(F, A, layer); if (ctx_out) { prep_hyena_ctx(F, A, layer); filt_norm_ctx(F, A); } } }
            SEAM(pb + 5);
            if (EN(8) && IN(pb + 6)) { for (int rep_ = 0; rep_ < REPS(8); ++rep_) { __syncthreads(); int klru = 256; asm volatile("" : "+s"(klru));
                pg8::Gemm g{WSP(bf16, WS_XA), (const bf16*)(wb + WO_LRU), 6 * MROWS, 6 * 1024, klru}; pg8::LruOrder S; S.init(F.G, fresh(F).bid);
                pg8::EpiLru E{WSP(float, WS_LA), WSP(float, WS_LB), WSP(bf16, WS_XA), inp(A, I_LBA) + (size_t)layer * 2 * WMIX, inp(A, I_LBX) + (size_t)layer * 2 * WMIX, WSP(float, WS_MOD + 1536 * 1024) + (size_t)layer * 2 * WMIX, MROWS, WSP(float, WS_CA), WSP(float, WS_CB)};
                pg8::gemm_phase<pg8::EpiLru, pg8::LruOrder, GEMM_ALIGN, GEMM_SP2>(ring, g, S, E, fresh(F).tid); } }
            SEAM(pb + 6);
            if (EN(9) && IN(pb + 7)) {   }
            if (EN(10) && IN(pb + 8)) { for (int rep_ = 0; rep_ < REPS(10); ++rep_) { __syncthreads();
                lru_carries(F, A);
                if (EN(17)) for (int r2_ = 0; r2_ < REPS(17); ++r2_) attn_phase(F, A, ctx_out, (char*)lds);
                { const Frame L = fresh(F); const int x = L.bid & 7, slot = L.bid >> 3, nunits = 3 * (ctx_out ? 33 : 32), thr = nunits - 96, KH = ctx_out ? KH_CTX : KH_LAST;
                  const bool light = (x & 1) && slot >= thr; const int nh = 128 + 4 * thr, nl = 4 * (32 - thr), total = 768 + (ctx_out ? 48 : 0);
                  const int hi_ = (x & 1) ? 128 + (x >> 1) * thr + slot : (x >> 1) * 32 + slot, li = (x >> 1) * (32 - thr) + (slot - thr);
                  for (int r2_ = 0; r2_ < REPS(18); ++r2_)
                  for (int m = 0; ; ++m) { int u; if (light) { u = KH * nh + li + nl * m; if (u >= total) break; } else { if (m >= KH) break; u = hi_ + nh * m; if (u >= total) break; }
                      if (u < 768) { if (EN(18)) hyena_conv_unit(F, A, layer, u);
#ifdef PROBE_FFT
                          hyena_fft_dummy(F);
#endif
                      } else { if (EN(19)) hyena_ctx_unit(F, A, layer, u - 768); } } }
            } }
            SEAM(pb + 8);
            if (EN(11) && IN(pb + 9)) { for (int rep_ = 0; rep_ < REPS(11); ++rep_) { __syncthreads(); lru_out(F, A); yb_transpose(F, A); if (layer + 1 < DEPTH) filt_mlp(F, A, layer + 1, layer + 1 < DEPTH - 1); } }
            SEAM(pb + 9);
            if (EN(12) && IN(pb + 10)) { for (int rep_ = 0; rep_ < REPS(12); ++rep_) { __syncthreads(); const bf16* WB = (const bf16*)(wb + WO_BR); float* M32 = WSP(float, WS_M32) + (size_t)roff * DM; pg8::StaticOrder S; S.init(MROWS - roff, DM, F.G, fresh(F).bid);
                const size_t yo = (size_t)roff * WMIX; bf16* Hm = H + (size_t)roff * DM; const bf16* Pg = P + (size_t)roff * NIN + COL_G; const int Mm = MROWS - roff;
                { pg8::Gemm g{WSP(bf16, WS_YA) + yo, WB, Mm, DM, WMIX}; pg8::EpiMerge<0> E{M32, Hm, Pg, NIN}; pg8::gemm_phase<pg8::EpiMerge<0>, pg8::StaticOrder, MERGE_ALIGN, GEMM_SP2>(ring, g, S, E, fresh(F).tid); }
                { pg8::Gemm g{WSP(bf16, WS_YB) + yo, WB + (size_t)DM * WMIX, Mm, DM, WMIX}; pg8::EpiMerge<1> E{M32, Hm, Pg + DM, NIN}; pg8::gemm_phase<pg8::EpiMerge<1>, pg8::StaticOrder, MERGE_ALIGN, GEMM_SP2>(ring, g, S, E, fresh(F).tid); }
                { pg8::Gemm g{WSP(bf16, WS_YC) + yo, WB + (size_t)2 * DM * WMIX, Mm, DM, WMIX}; pg8::EpiMerge<2> E{M32, Hm, Pg + 2 * DM, NIN}; pg8::gemm_phase<pg8::EpiMerge<2>, pg8::StaticOrder, MERGE_ALIGN, GEMM_SP2>(ring, g, S, E, fresh(F).tid); }
                if (layer + 1 < DEPTH) filler(F, A, 1, layer + 1, 0, fresh(F).bid - 16, 240, 2); } }
            SEAM(pb + 10);
            if (EN(13) && IN(pb + 11)) for (int rep_ = 0; rep_ < REPS(13); ++rep_) { __syncthreads(); pg8::Gemm g{H + (size_t)roff * DM, (const bf16*)(wb + WO_OUT), MROWS - roff, DM, DM}; pg8::StaticOrder S; S.init(MROWS - roff, DM, F.G, fresh(F).bid);
                pg8::EpiResid E{WSP(bf16, WS_M32) + (size_t)roff * DM, DM, modL + 5 * DM, (roff ? modL : modC) + 5 * DM, 1.0f}; pg8::gemm_phase<pg8::EpiResid, pg8::StaticOrder, RESID_ALIGN, GEMM_SP2>(ring, g, S, E, fresh(F).tid);
                if (layer + 1 < DEPTH) filler(F, A, 1, layer + 1, 480, fresh(F).bid - 16, 240, 2); }
            SEAM(pb + 11);
        }
    }
#ifdef DUMP
    if (IN(PH_FINAL)) dump_phase(F, A);
#else
    if (EN(14) && IN(PH_FINAL)) final_norm_phase(F, A);
#endif
#undef IN
#undef SEAM
}

extern "C" void kernel_launch(void* const* d_in, const int* in_sizes, int n_in, void* d_out, int out_size, void* d_ws, size_t ws_size, hipStream_t stream) {
    static int grid = 0;
    if (grid == 0) {
        if (n_in != N_IN_TENSORS || in_sizes[0] != SEQ * DM || out_size != SEQ * DM || ws_size < WS_END) {
            fprintf(stderr, "kernel_launch: shape mismatch: n_in %d in0 %d out %d ws %zu (need %zu)\n", n_in, n_in > 0 ? in_sizes[0] : -1, out_size, ws_size, (size_t)WS_END); grid = -1; return; }
        int dev = 0, cus = 0, per_cu = 0;
        if (hipGetDevice(&dev) != hipSuccess || hipDeviceGetAttribute(&cus, hipDeviceAttributeMultiprocessorCount, dev) != hipSuccess) { fprintf(stderr, "kernel_launch: device query failed\n"); grid = -1; return; }
        if (hipFuncSetAttribute((const void*)mk_fwd, hipFuncAttributeMaxDynamicSharedMemorySize, LDS_BYTES) != hipSuccess) { fprintf(stderr, "kernel_launch: hipFuncSetAttribute failed\n"); grid = -1; return; }
        if (hipOccupancyMaxActiveBlocksPerMultiprocessor(&per_cu, (const void*)mk_fwd, NWAVES * 64, LDS_BYTES) != hipSuccess || per_cu < 1)
            fprintf(stderr, "kernel_launch: note: occupancy query reports %d workgroups per CU\n", per_cu);
        (void)hipGetLastError();
        grid = cus;
        if (grid != 256) { fprintf(stderr, "kernel_launch: built for 256 CUs, found %d\n", cus); grid = -1; return; }
    }
    if (grid < 0) return;
    if (hipMemsetAsync((char*)d_ws + WS_CTL, 0, CTL_ZERO_BYTES, stream) != hipSuccess) { fprintf(stderr, "kernel_launch: memset failed\n"); return; }
    Args a{};
    for (int i = 0; i < N_IN_TENSORS; ++i) a.in[i] = (const float*)d_in[i];
    a.out = (float*)d_out; a.ws = (unsigned char*)d_ws;
#if MK_PER_PHASE
#ifndef STOP_PHASE
#define STOP_PHASE PH_FINAL
#endif
    for (int ph = 0; ph < N_PHASES; ++ph) { if (ph >= STOP_PHASE && ph != PH_FINAL) continue; a.ph_lo = ph; a.ph_hi = ph + 1; hipLaunchKernelGGL(mk_fwd, dim3(grid), dim3(NWAVES * 64), LDS_BYTES, stream, a); }
#else
    a.ph_lo = 0; a.ph_hi = N_PHASES; hipLaunchKernelGGL(mk_fwd, dim3(grid), dim3(NWAVES * 64), LDS_BYTES, stream, a);
#endif
    const hipError_t le = hipPeekAtLastError();
    if (le != hipSuccess) fprintf(stderr, "kernel_launch: launch failed: %s\n", hipGetErrorName(le));
}
```

```cpp
#include <hip/hip_runtime.h>
#include <hip/hip_bf16.h>
#include <cstdio>
#include <cstdint>
namespace pg8 {
#define PG8_LAS __attribute__((address_space(3)))
typedef unsigned short bf16_t;
typedef short bf16x8 __attribute__((ext_vector_type(8)));
typedef float f32x4 __attribute__((ext_vector_type(4)));
typedef unsigned u32x4 __attribute__((ext_vector_type(4)));
constexpr int BM = 256, BK = 64, HALF = 128, HTB = HALF * BK * 2  , STAGE_BYTES = 8 * HTB, NXCD = 8, WGM = 8;

__host__ __device__ __forceinline__ int lds_byte(int r, int c) { const int st = (r >> 4) * 2 + (c >> 5), rr = r & 15, cc = c & 31, ob = rr * 64 + cc * 2; return st * 1024 + (ob ^ (((ob >> 9) & 1) << 5)); }
__host__ __device__ __forceinline__ void stage_rc(int b, int& R, int& C) { const int st = b / 1024, sb = b % 1024, swz = sb ^ (((sb >> 9) & 1) << 5); R = (st >> 1) * 16 + swz / 64; C = (st & 1) * 32 + (swz % 64) / 2; }
__host__ __device__ __forceinline__ int perm32(int rho) { const int n = rho >> 4, i = rho & 15; return 8 * (i >> 2) + 4 * n + (i & 3); }

struct Unit { int pm, pn; };
struct Gemm { const bf16_t* A; const bf16_t* Bt; int M, N, K; };

struct StaticOrder {
    int nM, nN, nwg, G, c, wgm = WGM;
    __host__ __device__ void init(int M, int N, int G_, int c_) { nM = M / BM; nN = N / BM; nwg = nM * nN; G = G_; c = c_; }
    __host__ __device__ bool next(int i, Unit& u) const {
        const long L = (long)i * G + c; if (L >= nwg) return false;
        int wgid = (int)L; { const int q = nwg / NXCD, r = nwg % NXCD, xcd = wgid % NXCD, off = wgid / NXCD; wgid = (xcd < r ? xcd * (q + 1) : r * (q + 1) + (xcd - r) * q) + off; }
        const int nig = wgm * nN, gid = wgid / nig, fm = gid * wgm, gsz = (nM - fm) < wgm ? (nM - fm) : wgm;
        u.pm = fm + ((wgid % nig) % gsz); u.pn = (wgid % nig) / gsz; return true;
    }
    __device__ __forceinline__ void a_ready(const Unit&) const {}
    __device__ __forceinline__ void done(const Unit&) const {}
};
struct SplitNOrder {
    int nM, nNs, ns, nwg, G, c, wgm;
    __host__ __device__ void init(int M, int N, int NS, int G_, int c_, int wgm_) { nM = M / BM; ns = NS; nNs = (N / BM) / NS; nwg = nM * nNs * NS; G = G_; c = c_; wgm = wgm_; }
    __host__ __device__ bool next(int i, Unit& u) const {
        const long L = (long)i * G + c; if (L >= nwg) return false;
        int wgid = (int)L; { const int q = nwg / NXCD, r = nwg % NXCD, xcd = wgid % NXCD, off = wgid / NXCD; wgid = (xcd < r ? xcd * (q + 1) : r * (q + 1) + (xcd - r) * q) + off; }
        const int nMv = nM * ns, nig = wgm * nNs, gid = wgid / nig, fm = gid * wgm, gsz = (nMv - fm) < wgm ? (nMv - fm) : wgm;
        const int pv = fm + ((wgid % nig) % gsz), pnl = (wgid % nig) / gsz, slab = pv / nM;
        u.pm = pv - slab * nM; u.pn = slab * nNs + pnl; return true;
    }
    __device__ __forceinline__ void a_ready(const Unit&) const {}
    __device__ __forceinline__ void done(const Unit&) const {}
};
__device__ __forceinline__ unsigned cvt_pk_bf16(float lo, float hi) { unsigned r; asm volatile("v_cvt_pk_bf16_f32 %0, %1, %2" : "=v"(r) : "v"(lo), "v"(hi)); return r; }
typedef float f32x2 __attribute__((ext_vector_type(2)));
template <int MASK> __device__ __forceinline__ float swz_xor(float v) { return __int_as_float(__builtin_amdgcn_ds_swizzle(__float_as_int(v), (MASK << 10) | 0x1f)); }
__device__ __forceinline__ float fast_sigmoid(float x) { return __builtin_amdgcn_rcpf(1.0f + __expf(-x)); }
__device__ __forceinline__ float gelu_tanh(float x) { const float u = 0.7978845608028654f * (x + 0.044715f * x * x * x); return x * fast_sigmoid(2.0f * u); }
__device__ __forceinline__ float bf_lo(unsigned w) { return __uint_as_float(w << 16); }
__device__ __forceinline__ float bf_hi(unsigned w) { return __uint_as_float(w & 0xffff0000u); }

struct EpiSwiglu {
    static constexpr bool PERM = true, AFTER_DRAIN = false;
    bf16_t* O; int ldo;
    __device__ __forceinline__ void operator()(const f32x4 (&acc)[2][2][4][2], const Unit& u, int wr, int wc, int fr, int fq) const {
        const int row0 = u.pm * BM + wr * 64 + fr, col0 = u.pn * HALF + wc * 32 + 8 * fq;
#pragma unroll
        for (int ai = 0; ai < 2; ++ai)
#pragma unroll
            for (int m = 0; m < 4; ++m) { bf16_t* rowp = O + (size_t)(row0 + ai * HALF + m * 16) * ldo + col0;
                float v[8];
#pragma unroll
                for (int n = 0; n < 2; ++n)
#pragma unroll
                    for (int j = 0; j < 4; ++j) { const float a = acc[ai][0][m][n][j], b = acc[ai][1][m][n][j]; v[n * 4 + j] = a * fast_sigmoid(a) * b; }
                u32x4 w; w.x = cvt_pk_bf16(v[0], v[1]); w.y = cvt_pk_bf16(v[2], v[3]); w.z = cvt_pk_bf16(v[4], v[5]); w.w = cvt_pk_bf16(v[6], v[7]);
                *(u32x4*)rowp = w; }
    }
};
struct EpiResid {
    static constexpr bool PERM = true, AFTER_DRAIN = false;
    bf16_t* Dd; int ldd; const float* gate_lat; const float* gate_ctx; float coef;
    __device__ __forceinline__ void operator()(const f32x4 (&acc)[2][2][4][2], const Unit& u, int wr, int wc, int fr, int fq) const {
        const int row0 = u.pm * BM + wr * 64 + fr, col0 = u.pn * BM + wc * 32 + 8 * fq;
        const float* gate = (u.pm == 0) ? gate_ctx : gate_lat;
        f32x4 gv[2][2];
#pragma unroll
        for (int bj = 0; bj < 2; ++bj)
#pragma unroll
            for (int n = 0; n < 2; ++n) gv[bj][n] = *(const f32x4*)(gate + col0 + bj * HALF + 4 * n) * coef;
#pragma unroll
        for (int ai = 0; ai < 2; ++ai)
#pragma unroll
            for (int m = 0; m < 4; ++m) { bf16_t* rowp = Dd + (size_t)(row0 + ai * HALF + m * 16) * ldd + col0;
#pragma unroll
                for (int bj = 0; bj < 2; ++bj) { const f32x4 v0 = gv[bj][0] * acc[ai][bj][m][0], v1 = gv[bj][1] * acc[ai][bj][m][1];
                    u32x4 w; w.x = cvt_pk_bf16(v0[0], v0[1]); w.y = cvt_pk_bf16(v0[2], v0[3]); w.z = cvt_pk_bf16(v1[0], v1[1]); w.w = cvt_pk_bf16(v1[2], v1[3]);
                    *(u32x4*)(rowp + bj * HALF) = w; } }
    }
};
struct EpiWin {
    static constexpr bool PERM = true, AFTER_DRAIN = false;
    bf16_t* O; int ldo; int pn0;
    __device__ __forceinline__ void operator()(const f32x4 (&acc)[2][2][4][2], const Unit& u, int wr, int wc, int fr, int fq) const {
        const int pn = u.pn + pn0, row0 = u.pm * BM + wr * 64 + fr, col0 = pn * BM + wc * 32 + 8 * fq;
        const bool sig = pn >= 40, gel = (pn >= 10 && pn < 16);
        const float kx = sig ? 1.0f : (gel ? 2.0f * 0.7978845608028654f : 0.0f), k3 = gel ? 2.0f * 0.7978845608028654f * 0.044715f : 0.0f, k0 = (sig || gel) ? 0.0f : 80.0f;
#pragma unroll
        for (int ai = 0; ai < 2; ++ai)
#pragma unroll
            for (int m = 0; m < 4; ++m) { bf16_t* rowp = O + (size_t)(row0 + ai * HALF + m * 16) * ldo + col0;
#pragma unroll
                for (int bj = 0; bj < 2; ++bj) { float v[8];
#pragma unroll
                    for (int n = 0; n < 2; ++n)
#pragma unroll
                        for (int j = 0; j < 4; ++j) { const float x = acc[ai][bj][m][n][j]; const float t = k0 + x * (kx + k3 * x * x);
                            const float r = __builtin_amdgcn_rcpf(1.0f + __expf(-t)); v[n * 4 + j] = sig ? r : x * r; }
                    u32x4 w; w.x = cvt_pk_bf16(v[0], v[1]); w.y = cvt_pk_bf16(v[2], v[3]); w.z = cvt_pk_bf16(v[4], v[5]); w.w = cvt_pk_bf16(v[6], v[7]);
                    *(u32x4*)(rowp + bj * HALF) = w; } }
    }
};
struct LruOrder {
    int G, c;
    __host__ __device__ void init(int G_, int c_) { G = G_; c = c_; }
    __host__ __device__ bool next(int i, Unit& u) const { const int L = i * G + c; if (L >= 6 * 33 * 4) return false; const int pmv = L >> 2; u.pm = pmv; u.pn = (pmv / 33) * 4 + (L & 3); return true; }
    __device__ __forceinline__ void a_ready(const Unit&) const {}
    __device__ __forceinline__ void done(const Unit&) const {}
};
struct EpiLru {
    static constexpr bool PERM = true, AFTER_DRAIN = false;
    float* LA; float* LB; const bf16_t* XA; const float* b_a; const float* b_x; const float* lam;
    int M; float* CA; float* CB;
    __device__ __forceinline__ void operator()(const f32x4 (&acc)[2][2][4][2], const Unit& u, int wr, int wc, int fr, int fq) const {
        const int jb = u.pm / 33, pmr = u.pm - jb * 33, pnn = u.pn & 3, d = pnn >> 1, blk = 2 * jb + (pnn & 1);
        const int row0 = pmr * BM + wr * 64 + fr, c0 = blk * HALF + wc * 32 + 8 * fq;
        const float* pba = b_a + d * 1536 + c0; const float* pbx = b_x + d * 1536 + c0; const float* psp = lam + d * 1536 + c0;
#pragma unroll
        for (int ai = 0; ai < 2; ++ai) { float RA[8], RB[8];
#pragma unroll
            for (int m = 0; m < 4; ++m) { const size_t row = (size_t)(row0 + ai * HALF + m * 16);
                const bf16_t* xp = XA + ((size_t)jb * M + row) * 256 + (c0 - 256 * jb);
                unsigned* pab = (unsigned*)LA + ((((size_t)d * (M >> 6) + (row >> 6)) * 6 + (c0 >> 8)) * 64 + (row & 63)) * 256 + (c0 & 255);
#pragma unroll
                for (int n = 0; n < 2; ++n) { const f32x4 ba = *(const f32x4*)(pba + 4 * n), bx = *(const f32x4*)(pbx + 4 * n), sp = *(const f32x4*)(psp + 4 * n);
                    const unsigned long long xw = *(const unsigned long long*)(xp + 4 * n); const unsigned x01 = (unsigned)xw, x23 = (unsigned)(xw >> 32);
                    const float xa[4] = {bf_lo(x01), bf_hi(x01), bf_lo(x23), bf_hi(x23)};
                    u32x4 ab;
#pragma unroll
                    for (int j = 0; j < 4; ++j) {
                        const float r = fast_sigmoid(acc[ai][0][m][n][j] + ba[j]), ig = fast_sigmoid(acc[ai][1][m][n][j] + bx[j]);
                        const float la = -sp[j] * r, x2 = 2.0f * la;
                        const float em = (x2 > -0.5f) ? -x2 * (1.0f + x2 * (0.5f + x2 * (0.16666667f + x2 * (0.041666668f + x2 * (0.0083333338f + x2 * 0.0013888889f))))) : 1.0f - __expf(x2);
                        ab[j] = cvt_pk_bf16(la, sqrtf(fmaxf(em, 0.0f)) * (ig * xa[j])); }
                    *(u32x4*)(pab + 4 * n) = ab;
#pragma unroll
                    for (int j = 0; j < 4; ++j) { float a = __expf(bf_lo(ab[j])), b = bf_hi(ab[j]);
#define LRU_STEP(S_) { const float pa = swz_xor<S_>(a), pb = swz_xor<S_>(b); const bool mine_first = (((fr & S_) == 0) != (d == 1)); b = mine_first ? (pa * b + pb) : (a * pb + b); a = a * pa; }
                        LRU_STEP(1) LRU_STEP(2) LRU_STEP(4) LRU_STEP(8)
#undef LRU_STEP
                        const int e = n * 4 + j;
                        if (m == 0) { RA[e] = a; RB[e] = b; } else { const float f0 = a * RB[e] + b, f1 = RA[e] * b + RB[e]; RB[e] = (d == 0) ? f0 : f1; RA[e] = RA[e] * a; } }
                    asm volatile("" ::: "memory"); }
                asm volatile("" ::: "memory"); }
            { const size_t ci = ((size_t)d * (M >> 6) + ((row0 + ai * HALF) >> 6)) * 1536 + c0;
                *(f32x4*)(CA + ci) = (f32x4){RA[0], RA[1], RA[2], RA[3]}; *(f32x4*)(CA + ci + 4) = (f32x4){RA[4], RA[5], RA[6], RA[7]};
                *(f32x4*)(CB + ci) = (f32x4){RB[0], RB[1], RB[2], RB[3]}; *(f32x4*)(CB + ci + 4) = (f32x4){RB[4], RB[5], RB[6], RB[7]}; } }
    }
};
template <int STEP> struct EpiMerge {
    static constexpr bool PERM = true, AFTER_DRAIN = false;
    float* M32; bf16_t* Mb; const bf16_t* G; int ldg;
    __device__ __forceinline__ void operator()(const f32x4 (&acc)[2][2][4][2], const Unit& u, int wr, int wc, int fr, int fq) const {
        const int row0 = u.pm * BM + wr * 64 + fr, col0 = u.pn * BM + wc * 32 + 8 * fq;
#pragma unroll
        for (int ai = 0; ai < 2; ++ai) { u32x4 gw[4][2], ow[4][2];
#pragma unroll
            for (int m = 0; m < 4; ++m) { const size_t row = (size_t)(row0 + ai * HALF + m * 16);
#pragma unroll
                for (int bj = 0; bj < 2; ++bj) { const int col = col0 + bj * HALF; gw[m][bj] = *(const u32x4*)(G + row * ldg + col); if (STEP >= 1) ow[m][bj] = *(const u32x4*)(Mb + row * 4096 + col); } }
#pragma unroll
            for (int m = 0; m < 4; ++m) { const size_t row = (size_t)(row0 + ai * HALF + m * 16);
#pragma unroll
                for (int bj = 0; bj < 2; ++bj) { const int col = col0 + bj * HALF; const u32x4 g4 = gw[m][bj];
                    const float g[8] = {bf_lo(g4.x), bf_hi(g4.x), bf_lo(g4.y), bf_hi(g4.y), bf_lo(g4.z), bf_hi(g4.z), bf_lo(g4.w), bf_hi(g4.w)};
                    float v[8];
#pragma unroll
                    for (int n = 0; n < 2; ++n)
#pragma unroll
                        for (int j = 0; j < 4; ++j) v[n * 4 + j] = g[n * 4 + j] * acc[ai][bj][m][n][j];
                    if (STEP >= 1) { const u32x4 o = ow[m][bj];
                        v[0] += bf_lo(o.x); v[1] += bf_hi(o.x); v[2] += bf_lo(o.y); v[3] += bf_hi(o.y); v[4] += bf_lo(o.z); v[5] += bf_hi(o.z); v[6] += bf_lo(o.w); v[7] += bf_hi(o.w); }
                    u32x4 w; w.x = cvt_pk_bf16(v[0], v[1]); w.y = cvt_pk_bf16(v[2], v[3]); w.z = cvt_pk_bf16(v[4], v[5]); w.w = cvt_pk_bf16(v[6], v[7]);
                    *(u32x4*)(Mb + row * 4096 + col) = w; } }
            asm volatile("" ::: "memory"); }
    }
};
template <class Epi, class Sched, bool ALIGN_EPI = false, bool SP2 = false>
__device__ __forceinline__ void gemm_phase(PG8_LAS unsigned char* lds, const Gemm g, const Sched& S, const Epi& E, int tid_in) {
    int tid_ = tid_in; asm volatile("" : "+v"(tid_));
    const int tid = tid_, wid = __builtin_amdgcn_readfirstlane(tid >> 6), lane = tid & 63, wr = wid >> 2, wc = wid & 3, fr = lane & 15, fq = lane >> 4;
    const int K = g.K, nt = K / BK;
    unsigned voffA[2], voffB[2];
#pragma unroll
    for (int i = 0; i < 2; ++i) { int R, C; stage_rc(tid * 16 + i * 8192, R, C); const int Rb = Epi::PERM ? ((R & ~31) + perm32(R & 31)) : R;
        voffA[i] = (unsigned)(R * K + C) * 2u; voffB[i] = (unsigned)(Rb * K + C) * 2u; }
    const size_t kstep = (size_t)(BK * 2);
    const size_t hstep = (size_t)HALF * K * 2;
    const size_t tstep = 2 * hstep;
    const unsigned ldsw = (unsigned)wid * 1024u;
    const int aoff = lds_byte(wr * 64 + fr, fq * 8), boff = lds_byte(wc * 32 + fr, fq * 8);
#define PG8_SA(b, h) (((b) * 2 + (h)) * HTB)
#define PG8_SB(b, h) ((4 + (b) * 2 + (h)) * HTB)
#define PG8_STAGE(bufoff, gbase, voff) do { _Pragma("unroll") for (int _i = 0; _i < 2; ++_i) \
        __builtin_amdgcn_global_load_lds((const unsigned*)((const char*)(gbase) + (voff)[_i]), (PG8_LAS unsigned*)(lds + (bufoff) + ldsw + _i * 8192), 16, 0, 0); } while (0)
#define PG8_LDA(dst, b, h) do { _Pragma("unroll") for (int m = 0; m < 4; ++m) _Pragma("unroll") for (int k = 0; k < 2; ++k) dst[m][k] = *(const PG8_LAS bf16x8*)(lds + PG8_SA(b, h) + aoff + m * 2048 + k * 1024); } while (0)
#define PG8_LDB(dst, b, h) do { _Pragma("unroll") for (int n = 0; n < 2; ++n) _Pragma("unroll") for (int k = 0; k < 2; ++k) dst[n][k] = *(const PG8_LAS bf16x8*)(lds + PG8_SB(b, h) + boff + n * 2048 + k * 1024); } while (0)
#define PG8_MMA(ai, bj, At, Bt) do { __builtin_amdgcn_s_setprio(1); _Pragma("unroll") for (int m = 0; m < 4; ++m) _Pragma("unroll") for (int n = 0; n < 2; ++n) _Pragma("unroll") for (int k = 0; k < 2; ++k) \
        acc[ai][bj][m][n] = __builtin_amdgcn_mfma_f32_16x16x32_bf16(Bt[n][k], At[m][k], acc[ai][bj][m][n], 0, 0, 0); __builtin_amdgcn_s_setprio(0); } while (0)
#define PG8_WAIT_V(n) asm volatile("s_waitcnt vmcnt(" #n ")" ::: "memory")
#define PG8_WAIT_L(n) asm volatile("s_waitcnt lgkmcnt(" #n ")" ::: "memory")
#define PG8_BAR __builtin_amdgcn_s_barrier()
#define PG8_SCHED __builtin_amdgcn_sched_barrier(0)
    Unit cur, nxt; int ui = 0;
    if (!S.next(0, cur)) return;
    f32x4 acc[2][2][4][2];
#pragma unroll
    for (int a = 0; a < 2; ++a)
#pragma unroll
        for (int b = 0; b < 2; ++b)
#pragma unroll
            for (int m = 0; m < 4; ++m)
#pragma unroll
                for (int n = 0; n < 2; ++n) acc[a][b][m][n] = (f32x4){0.f, 0.f, 0.f, 0.f};
    bf16x8 At[4][2], B0[2][2], B1[2][2];
    const char* cA = (const char*)g.A + (size_t)cur.pm * tstep; const char* cB = (const char*)g.Bt + (size_t)cur.pn * tstep;
    S.a_ready(cur);
    if constexpr (SP2) {
        PG8_STAGE(PG8_SB(0, 0), cB, voffB); PG8_STAGE(PG8_SB(0, 1), cB + hstep, voffB); PG8_STAGE(PG8_SA(0, 0), cA, voffA); PG8_STAGE(PG8_SA(0, 1), cA + hstep, voffA);
        if (wr == 1) PG8_BAR;
        PG8_WAIT_V(2); PG8_BAR;
        PG8_STAGE(PG8_SB(1, 0), cB + kstep, voffB); PG8_STAGE(PG8_SA(1, 0), cA + kstep, voffA); PG8_STAGE(PG8_SB(1, 1), cB + hstep + kstep, voffB);
        PG8_WAIT_V(6); PG8_BAR;
    } else {
        PG8_STAGE(PG8_SB(0, 0), cB, voffB); PG8_STAGE(PG8_SA(0, 0), cA, voffA); PG8_STAGE(PG8_SB(0, 1), cB + hstep, voffB); PG8_STAGE(PG8_SA(0, 1), cA + hstep, voffA);
        if (wr == 1) PG8_BAR;
        PG8_WAIT_V(4); PG8_BAR;
        PG8_STAGE(PG8_SB(1, 0), cB + kstep, voffB); PG8_STAGE(PG8_SA(1, 0), cA + kstep, voffA); PG8_STAGE(PG8_SB(1, 1), cB + hstep + kstep, voffB);
        PG8_WAIT_V(6); PG8_BAR;
    }
    for (;;) {
        const bool has_next = S.next(ui + 1, nxt);
        const char* nA = has_next ? (const char*)g.A + (size_t)nxt.pm * tstep : cA; const char* nB = has_next ? (const char*)g.Bt + (size_t)nxt.pn * tstep : cB;
        for (int t = 0; t < nt; t += 2) {
            const bool last = (t == nt - 2);
            const char* a1 = cA + (size_t)(t + 1) * kstep;
            const char* a2 = last ? nA : cA + (size_t)(t + 2) * kstep; const char* b2 = last ? nB : cB + (size_t)(t + 2) * kstep;
            const char* a3 = a2 + kstep; const char* b3 = b2 + kstep;
            if (last && has_next) S.a_ready(nxt);
            if constexpr (SP2) {
            PG8_LDB(B0, 0, 0); PG8_LDB(B1, 0, 1); PG8_SCHED; PG8_LDA(At, 0, 0); PG8_STAGE(PG8_SA(1, 1), a1 + hstep, voffA);
            PG8_WAIT_V(8); PG8_WAIT_L(0); PG8_BAR; PG8_MMA(0, 0, At, B0); PG8_MMA(0, 1, At, B1); PG8_BAR; PG8_SCHED;
            PG8_LDA(At, 0, 1); PG8_STAGE(PG8_SB(0, 0), b2, voffB); PG8_STAGE(PG8_SB(0, 1), b2 + hstep, voffB); PG8_STAGE(PG8_SA(0, 0), a2, voffA);
            PG8_WAIT_V(8); PG8_WAIT_L(0); PG8_BAR; PG8_MMA(1, 0, At, B0); PG8_MMA(1, 1, At, B1); PG8_BAR; PG8_SCHED;
            PG8_LDB(B0, 1, 0); PG8_LDB(B1, 1, 1); PG8_SCHED; PG8_LDA(At, 1, 0); PG8_STAGE(PG8_SA(0, 1), a2 + hstep, voffA);
            PG8_WAIT_V(8); PG8_WAIT_L(0); PG8_BAR; PG8_MMA(0, 0, At, B0); PG8_MMA(0, 1, At, B1); PG8_BAR; PG8_SCHED;
            PG8_LDA(At, 1, 1); PG8_STAGE(PG8_SB(1, 0), b3, voffB); PG8_STAGE(PG8_SB(1, 1), b3 + hstep, voffB); PG8_STAGE(PG8_SA(1, 0), a3, voffA);
            PG8_WAIT_V(8); PG8_WAIT_L(0); PG8_BAR; PG8_MMA(1, 0, At, B0); PG8_MMA(1, 1, At, B1); PG8_BAR; PG8_SCHED;
            } else {
            PG8_LDB(B0, 0, 0); PG8_SCHED; PG8_LDA(At, 0, 0); PG8_STAGE(PG8_SA(1, 1), a1 + hstep, voffA);
            PG8_WAIT_L(8); PG8_BAR; PG8_WAIT_L(0); PG8_MMA(0, 0, At, B0); PG8_BAR; PG8_SCHED;
            PG8_LDB(B1, 0, 1); PG8_STAGE(PG8_SB(0, 0), b2, voffB);
            PG8_BAR; PG8_WAIT_L(0); PG8_MMA(0, 1, At, B1); PG8_BAR;
            PG8_LDA(At, 0, 1); PG8_STAGE(PG8_SA(0, 0), a2, voffA);
            PG8_BAR; PG8_WAIT_L(0); PG8_MMA(1, 0, At, B0); PG8_BAR; PG8_SCHED;
            PG8_STAGE(PG8_SB(0, 1), b2 + hstep, voffB);
            PG8_WAIT_V(6); PG8_BAR; PG8_MMA(1, 1, At, B1); PG8_BAR;
            PG8_LDB(B0, 1, 0); PG8_SCHED; PG8_LDA(At, 1, 0); PG8_STAGE(PG8_SA(0, 1), a2 + hstep, voffA);
            PG8_WAIT_L(8); PG8_BAR; PG8_WAIT_L(0); PG8_MMA(0, 0, At, B0); PG8_BAR; PG8_SCHED;
            PG8_LDB(B1, 1, 1); PG8_STAGE(PG8_SB(1, 0), b3, voffB);
            PG8_BAR; PG8_WAIT_L(0); PG8_MMA(0, 1, At, B1); PG8_BAR;
            PG8_LDA(At, 1, 1); PG8_STAGE(PG8_SA(1, 0), a3, voffA);
            PG8_BAR; PG8_WAIT_L(0); PG8_MMA(1, 0, At, B0); PG8_BAR; PG8_SCHED;
            PG8_STAGE(PG8_SB(1, 1), b3 + hstep, voffB);
            PG8_WAIT_V(6); PG8_BAR; PG8_MMA(1, 1, At, B1); PG8_BAR;
            }
        }
        if constexpr (ALIGN_EPI) { if (wr == 0) PG8_BAR; }
        if constexpr (!Epi::AFTER_DRAIN) { E(acc, cur, wr, wc, fr, fq); S.done(cur); }
        if (!has_next) break;
#pragma unroll
        for (int a = 0; a < 2; ++a)
#pragma unroll
            for (int b = 0; b < 2; ++b)
#pragma unroll
                for (int m = 0; m < 4; ++m)
#pragma unroll
                    for (int n = 0; n < 2; ++n) acc[a][b][m][n] = (f32x4){0.f, 0.f, 0.f, 0.f};
        cur = nxt; cA = nA; cB = nB; ++ui;
        if constexpr (ALIGN_EPI) { if (wr == 1) PG8_BAR; }
    }
    PG8_WAIT_V(0);
    if constexpr (!ALIGN_EPI) { if (wr == 0) PG8_BAR; }
    PG8_BAR;
    if constexpr (Epi::AFTER_DRAIN) { E.fused(acc, cur, wr, wc, fr, fq, lds, wid, lane); S.done(cur); }
#undef PG8_SA
#undef PG8_SB
#undef PG8_STAGE
#undef PG8_LDA
#undef PG8_LDB
#undef PG8_MMA
#undef PG8_WAIT_V
#undef PG8_WAIT_L
#undef PG8_BAR
#undef PG8_SCHED
}
}
namespace att {
using bf16 = __hip_bfloat16;
constexpr int   D = 128, NW = 8, QBLK = 32, KVBLK = 64;
constexpr float SCALE = 0.088388347648318440f;
constexpr float THR = 8.f;
constexpr int SDEPTH = 2;
constexpr int LDQ = 1536, LDK = 512, LDO = 1536;
constexpr size_t SHM_V = KVBLK * D * 2, SHM_K = KVBLK * D * 2, SHM_ATTN = 2 * SHM_V + 2 * SHM_K + NW * 64 * 4;
__device__ __forceinline__ unsigned short f2bf_att(float f) { unsigned u = __builtin_bit_cast(unsigned, f); return (unsigned short)((u + 0x7fffu + ((u >> 16) & 1u)) >> 16); }
using bf16x8 = __attribute__((ext_vector_type(8))) short;
using s16x4  = __attribute__((ext_vector_type(4))) short;
using f32x16 = __attribute__((ext_vector_type(16))) float;
using f32x8  = __attribute__((ext_vector_type(8))) float;
using u32x4  = __attribute__((ext_vector_type(4))) unsigned;
#define KSWZ(row, colB) ((row) * 256 + ((colB) ^ (((row) & 7) << 4)))
#define SBAR() __builtin_amdgcn_sched_barrier(0)
__device__ __forceinline__ int crow(int r, int hi) { return (r & 3) + 8 * (r >> 2) + 4 * hi; }
__device__ __forceinline__ unsigned cvtpk(float lo, float hi) {
  unsigned r; asm volatile("v_cvt_pk_bf16_f32 %0, %1, %2" : "=v"(r) : "v"(lo), "v"(hi)); return r;
}
template <typename TIn> struct Stage;
template <> struct Stage<bf16>  { using T = bf16x8;
  __device__ static __forceinline__ T ld8(const bf16* p) { return *reinterpret_cast<const bf16x8*>(p); }
  __device__ static __forceinline__ bf16x8 tobf(T x) { return x; } };
template <> struct Stage<float> { using T = f32x8;
  __device__ static __forceinline__ T ld8(const float* p) { return *reinterpret_cast<const f32x8*>(p); }
  __device__ static __forceinline__ bf16x8 tobf(T x) {
    u32x4 w = {cvtpk(x[0], x[1]), cvtpk(x[2], x[3]), cvtpk(x[4], x[5]), cvtpk(x[6], x[7])}; return *reinterpret_cast<bf16x8*>(&w); } };

__device__ __forceinline__ void partialSM(f32x16& p0, f32x16& p1, float& m_reg, float& mn, float& alpha) {
  constexpr float C = SCALE * 1.4426950408889634f;
  float pmax = p0[0]; for (int r = 1; r < 16; ++r) pmax = fmaxf(pmax, p0[r]); for (int r = 0; r < 16; ++r) pmax = fmaxf(pmax, p1[r]);
  { auto rr = __builtin_amdgcn_permlane32_swap(__float_as_uint(pmax), __float_as_uint(pmax), false, false);
    pmax = fmaxf(__uint_as_float(rr[0]), __uint_as_float(rr[1])); }
  if (__builtin_expect(__all(pmax - m_reg <= THR / SCALE), 1)) { mn = m_reg; alpha = 1.f; }
  else { mn = fmaxf(m_reg, pmax); alpha = __builtin_amdgcn_exp2f((m_reg - mn) * C); m_reg = mn; }
  float mnC = -mn * C;
  for (int r = 0; r < 16; ++r) p0[r] = fmaf(p0[r], C, mnC); for (int r = 0; r < 16; ++r) p1[r] = fmaf(p1[r], C, mnC);
  for (int r = 0; r < 16; ++r) p0[r] = __builtin_amdgcn_exp2f(p0[r]);
}
__device__ __forceinline__ void finishSM(f32x16& p0, f32x16& p1, float alpha, float& l_reg, bf16x8& pa0, bf16x8& pa1, bf16x8& pa2, bf16x8& pa3) {
  for (int r = 0; r < 16; ++r) p1[r] = __builtin_amdgcn_exp2f(p1[r]);
  float ps = 0; for (int r = 0; r < 16; ++r) ps += p0[r]; for (int r = 0; r < 16; ++r) ps += p1[r];
  { auto rr = __builtin_amdgcn_permlane32_swap(__float_as_uint(ps), __float_as_uint(ps), false, false);
    ps = __uint_as_float(rr[0]) + __uint_as_float(rr[1]); }
  l_reg = l_reg * alpha + ps;
#define PK4(P, BASE, OUT) do { unsigned a0 = cvtpk(P[BASE + 0], P[BASE + 1]), a1 = cvtpk(P[BASE + 2], P[BASE + 3]);   \
    unsigned b0 = cvtpk(P[BASE + 4], P[BASE + 5]), b1 = cvtpk(P[BASE + 6], P[BASE + 7]);                              \
    auto r0 = __builtin_amdgcn_permlane32_swap(a0, b0, false, false); auto r1 = __builtin_amdgcn_permlane32_swap(a1, b1, false, false); \
    u32x4 w = {r0[0], r1[0], r0[1], r1[1]}; OUT = *reinterpret_cast<bf16x8*>(&w); } while (0)
  PK4(p0, 0, pa0); PK4(p0, 8, pa1); PK4(p1, 0, pa2); PK4(p1, 8, pa3);
#undef PK4
}
__device__ __forceinline__ void qkt(f32x16& p0, f32x16& p1, const bf16* Ks, const bf16x8* qr, int r32, int hi) {
  p0 = f32x16{}; p1 = f32x16{};
  for (int d0 = 0; d0 < 8; ++d0) { int cb = (d0 * 16 + hi * 8) * 2;
    bf16x8 b0 = *reinterpret_cast<const bf16x8*>((const char*)Ks + KSWZ(r32, cb));
    bf16x8 b1 = *reinterpret_cast<const bf16x8*>((const char*)Ks + KSWZ(32 + r32, cb));
    p0 = __builtin_amdgcn_mfma_f32_32x32x16_bf16(b0, qr[d0], p0, 0, 0, 0);
    p1 = __builtin_amdgcn_mfma_f32_32x32x16_bf16(b1, qr[d0], p1, 0, 0, 0); }
}
__device__ __forceinline__ int v_st(int k, int c) { const int kk = (k & ~0xC) | ((k & 4) << 1) | ((k & 8) >> 1); return ((kk >> 3) * 4 + (c >> 5)) * 512 + ((kk & 7) * 32 + (c & 31)) * 2; }
__device__ __forceinline__ int v_rd_base(int lane) { return ((lane & 3) << 3) | (((lane >> 2) & 3) << 6) | (((lane >> 4) & 1) << 5) | (((lane >> 5) & 1) << 8); }
constexpr int v_rd_off(int d0, int ks, int half) { return d0 * 512 + ks * 4096 + half * 2048; }
template <int OFF> __device__ __forceinline__ s16x4 tr_read(int vb) {
  s16x4 r; asm volatile("ds_read_b64_tr_b16 %0, %1 offset:%2" : "=&v"(r) : "v"(vb), "i"(OFF) : "memory"); return r;
}
template <int D0> __device__ __forceinline__ void pv_one(f32x16& od, int vb, bf16x8 pa0, bf16x8 pa1, bf16x8 pa2, bf16x8 pa3) {
  const s16x4 l0 = tr_read<v_rd_off(D0, 0, 0)>(vb), h0 = tr_read<v_rd_off(D0, 0, 1)>(vb), l1 = tr_read<v_rd_off(D0, 1, 0)>(vb), h1 = tr_read<v_rd_off(D0, 1, 1)>(vb);
  const s16x4 l2 = tr_read<v_rd_off(D0, 2, 0)>(vb), h2 = tr_read<v_rd_off(D0, 2, 1)>(vb), l3 = tr_read<v_rd_off(D0, 3, 0)>(vb), h3 = tr_read<v_rd_off(D0, 3, 1)>(vb);
  asm volatile("s_waitcnt lgkmcnt(0)" ::: "memory"); SBAR();
#define PK(L, H) (bf16x8){L[0], L[1], L[2], L[3], H[0], H[1], H[2], H[3]}
  od = __builtin_amdgcn_mfma_f32_32x32x16_bf16(pa0, PK(l0, h0), od, 0, 0, 0);
  od = __builtin_amdgcn_mfma_f32_32x32x16_bf16(pa1, PK(l1, h1), od, 0, 0, 0);
  od = __builtin_amdgcn_mfma_f32_32x32x16_bf16(pa2, PK(l2, h2), od, 0, 0, 0);
  od = __builtin_amdgcn_mfma_f32_32x32x16_bf16(pa3, PK(l3, h3), od, 0, 0, 0);
#undef PK
}
__device__ __forceinline__ void pv_d0(f32x16* o, int vb, bf16x8 pa0, bf16x8 pa1, bf16x8 pa2, bf16x8 pa3) {
  pv_one<0>(o[0], vb, pa0, pa1, pa2, pa3); pv_one<1>(o[1], vb, pa0, pa1, pa2, pa3); pv_one<2>(o[2], vb, pa0, pa1, pa2, pa3); pv_one<3>(o[3], vb, pa0, pa1, pa2, pa3);
}

template <typename TQ>
__device__ __forceinline__ void attn_dense_body(const TQ* __restrict__ Qb, const bf16* __restrict__ Kh, const bf16* __restrict__ Vh,
                                                unsigned short* __restrict__ Ob, int seq, char* lds, int tid_in) {
  using St = Stage<bf16>; using SQ = Stage<TQ>;
  int tid_ = tid_in; asm volatile("" : "+v"(tid_));
  const int tid = tid_, wid = tid >> 6, lane = tid & 63, r32 = lane & 31, hi = lane >> 5;
  bf16* V_lds = (bf16*)lds; bf16* K_lds = (bf16*)(lds + 2 * SHM_V);
  float* ws = (float*)(lds + 2 * SHM_V + 2 * SHM_K) + wid * 64; float* li_l = ws; float* al_l = ws + 32;
  float m_reg = -1e30f, l_reg = 0; f32x16 o[4] = {}; bf16x8 qr[8];
  const TQ* Qw = Qb + (long)(wid * QBLK + r32) * LDQ + hi * 8;
#pragma unroll
  for (int d0 = 0; d0 < 8; ++d0) qr[d0] = SQ::tobf(SQ::ld8(Qw + d0 * 16));
  const int sr = tid >> 4, sc = (tid & 15) * 8, vst0 = v_st(sr, sc), vst1 = v_st(32 + sr, sc);
  const int vb0 = (int)(uintptr_t)V_lds + v_rd_base(lane);
  struct { typename St::T vs0, vs1, ks0, ks1; } sr_[SDEPTH];
  const unsigned lo0 = (unsigned)(sr * LDK + sc) * 2u, lo1 = lo0 + 32u * LDK * 2u;
#define SLOAD(i, k0) do { const char* vt_ = (const char*)Vh + (size_t)(k0) * (LDK * 2); const char* kt_ = (const char*)Kh + (size_t)(k0) * (LDK * 2); \
    sr_[i].vs0 = *(const bf16x8*)(vt_ + lo0); sr_[i].vs1 = *(const bf16x8*)(vt_ + lo1); \
    sr_[i].ks0 = *(const bf16x8*)(kt_ + lo0); sr_[i].ks1 = *(const bf16x8*)(kt_ + lo1); } while (0)
#define SWRITE(b, i) do { *(bf16x8*)((char*)V_lds + (b) * SHM_V + vst0) = St::tobf(sr_[i].vs0);          \
    *(bf16x8*)((char*)V_lds + (b) * SHM_V + vst1) = St::tobf(sr_[i].vs1); int kc = sc * 2;               \
    *(bf16x8*)((char*)K_lds + (b) * SHM_K + KSWZ(sr, kc)) = St::tobf(sr_[i].ks0);                       \
    *(bf16x8*)((char*)K_lds + (b) * SHM_K + KSWZ(32 + sr, kc)) = St::tobf(sr_[i].ks1); } while (0)
#define SWAIT() do { if constexpr (SDEPTH == 2) asm volatile("s_waitcnt vmcnt(4)" ::: "memory"); else asm volatile("s_waitcnt vmcnt(0)" ::: "memory"); } while (0)
#define RESC(a) do { if (__any((a) < 1.f)) { if (hi == 0) al_l[r32] = (a); asm volatile("s_waitcnt lgkmcnt(0)" ::: "memory"); \
    for (int d = 0; d < 4; ++d) for (int r = 0; r < 16; ++r) o[d][r] *= al_l[crow(r, hi)]; } } while (0)
  f32x16 pA0, pA1, pB0, pB1; float mnA, mnB, alA, alB; bf16x8 pa0, pa1, pa2, pa3; const int NT = seq / KVBLK;
  constexpr int SE = 0, SO = SDEPTH - 1;
  SLOAD(SE, 0); asm volatile("s_waitcnt vmcnt(0)" ::: "memory"); SWRITE(0, SE); __syncthreads();
  qkt(pA0, pA1, K_lds, qr, r32, hi); partialSM(pA0, pA1, m_reg, mnA, alA);
  SLOAD(SO, KVBLK); if constexpr (SDEPTH == 2) { if (2 < NT) SLOAD(SE, 2 * KVBLK); }
  SWAIT(); SWRITE(1, SO); __syncthreads();
  for (int j = 1; j + 1 < NT; j += 2) {
    SBAR(); qkt(pB0, pB1, (bf16*)((char*)K_lds + SHM_K), qr, r32, hi);
    finishSM(pA0, pA1, alA, l_reg, pa0, pa1, pa2, pa3); SBAR();
    SLOAD(SO, (j + SDEPTH) * KVBLK); SBAR();
    pv_d0(o, vb0, pa0, pa1, pa2, pa3); partialSM(pB0, pB1, m_reg, mnB, alB);
    __syncthreads(); SWAIT(); SWRITE(0, SE);
    RESC(alB); __syncthreads();
    SBAR(); qkt(pA0, pA1, K_lds, qr, r32, hi);
    finishSM(pB0, pB1, alB, l_reg, pa0, pa1, pa2, pa3); SBAR();
    if (SDEPTH == 1 || j + 3 < NT) SLOAD(SE, (j + 1 + SDEPTH) * KVBLK); SBAR();
    pv_d0(o, vb0 + (int)SHM_V, pa0, pa1, pa2, pa3); partialSM(pA0, pA1, m_reg, mnA, alA);
    __syncthreads(); SWAIT(); SWRITE(1, SO);
    RESC(alA); __syncthreads();
  }
  SBAR(); qkt(pB0, pB1, (bf16*)((char*)K_lds + SHM_K), qr, r32, hi);
  finishSM(pA0, pA1, alA, l_reg, pa0, pa1, pa2, pa3); SBAR();
  pv_d0(o, vb0, pa0, pa1, pa2, pa3); partialSM(pB0, pB1, m_reg, mnB, alB);
  __syncthreads(); RESC(alB);
  finishSM(pB0, pB1, alB, l_reg, pa0, pa1, pa2, pa3); SBAR();
  pv_d0(o, vb0 + (int)SHM_V, pa0, pa1, pa2, pa3);
  if (hi == 0) li_l[r32] = l_reg; asm volatile("s_waitcnt lgkmcnt(0)" ::: "memory");
  float rli[16];
#pragma unroll
  for (int r = 0; r < 16; ++r) rli[r] = __builtin_amdgcn_rcpf(li_l[crow(r, hi)]);
  unsigned short* Ow = Ob + (long)(wid * QBLK) * LDO;
#pragma unroll
  for (int r = 0; r < 16; ++r) { int orow = crow(r, hi);
    for (int d0 = 0; d0 < 4; ++d0) Ow[(long)orow * LDO + d0 * 32 + r32] = f2bf_att(o[d0][r] * rli[r]); }
#undef SLOAD
#undef SWRITE
#undef SWAIT
#undef RESC
}

#undef KSWZ
#undef SBAR
}
constexpr int NWAVES = 8;
constexpr int DM = 4096, SEQ = 8192, CTXL = 256, MROWS = SEQ + CTXL, DEPTH = 4;
constexpr int WMIX = 1536, KVW = 512, NIN = 22528, DFF = 4096, MODR = 256, NMOD = 9;
constexpr int COL_AX = 0, COL_CK = 1536, COL_CV = 2048, COL_AG = 2560, COL_B = 4096, COL_CQ = 8704, COL_G = 10240;
constexpr int NCHUNK = MROWS / 64;
constexpr int FFTN = 16384;
constexpr float EPSN = 1e-6f;
constexpr int N_IN_TENSORS = 36;
enum { I_X = 0, I_C, I_CTX, I_CCTX, I_WMD, I_WMU, I_BMOD, I_NF1, I_NMIX, I_NF2, I_F1IN, I_F1OUT, I_F2IN, I_F2OUT, I_WIN, I_LCONV, I_LWA, I_LBA, I_LWX, I_LBX, I_LLAM,
       I_HCONV, I_HFW1, I_HFB1, I_HFREQ, I_HFW2, I_HFB2, I_HFW3, I_HSKIP, I_QN, I_KN, I_WBA, I_WBB, I_WBC, I_WOUT, I_FNORM };

constexpr size_t MiB = 1u << 20;
constexpr size_t WS_CTL = 0, CTL_ZERO_BYTES = 1 * MiB;
constexpr size_t WS_MOD = 2 * MiB;
constexpr size_t WS_W = 4 * MiB;
constexpr size_t WO_GU1 = 0, WO_D1 = 64 * MiB, WO_GU2 = 96 * MiB, WO_D2 = 160 * MiB, WO_IN = 192 * MiB, WO_BR = 368 * MiB, WO_OUT = 404 * MiB, WO_LRU = 436 * MiB, W_LAYER = 454 * MiB;
constexpr size_t WS_X = WS_W + DEPTH * W_LAYER;
constexpr size_t WS_U = WS_X + 132 * MiB;
constexpr size_t WS_H = WS_U + 66 * MiB;
constexpr size_t WS_P = WS_H + 66 * MiB;
constexpr size_t WS_XA = WS_P + 363 * MiB;
constexpr size_t WS_LA = WS_XA + 25 * MiB;
constexpr size_t WS_LB = WS_LA + 99 * MiB;
constexpr size_t WS_CA = WS_LB + 99 * MiB;
constexpr size_t WS_CB = WS_CA + 2 * MiB;
constexpr size_t WS_CIN = WS_CB + 2 * MiB;
constexpr size_t WS_QN = WS_CIN + 2 * MiB;
constexpr size_t WS_KN = WS_QN + 25 * MiB;
constexpr size_t WS_VN = WS_KN + 9 * MiB;
constexpr size_t WS_YA = WS_VN + 9 * MiB;
constexpr size_t WS_YB = WS_YA + 25 * MiB;
constexpr size_t WS_YC = WS_YB + 25 * MiB;
constexpr size_t WS_M32 = WS_YC + 25 * MiB;
constexpr size_t WS_VT = WS_M32 + 132 * MiB;
constexpr size_t WS_YBT = WS_VT + 144 * MiB;
constexpr size_t WS_KT = WS_YBT + 48 * MiB;
constexpr size_t WS_PM = WS_KT + 192 * MiB;
constexpr size_t WS_H2 = WS_PM + 384 * MiB;
constexpr size_t WS_H2C = WS_H2 + 2 * MiB;
constexpr size_t WS_KC = WS_H2C + 1 * MiB;
constexpr size_t WS_KCN = WS_KC + 6 * MiB;
constexpr size_t WS_UC = WS_KCN + 1 * MiB;
constexpr size_t WS_END = WS_UC + 5 * MiB;
constexpr int CW_TMO = 0, CW_CODE = 1;
constexpr int CW_BAR = 4096;
constexpr int CW_T1 = 16384;

constexpr int RING_OFF = 0, RING_BYTES = 131072;
constexpr int FFT_BYTES = (FFTN + FFTN / 32) * 8;
constexpr int RED_OFF = FFT_BYTES;
constexpr int WSCR_BYTES = 66 * 65 * 4;
constexpr int LDSCTL_OFF = 143360, MISC_OFF = LDSCTL_OFF + 320;
constexpr int LDS_BYTES = 147456;
static_assert(RED_OFF + 1024 <= LDSCTL_OFF && NWAVES * WSCR_BYTES <= LDSCTL_OFF && MISC_OFF + 128 <= LDS_BYTES, "LDS map");

#define GAS __attribute__((address_space(1)))
#define LAS __attribute__((address_space(3)))
typedef unsigned short bf16;
typedef unsigned v4u __attribute__((ext_vector_type(4)));
typedef unsigned v2u __attribute__((ext_vector_type(2)));
typedef float f32x4 __attribute__((ext_vector_type(4)));
typedef float f32x2 __attribute__((ext_vector_type(2)));
typedef GAS unsigned gu32;
#define RLX_AGENT __ATOMIC_RELAXED, __HIP_MEMORY_SCOPE_AGENT
#define LDS_WAIT() asm volatile("s_waitcnt lgkmcnt(0)" ::: "memory")
#define VM_WAIT() asm volatile("s_waitcnt vmcnt(0)" ::: "memory")
__device__ __forceinline__ unsigned f2bf(float f) { unsigned u = __builtin_bit_cast(unsigned, f); return (u + 0x7fffu + ((u >> 16) & 1u)) >> 16; }
__device__ __forceinline__ unsigned pk2(float lo, float hi) { return f2bf(lo) | (f2bf(hi) << 16); }
__device__ __forceinline__ float bflo(unsigned w) { return __uint_as_float(w << 16); }
__device__ __forceinline__ float bfhi(unsigned w) { return __uint_as_float(w & 0xffff0000u); }
__device__ __forceinline__ float bf1(bf16 h) { return __uint_as_float(((unsigned)h) << 16); }
template <int MASK> __device__ __forceinline__ float swz_xor(float v) { return __int_as_float(__builtin_amdgcn_ds_swizzle(__float_as_int(v), (MASK << 10) | 0x1f)); }
__device__ __forceinline__ float lane_bcast(float v, int l) { return __int_as_float(__builtin_amdgcn_readlane(__float_as_int(v), l)); }
__device__ __forceinline__ float wave_sum(float v) {
    v += swz_xor<1>(v); v += swz_xor<2>(v); v += swz_xor<4>(v); v += swz_xor<8>(v); v += swz_xor<16>(v);
    const auto rr = __builtin_amdgcn_permlane32_swap(__float_as_uint(v), __float_as_uint(v), false, false);
    return __uint_as_float(rr[0]) + __uint_as_float(rr[1]);
}
__device__ __forceinline__ float sigmoidf_(float x) { return 1.0f / (1.0f + __expf(-x)); }
#define XB_TMO      128
#define XB_XCNT(j)  (256  + 64 * (j))
#define XB_XSUB(j)  (1280 + 64 * (j))
#define XB_XGEN(j)  (2304 + 64 * (j))
#define XB_TOP      3328
#define XB_TOPGEN   3392
#define XCD_BAR_WORDS 3456
#define XB_SPIN_CAP (1u << 18)

__device__ __forceinline__ unsigned xb_ld(unsigned* p)              { return __hip_atomic_load(p, __ATOMIC_RELAXED, __HIP_MEMORY_SCOPE_AGENT); }
__device__ __forceinline__ unsigned xb_add(unsigned* p, unsigned v) { return __hip_atomic_fetch_add(p, v, __ATOMIC_RELAXED, __HIP_MEMORY_SCOPE_AGENT); }
__device__ __forceinline__ unsigned xb_xcc_id() { return (unsigned)__builtin_amdgcn_s_getreg((3 << 11) | 20) & 0xFu; }
#define XB_SPIN(cond, bar) do { unsigned _sp = 0; while (cond) { __builtin_amdgcn_s_sleep(1); \
    if ((++_sp & 255u) == 0u) { if (xb_ld(&(bar)[XB_TMO])) break; if (_sp > XB_SPIN_CAP) { atomicAdd(&(bar)[XB_TMO], 1u); break; } } } } while (0)

struct XcdBarrier {
    unsigned* bar; unsigned x;
    volatile LAS unsigned* st;
};

__device__ __forceinline__ XcdBarrier xcd_barrier_post(unsigned* bar, volatile LAS unsigned* st) {
    XcdBarrier b; b.bar = bar; b.x = xb_xcc_id(); b.st = st;
    if (threadIdx.x == 0) (void)xb_add(&bar[XB_XCNT(b.x)], 1u);
    return b;
}
__device__ __forceinline__ void xcd_barrier_complete(unsigned* bar, unsigned x, unsigned& nloc, unsigned& nx) {
    const unsigned G = gridDim.x * gridDim.y * gridDim.z;
    unsigned sum, cnt, mine, sp = 0u;
    for (;;) {
        sum = 0u; cnt = 0u; mine = 0u;
#pragma unroll
        for (unsigned j = 0; j < 16; ++j) { const unsigned c = xb_ld(&bar[XB_XCNT(j)]); sum += c; cnt += (c > 0u) ? 1u : 0u; mine = (j == x) ? c : mine; }
        if (sum == G) break;
        __builtin_amdgcn_s_sleep(1);
        if ((++sp & 255u) == 0u) { if (xb_ld(&bar[XB_TMO])) break; if (sp > XB_SPIN_CAP) { atomicAdd(&bar[XB_TMO], 1u); break; } }
    }
    nloc = mine > 0u ? mine : 1u; nx = cnt > 0u ? cnt : 1u;
}

__device__ __forceinline__ void xcd_barrier(const XcdBarrier& b) {
    asm volatile("s_waitcnt vmcnt(0)" ::: "memory");
    __syncthreads();
    if (threadIdx.x == 0) {
        unsigned* bar = b.bar;
        __builtin_amdgcn_s_waitcnt(0);
        unsigned nloc = b.st[0], nx = b.st[1];
        if (nloc == 0u) { xcd_barrier_complete(bar, b.x, nloc, nx); b.st[0] = nloc; b.st[1] = nx; }
        const unsigned old = xb_add(&bar[XB_XSUB(b.x)], 1u);
        const unsigned gen = old / nloc;
        if (old + 1u == (gen + 1u) * nloc) {
            __builtin_amdgcn_fence(__ATOMIC_RELEASE, "agent");
            asm volatile("s_waitcnt vmcnt(0)" ::: "memory");
            const unsigned og = xb_add(&bar[XB_TOP], 1u);
            const unsigned tg = og / nx;
            if (og + 1u == (tg + 1u) * nx) xb_add(&bar[XB_TOPGEN], 1u);
            else XB_SPIN(xb_ld(&bar[XB_TOPGEN]) == tg, bar);
            __builtin_amdgcn_fence(__ATOMIC_ACQUIRE, "agent");
            xb_add(&bar[XB_XGEN(b.x)], 1u);
            asm volatile("s_waitcnt vmcnt(0)" ::: "memory");
        } else {
            XB_SPIN(xb_ld(&bar[XB_XGEN(b.x)]) == gen, bar);
            __builtin_amdgcn_fence(__ATOMIC_ACQUIRE, "agent");
            asm volatile("s_waitcnt vmcnt(0)" ::: "memory");
        }
    }
    __syncthreads();
}
struct Args { const float* in[N_IN_TENSORS]; float* out; unsigned char* ws; int ph_lo, ph_hi; };
static_assert(sizeof(Args) == N_IN_TENSORS * 8 + 8 + 8 + 8, "Args has no padding");
__device__ __forceinline__ const float* inp(const Args& A, int i) { asm volatile("" : "+s"(i)); return (const float*)(const GAS float*)A.in[i]; }
struct Frame {
    LAS unsigned char* lds;
    unsigned char* ws;
    float* out;
    int tid, lane, wave, G, gw, ngw, bid;
};
__device__ __forceinline__ Frame fresh(const Frame& F) { Frame L = F; unsigned z = 0u; asm volatile("" : "+v"(z)); int wv = F.wave; asm volatile("" : "+s"(wv)); int b = F.bid; asm volatile("" : "+s"(b));
    unsigned long long w = (unsigned long long)F.ws; asm volatile("" : "+s"(w)); L.ws = (unsigned char*)(GAS unsigned char*)w;
    L.lane = (int)__builtin_amdgcn_mbcnt_hi(~0u, __builtin_amdgcn_mbcnt_lo(~0u, z));
    L.wave = wv; L.tid = wv * 64 + L.lane; L.bid = b; L.gw = b * NWAVES + wv; return L; }
#define WSP(T, off) ((T*)(F.ws + (off)))

__device__ __forceinline__ void transpose_item(const float* W, int K, int N, bf16* WT, int k0, int n0, int drow0, LAS float* scr, int lane) {
    const float* src = W + (size_t)k0 * N + n0 + lane;
#pragma unroll 16
    for (int kk = 0; kk < 64; ++kk) scr[kk * 65 + lane] = src[(size_t)kk * N];
    LDS_WAIT(); asm volatile("" ::: "memory");
    const int c = lane & 7;
#pragma unroll
    for (int j = 0; j < 8; ++j) { const int n = (lane >> 3) + 8 * j; const LAS float* s = scr + (8 * c) * 65 + n;
        v4u o; o.x = pk2(s[0 * 65], s[1 * 65]); o.y = pk2(s[2 * 65], s[3 * 65]); o.z = pk2(s[4 * 65], s[5 * 65]); o.w = pk2(s[6 * 65], s[7 * 65]);
        *(GAS v4u*)(WT + (size_t)(drow0 + n) * K + k0 + 8 * c) = o; }
    LDS_WAIT(); asm volatile("" ::: "memory");
}
template <int SWI> __device__ __forceinline__ void transpose_matrix(const Frame& F_, const Args& A, const float* W, int K, int N, bf16* WT, LAS float* scr) {
    const Frame F = fresh(F_);
    const int nblk = N / 64, nitems = (K / 64) * nblk;
    for (int it = F.gw; it < nitems; it += F.ngw) { const int kb = it / nblk, nb = it - kb * nblk, n0 = 64 * nb; int drow0 = n0;
        if (SWI) { const int h = n0 / 4096, c = n0 - h * 4096; drow0 = 256 * (c / 128) + 128 * h + (c & 127); }
        transpose_item(W, K, N, WT, 64 * kb, n0, drow0, scr, F.lane); }
}
__device__ __forceinline__ void prologue_a(const Frame& F_, const Args& A) {
    const Frame F = fresh(F_);
    LAS float* scr = (LAS float*)(F.lds + F.wave * 16640);
    { float* T1 = WSP(float, WS_CTL) + CW_T1; const float* cl = inp(A, I_C); const float* cc = inp(A, I_CCTX);
      for (int u = F.gw; u < DEPTH * 64; u += F.ngw) { const int layer = u >> 6, jg = u & 63;
          f32x4 al = {0.f, 0.f, 0.f, 0.f}, ac = {0.f, 0.f, 0.f, 0.f};
#pragma unroll 8
          for (int i = 0; i < 64; ++i) { const int d = F.lane + 64 * i; const float xl = cl[d], xc = cc[d]; const float sl = xl * sigmoidf_(xl), sc = xc * sigmoidf_(xc);
              const f32x4 w = *(const f32x4*)(inp(A, I_WMD) + ((size_t)layer * DM + d) * MODR + 4 * jg); al += w * sl; ac += w * sc; }
#pragma unroll
          for (int e = 0; e < 4; ++e) { const float tl = wave_sum(al[e]), tc = wave_sum(ac[e]);
              if (F.lane == 0) { T1[(layer * 2 + 0) * MODR + 4 * jg + e] = tl; T1[(layer * 2 + 1) * MODR + 4 * jg + e] = tc; } } } }
    { float* SPT = WSP(float, WS_MOD + 1536 * 1024); const float* lam = inp(A, I_LLAM);
      for (int i = F.bid * 512 + F.tid; i < DEPTH * 2 * WMIX; i += F.G * 512) SPT[i] = 8.0f * log1pf(__expf(-lam[i])); }
    { v2u* X = WSP(v2u, WS_X); const f32x4* xc = (const f32x4*)inp(A, I_CTX); const f32x4* xl = (const f32x4*)inp(A, I_X); const size_t nc = (size_t)CTXL * DM / 4, nt = (size_t)MROWS * DM / 4;
      for (size_t i = (size_t)F.bid * 512 + F.tid; i < nt; i += (size_t)F.G * 512) { const f32x4 v = (i < nc) ? xc[i] : xl[i - nc]; X[i] = (v2u){pk2(v.x, v.y), pk2(v.z, v.w)}; } }
    for (int layer = 0; layer < DEPTH; ++layer) { unsigned char* wb = F.ws + WS_W + (size_t)layer * W_LAYER;
        transpose_matrix<1>(F, A, inp(A, I_F1IN) + (size_t)layer * DM * 2 * DFF, DM, 2 * DFF, (bf16*)(wb + WO_GU1), scr);
        transpose_matrix<0>(F, A, inp(A, I_F1OUT) + (size_t)layer * DFF * DM, DFF, DM, (bf16*)(wb + WO_D1), scr);
        transpose_matrix<1>(F, A, inp(A, I_F2IN) + (size_t)layer * DM * 2 * DFF, DM, 2 * DFF, (bf16*)(wb + WO_GU2), scr);
        transpose_matrix<0>(F, A, inp(A, I_F2OUT) + (size_t)layer * DFF * DM, DFF, DM, (bf16*)(wb + WO_D2), scr);
        transpose_matrix<0>(F, A, inp(A, I_WIN) + (size_t)layer * DM * NIN, DM, NIN, (bf16*)(wb + WO_IN), scr);
        transpose_matrix<0>(F, A, inp(A, I_WBA) + (size_t)layer * WMIX * DM, WMIX, DM, (bf16*)(wb + WO_BR), scr);
        transpose_matrix<0>(F, A, inp(A, I_WBB) + (size_t)layer * WMIX * DM, WMIX, DM, (bf16*)(wb + WO_BR) + (size_t)DM * WMIX, scr);
        transpose_matrix<0>(F, A, inp(A, I_WBC) + (size_t)layer * WMIX * DM, WMIX, DM, (bf16*)(wb + WO_BR) + (size_t)2 * DM * WMIX, scr);
        transpose_matrix<0>(F, A, inp(A, I_WOUT) + (size_t)layer * DM * DM, DM, DM, (bf16*)(wb + WO_OUT), scr);
        { bf16* WL = (bf16*)(wb + WO_LRU); const float* wa = inp(A, I_LWA) + (size_t)layer * 2 * 12 * 128 * 128; const float* wx = inp(A, I_LWX) + (size_t)layer * 2 * 12 * 128 * 128;
          for (int row = F.gw; row < 6144; row += F.ngw) { const int jb = row >> 10, pnn = (row >> 8) & 3, h = (row >> 7) & 1, e = row & 127, dir = pnn >> 1, blk = 2 * jb + (pnn & 1);
              const float* src = (h ? wx : wa) + ((size_t)(dir * 12 + blk) * 128) * 128 + e;
              if (F.lane < 32) { const int k0 = F.lane * 8; v4u o = {0u, 0u, 0u, 0u};
                  if ((k0 >> 7) == (pnn & 1)) { const int dd = k0 & 127; float v[8];
#pragma unroll
                      for (int j = 0; j < 8; ++j) v[j] = src[(size_t)(dd + j) * 128];
                      o.x = pk2(v[0], v[1]); o.y = pk2(v[2], v[3]); o.z = pk2(v[4], v[5]); o.w = pk2(v[6], v[7]); }
                  *(GAS v4u*)(WL + (size_t)row * 256 + k0) = o; } } }
    }
}
__device__ __forceinline__ void prologue_b(const Frame& F_, const Args& A) {
    const Frame F = fresh(F_);
    const float* T1 = WSP(float, WS_CTL) + CW_T1; float* MOD = WSP(float, WS_MOD); constexpr int NM = NMOD * DM;
    for (int u = F.gw; u < DEPTH * 2 * (NM / 256); u += F.ngw) { const int lw = u / (NM / 256), nc = u - lw * (NM / 256), layer = lw >> 1, n0 = nc * 256 + 4 * F.lane;
        f32x4 acc = *(const f32x4*)(inp(A, I_BMOD) + (size_t)layer * NM + n0); const float* t1 = T1 + lw * MODR; const float* wu = inp(A, I_WMU) + (size_t)layer * MODR * NM + n0;
#pragma unroll 8
        for (int j = 0; j < MODR; ++j) acc += *(const f32x4*)(wu + (size_t)j * NM) * t1[j];
        *(f32x4*)(MOD + (size_t)lw * NM + n0) = acc; }
}
__device__ __forceinline__ void norm_phase(const Frame& F_, const Args& A, const float* g, const float* modL, const float* modC, int ishift, int iscale, int dfrom) {
    const Frame F = fresh(F_);
    bf16* X = WSP(bf16, WS_X); bf16* U = WSP(bf16, WS_U); const bf16* Dd = WSP(bf16, WS_M32); LAS f32x4* L4 = (LAS f32x4*)F.lds;
    __syncthreads();
    for (int i = F.tid; i < DM / 4; i += NWAVES * 64) { L4[i] = *(const f32x4*)(g + 4 * i);
        L4[1024 + i] = *(const f32x4*)(modL + ishift * DM + 4 * i); L4[2048 + i] = *(const f32x4*)(modL + iscale * DM + 4 * i) + 1.0f;
        L4[3072 + i] = *(const f32x4*)(modC + ishift * DM + 4 * i); L4[4096 + i] = *(const f32x4*)(modC + iscale * DM + 4 * i) + 1.0f; }
    __syncthreads();
    for (int r = F.gw; r < MROWS; r += F.ngw) { const int mo = (r < CTXL) ? 3072 : 1024; v4u* xr = (v4u*)(X + (size_t)r * DM) + F.lane;
        f32x4 v[8][2]; float s = 0.f;
#pragma unroll
        for (int i = 0; i < 8; ++i) { const v4u x = xr[64 * i]; v[i][0] = (f32x4){bflo(x.x), bfhi(x.x), bflo(x.y), bfhi(x.y)}; v[i][1] = (f32x4){bflo(x.z), bfhi(x.z), bflo(x.w), bfhi(x.w)}; }
        if (r >= dfrom) { const v4u* dr = (const v4u*)(Dd + (size_t)r * DM) + F.lane;
#pragma unroll
            for (int i = 0; i < 8; ++i) { const v4u d = dr[64 * i]; v[i][0] += (f32x4){bflo(d.x), bfhi(d.x), bflo(d.y), bfhi(d.y)}; v[i][1] += (f32x4){bflo(d.z), bfhi(d.z), bflo(d.w), bfhi(d.w)};
                xr[64 * i] = (v4u){pk2(v[i][0].x, v[i][0].y), pk2(v[i][0].z, v[i][0].w), pk2(v[i][1].x, v[i][1].y), pk2(v[i][1].z, v[i][1].w)}; } }
#pragma unroll
        for (int i = 0; i < 8; ++i)
#pragma unroll
            for (int h = 0; h < 2; ++h) s += (v[i][h].x * v[i][h].x + v[i][h].y * v[i][h].y) + (v[i][h].z * v[i][h].z + v[i][h].w * v[i][h].w);
        const float rms = rsqrtf(wave_sum(s) * (1.0f / DM) + EPSN);
        v4u* o16 = (v4u*)(U + (size_t)r * DM) + F.lane;
#pragma unroll
        for (int i = 0; i < 8; ++i) { f32x4 y[2];
#pragma unroll
            for (int h = 0; h < 2; ++h) { const int c4 = 2 * F.lane + 128 * i + h; const f32x4 gg = L4[c4], sh = L4[mo + c4], sc1 = L4[mo + 1024 + c4]; y[h] = (v[i][h] * rms * gg) * sc1 + sh; }
            o16[64 * i] = (v4u){pk2(y[0].x, y[0].y), pk2(y[0].z, y[0].w), pk2(y[1].x, y[1].y), pk2(y[1].z, y[1].w)}; } }
    __syncthreads();
}
__device__ __forceinline__ void final_norm_phase(const Frame& F_, const Args& A) {
    const Frame F = fresh(F_);
    const bf16* X = WSP(bf16, WS_X); const bf16* Dd = WSP(bf16, WS_M32); const float* g = inp(A, I_FNORM);
    for (int r = F.gw; r < SEQ; r += F.ngw) { const v2u* xr = (const v2u*)(X + (size_t)(r + CTXL) * DM) + F.lane; const v2u* dr = (const v2u*)(Dd + (size_t)(r + CTXL) * DM) + F.lane; f32x4 v[16]; float s = 0.f;
#pragma unroll
        for (int i = 0; i < 16; ++i) { const v2u x = xr[64 * i], d = dr[64 * i]; v[i] = (f32x4){bflo(x.x) + bflo(d.x), bfhi(x.x) + bfhi(d.x), bflo(x.y) + bflo(d.y), bfhi(x.y) + bfhi(d.y)}; s += (v[i].x * v[i].x + v[i].y * v[i].y) + (v[i].z * v[i].z + v[i].w * v[i].w); }
        const float rms = rsqrtf(wave_sum(s) * (1.0f / DM) + EPSN); f32x4* o = (f32x4*)(F.out + (size_t)r * DM) + F.lane;
#pragma unroll
        for (int i = 0; i < 16; ++i) o[64 * i] = v[i] * rms * *(const f32x4*)(g + 4 * F.lane + 256 * i); }
}

#ifdef DUMP
__device__ __forceinline__ void dump_phase(const Frame& F_, const Args& A) {
    const Frame F = fresh(F_);
    const bf16* YC = WSP(bf16, WS_YC); const bf16* YA = WSP(bf16, WS_YA); const bf16* YB = WSP(bf16, WS_YB);
#if DUMP >= 8
    { const bf16* P = WSP(bf16, WS_P); const size_t nctx = (size_t)CTXL * NIN;
      for (size_t i = (size_t)F.bid * 512 + F.tid; i < (size_t)SEQ * DM; i += (size_t)F.G * 512) { float v = 0.f;
          if (i < nctx) { if (DUMP & 8) v = bf1(P[i]); } else { const size_t k = i - nctx; const size_t r = k / DM, c = k % DM; if (DUMP & 16) v = bf1(P[(size_t)(r + CTXL) * NIN + c]); }
          F.out[i] = v; } return; }
#endif
    for (size_t i = (size_t)F.bid * 512 + F.tid; i < (size_t)SEQ * DM; i += (size_t)F.G * 512) { const int r = (int)(i / DM), c = (int)(i % DM); float v = 0.f;
        if (c < 1536) { if (DUMP & 1) v = bf1(YC[(size_t)(r + CTXL) * WMIX + c]); }
        else if (c < 3072) { if (DUMP & 2) v = bf1(YA[(size_t)(r + CTXL) * WMIX + c - 1536]); }
        else { if (DUMP & 4) v = bf1(YB[(size_t)(r + CTXL) * WMIX + c - 3072]); }
        F.out[i] = v; }
}
#endif
__device__ __forceinline__ bool same_seq(int r, int r2) { return r2 >= 0 && r2 < MROWS && ((r < CTXL) == (r2 < CTXL)); }
__device__ __forceinline__ void prep_lru_conv(const Frame& F_, const Args& A, int layer) {
    const Frame F = fresh(F_);
    const bf16* P = WSP(bf16, WS_P); bf16* XA = WSP(bf16, WS_XA); const float* w = inp(A, I_LCONV) + (size_t)layer * 4 * WMIX;
    const int nitems = (MROWS / 16) * (WMIX / 8);
    for (int it = F.bid * 512 + F.tid; it < nitems; it += F.G * 512) { const int run = it / (WMIX / 8), c0 = (it - run * (WMIX / 8)) * 8, r0 = run * 16;
        float wk[4][8];
#pragma unroll
        for (int k = 0; k < 4; ++k) { const f32x4 w0 = *(const f32x4*)(w + k * WMIX + c0), w1 = *(const f32x4*)(w + k * WMIX + c0 + 4);
            wk[k][0] = w0.x; wk[k][1] = w0.y; wk[k][2] = w0.z; wk[k][3] = w0.w; wk[k][4] = w1.x; wk[k][5] = w1.y; wk[k][6] = w1.z; wk[k][7] = w1.w; }
        v4u rows[19];
#pragma unroll
        for (int q = 0; q < 19; ++q) { const int r2 = r0 - 1 + q; rows[q] = same_seq(r0, r2) ? *(const v4u*)(P + (size_t)r2 * NIN + COL_AX + c0) : (v4u){0u, 0u, 0u, 0u}; }
#pragma unroll
        for (int t = 0; t < 16; ++t) { float acc[8] = {0.f, 0.f, 0.f, 0.f, 0.f, 0.f, 0.f, 0.f};
#pragma unroll
            for (int k = 0; k < 4; ++k) { const v4u pw = rows[t + k];
                acc[0] += wk[k][0] * bflo(pw.x); acc[1] += wk[k][1] * bfhi(pw.x); acc[2] += wk[k][2] * bflo(pw.y); acc[3] += wk[k][3] * bfhi(pw.y);
                acc[4] += wk[k][4] * bflo(pw.z); acc[5] += wk[k][5] * bfhi(pw.z); acc[6] += wk[k][6] * bflo(pw.w); acc[7] += wk[k][7] * bfhi(pw.w); }
            v4u o; o.x = pk2(acc[0], acc[1]); o.y = pk2(acc[2], acc[3]); o.z = pk2(acc[4], acc[5]); o.w = pk2(acc[6], acc[7]);
            *(v4u*)(XA + ((size_t)(c0 >> 8) * MROWS + r0 + t) * 256 + (c0 & 255)) = o; } }
}
__device__ __forceinline__ void prep_qkv(const Frame& F_, const Args& A, int layer) {
    const Frame F = fresh(F_);
    const bf16* P = WSP(bf16, WS_P); bf16* QN = WSP(bf16, WS_QN); bf16* KN = WSP(bf16, WS_KN); bf16* VN = WSP(bf16, WS_VN);
    const float* qg = inp(A, I_QN) + layer * 128; const float* kg = inp(A, I_KN) + layer * 128;
    const int d0 = (F.lane & 15) * 8, hl = F.lane >> 4;
    float gq[8], gk[8];
#pragma unroll
    for (int j = 0; j < 8; ++j) { gq[j] = qg[d0 + j]; gk[j] = kg[d0 + j]; }
    for (int r = F.gw; r < MROWS; r += F.ngw) { const bf16* pr = P + (size_t)r * NIN;
        float cs[4], sn[4]; const bool lat = r >= CTXL;
        if (lat) { const int s = r - CTXL, prow = s >> 6, pcol = s & 63;
#pragma unroll
            for (int j = 0; j < 4; ++j) { const int p = (d0 >> 1) + j;
                const float inv = exp2f(-(float)(p & 31) * (13.287712379549449f / 32.0f));
                const float ang = (float)((p < 32) ? prow : pcol) * inv; sincosf(ang, &sn[j], &cs[j]); } }
#pragma unroll
        for (int i = 0; i < 4; ++i) { const bool isq = i < 3; const int head = isq ? (hl + 4 * i) : hl;
            const bf16* src = pr + (isq ? (COL_CQ + head * 128) : (COL_CK + head * 128)) + d0;
            const v4u w = *(const v4u*)src; float v[8] = {bflo(w.x), bfhi(w.x), bflo(w.y), bfhi(w.y), bflo(w.z), bfhi(w.z), bflo(w.w), bfhi(w.w)};
            float ss = 0.f;
#pragma unroll
            for (int j = 0; j < 8; ++j) ss += v[j] * v[j];
            ss += swz_xor<1>(ss); ss += swz_xor<2>(ss); ss += swz_xor<4>(ss); ss += swz_xor<8>(ss);
            const float rms = rsqrtf(ss * (1.0f / 128.0f) + EPSN);
#pragma unroll
            for (int j = 0; j < 8; ++j) v[j] = v[j] * rms * (isq ? gq[j] : gk[j]);
            if (lat) {
#pragma unroll
                for (int j = 0; j < 4; ++j) { const float t0 = v[2 * j], t1 = v[2 * j + 1]; v[2 * j] = t0 * cs[j] - t1 * sn[j]; v[2 * j + 1] = t0 * sn[j] + t1 * cs[j]; } }
            v4u o; o.x = pk2(v[0], v[1]); o.y = pk2(v[2], v[3]); o.z = pk2(v[4], v[5]); o.w = pk2(v[6], v[7]);
            if (isq) *(v4u*)(QN + (size_t)r * WMIX + head * 128 + d0) = o; else *(v4u*)(KN + (size_t)r * KVW + head * 128 + d0) = o; }
        *(v4u*)(VN + (size_t)r * KVW + F.lane * 8) = *(const v4u*)(pr + COL_CV + F.lane * 8); }
}
__device__ __forceinline__ void prep_hyena_t(const Frame& F_, const Args& A, int layer) {
    const Frame F = fresh(F_);
    const bf16* P = WSP(bf16, WS_P); float* VT = WSP(float, WS_VT); const float* w = inp(A, I_HCONV) + (size_t)layer * 3 * (3 * WMIX);
    LAS float* scr = (LAS float*)(F.lds + F.wave * WSCR_BYTES);
    constexpr int NCB = 3 * WMIX / 64;
    for (int u = F.gw; u < (SEQ / 64) * NCB; u += F.ngw) { const int tb = u / NCB, cb = u - tb * NCB, t0 = tb * 64, c0 = cb * 64;
#pragma unroll
        for (int ps = 0; ps < 9; ++ps) { const int rr = ps * 8 + (F.lane >> 3), cc = (F.lane & 7) * 8; if (rr < 66) { const int t = t0 - 1 + rr; v4u pw = {0u, 0u, 0u, 0u};
                if (t >= 0 && t < SEQ) pw = *(const v4u*)(P + (size_t)(t + CTXL) * NIN + COL_B + c0 + cc);
                LAS float* d = scr + rr * 65 + cc; d[0] = bflo(pw.x); d[1] = bfhi(pw.x); d[2] = bflo(pw.y); d[3] = bfhi(pw.y); d[4] = bflo(pw.z); d[5] = bfhi(pw.z); d[6] = bflo(pw.w); d[7] = bfhi(pw.w); } }
        LDS_WAIT(); asm volatile("" ::: "memory");
        { const int part = c0 / WMIX, pr0 = (c0 - part * WMIX) >> 1;
          const int tl = 4 * (F.lane & 15), pl = F.lane >> 4;
#pragma unroll 2
          for (int pg = 0; pg < 8; ++pg) { const int pi = 4 * pg + pl, c = 2 * pi, ch = c0 + c; v4u o;
              const float w00 = w[ch], w01 = w[3 * WMIX + ch], w02 = w[2 * 3 * WMIX + ch], w10 = w[ch + 1], w11 = w[3 * WMIX + ch + 1], w12 = w[2 * 3 * WMIX + ch + 1];
              float xe[6], xo[6];
#pragma unroll
              for (int q = 0; q < 6; ++q) { xe[q] = scr[(tl + q) * 65 + c]; xo[q] = scr[(tl + q) * 65 + c + 1]; }
              o.x = pk2(w00 * xe[0] + w01 * xe[1] + w02 * xe[2], w10 * xo[0] + w11 * xo[1] + w12 * xo[2]);
              o.y = pk2(w00 * xe[1] + w01 * xe[2] + w02 * xe[3], w10 * xo[1] + w11 * xo[2] + w12 * xo[3]);
              o.z = pk2(w00 * xe[2] + w01 * xe[3] + w02 * xe[4], w10 * xo[2] + w11 * xo[3] + w12 * xo[4]);
              o.w = pk2(w00 * xe[3] + w01 * xe[4] + w02 * xe[5], w10 * xo[3] + w11 * xo[4] + w12 * xo[5]);
              *(v4u*)((unsigned*)VT + ((size_t)part * (WMIX / 2) + pr0 + pi) * SEQ + t0 + tl) = o; } }
        LDS_WAIT(); asm volatile("" ::: "memory"); }
}
__device__ __forceinline__ void prep_hyena_ctx(const Frame& F_, const Args& A, int layer) {
    const Frame F = fresh(F_);
    const bf16* P = WSP(bf16, WS_P); float* UC = WSP(float, WS_UC); const float* w = inp(A, I_HCONV) + (size_t)layer * 3 * (3 * WMIX);
    for (int it = F.bid * 512 + F.tid; it < CTXL * 3 * WMIX; it += F.G * 512) { const int t = it / (3 * WMIX), ch = it - t * (3 * WMIX);
        float v = w[3 * WMIX + ch] * bf1(P[(size_t)t * NIN + COL_B + ch]);
        if (t > 0) v += w[ch] * bf1(P[(size_t)(t - 1) * NIN + COL_B + ch]);
        if (t < CTXL - 1) v += w[2 * 3 * WMIX + ch] * bf1(P[(size_t)(t + 1) * NIN + COL_B + ch]);
        const int part = ch / WMIX, c = ch - part * WMIX; UC[((size_t)part * CTXL + t) * WMIX + c] = v; }
}
__device__ __forceinline__ void filt_mlp(const Frame& F_, const Args& A, int layer, bool with_ctx, int first_wg = 0) {
    const Frame F = fresh(F_); if (F.bid < first_wg) return;
    float* H2 = WSP(float, WS_H2); float* H2C = WSP(float, WS_H2C);
    const float* fw1 = inp(A, I_HFW1) + (size_t)layer * 33 * 64; const float* fb1 = inp(A, I_HFB1) + layer * 64; const float* fr = inp(A, I_HFREQ) + layer * 64;
    const float* fw2 = inp(A, I_HFW2) + (size_t)layer * 64 * 64; const float* fb2 = inp(A, I_HFB2) + layer * 64;
    const int j = F.lane; const float frj = fr[j], b1 = fb1[j], b2 = fb2[j];
    const int total = SEQ + (with_ctx ? CTXL : 0);
    for (int u = F.gw - first_wg * NWAVES; u < total; u += F.ngw - first_wg * NWAVES) { const bool isc = u >= SEQ; const int t = isc ? u - SEQ : u, L = isc ? CTXL : SEQ;
        const float tl = (float)t / (float)(L - 1);
        const int b = j & 15; const float band = 1e-4f + (float)b * ((15.0f - 1e-4f) / 15.0f);
        const float ang = (6.283185307179586f / (float)L) * (float)t * band; float sn, cs; sincosf(ang, &sn, &cs); const float zc = cs, zs = -sn;
        float pre = b1 + tl * fw1[j];
#pragma unroll
        for (int i = 0; i < 16; ++i) { pre += lane_bcast(zc, i) * fw1[(1 + i) * 64 + j]; pre += lane_bcast(zs, i) * fw1[(17 + i) * 64 + j]; }
        const float h1 = sinf(frj * pre);
        float pre2 = b2;
#pragma unroll 16
        for (int i = 0; i < 64; ++i) pre2 += lane_bcast(h1, i) * fw2[i * 64 + j];
        const float h2 = sinf(frj * pre2);
        (isc ? H2C : H2)[(size_t)t * 64 + j] = h2; }
}
__device__ __forceinline__ float hy_delta(int c) {
    const float d0 = -4.605170185988091f / 1.5f, d1 = -4.605170185988091f / 0.3f; return d0 + (float)c * ((d1 - d0) / 1535.0f);
}
__device__ __forceinline__ void filt_taps_unit(const Frame& F_, const Args& A, int layer, int u) {
    const Frame F = fresh(F_);
    const float* H2 = WSP(float, WS_H2); float* KT = WSP(float, WS_KT); const float* fw3 = inp(A, I_HFW3) + (size_t)layer * 64 * 6144;
    LAS float* Wl = (LAS float*)F.lds;
    { const int cg = u >> 4, tsb = u & 15, t = tsb * 512 + F.tid;
        __syncthreads();
#pragma unroll 1
        for (int i = 0; i < 12; ++i) { const int e = F.tid + 512 * i, j = e / 96, rem = e - j * 96, od = rem / 24, cl = rem - od * 24;
            Wl[(cl * 4 + od) * 64 + j] = fw3[(size_t)j * 6144 + od * WMIX + cg * 24 + cl]; }
        f32x4 h2[16];
#pragma unroll
        for (int i = 0; i < 16; ++i) h2[i] = *(const f32x4*)(H2 + (size_t)t * 64 + 4 * i);
        __syncthreads();
        const float tl = (float)t / (float)(SEQ - 1);
#pragma unroll 1
        for (int cp = 0; cp < 12; ++cp) { float acc[8];
#pragma unroll
            for (int q = 0; q < 8; ++q) { const LAS f32x4* wp = (const LAS f32x4*)(Wl + (cp * 8 + q) * 64); f32x4 a = {0.f, 0.f, 0.f, 0.f};
#pragma unroll
                for (int i = 0; i < 16; ++i) { a += h2[i] * wp[i]; if ((i & 3) == 3) asm volatile("" ::: "memory"); }
                acc[q] = (a.x + a.y) + (a.z + a.w); asm volatile("" : "+v"(acc[q]) :: "memory"); }
            const int c = cg * 24 + 2 * cp; const float d0 = __expf(tl * hy_delta(c)), d1 = __expf(tl * hy_delta(c + 1));
#pragma unroll
            for (int o = 0; o < 2; ++o) { f32x2* kt = (f32x2*)KT + ((size_t)o * (WMIX / 2) + (c >> 1)) * FFTN;
                const f32x2 hf = {acc[o * 2] * d0, acc[4 + o * 2] * d1}, hb = {acc[o * 2 + 1] * d0, acc[4 + o * 2 + 1] * d1};
                if (t == 0) { kt[0] = hf + hb; kt[SEQ] = (f32x2){0.f, 0.f}; } else { kt[t] = hf; kt[FFTN - t] = hb; } } }
    }
    __syncthreads();
}
__device__ __forceinline__ void filt_taps_ctx(const Frame& F_, const Args& A, int layer) {
    const Frame F = fresh(F_);
    const float* H2C = WSP(float, WS_H2C); float* KC = WSP(float, WS_KC); const float* fw3 = inp(A, I_HFW3) + (size_t)layer * 64 * 6144;
    for (int u = F.gw; u < CTXL * 48; u += F.ngw) { const int t = u / 48, oc = (u - t * 48) * 64 + F.lane, o = oc / WMIX, c = oc - o * WMIX;
        const float hrow = H2C[t * 64 + F.lane];
        const float* wf = fw3 + o * 2 * WMIX + c; float hf = 0.f, hb = 0.f;
#pragma unroll 32
        for (int j = 0; j < 64; ++j) { const float h = lane_bcast(hrow, j); hf += h * wf[(size_t)j * 6144]; hb += h * wf[(size_t)j * 6144 + WMIX]; }
        const float dec = __expf(((float)t / (float)(CTXL - 1)) * hy_delta(c)); hf *= dec; hb *= dec;
        float* kc = KC + (size_t)o * 512 * WMIX + c;
        if (t == 0) kc[(size_t)255 * WMIX] = hf + hb; else { kc[(size_t)(255 + t) * WMIX] = hf; kc[(size_t)(255 - t) * WMIX] = hb; } }
}
__device__ __forceinline__ void filt_norm_ctx(const Frame& F_, const Args& A) {
    const Frame F = fresh(F_);
    const float* KC = WSP(float, WS_KC); float* KCN = WSP(float, WS_KCN); LAS float* red = (LAS float*)F.lds;
    for (int u = F.bid; u < 48; u += F.G) { const int o = u / 24, c = (u - o * 24) * 64 + F.lane; const float* kc = KC + (size_t)o * 512 * WMIX + c; float s = 0.f;
#pragma unroll 16
        for (int i = 0; i < 64; ++i) { const int l = F.wave + 8 * i; const float k = (l < 511) ? kc[(size_t)l * WMIX] : 0.f; s += k * k; }
        __syncthreads(); red[F.wave * 64 + F.lane] = s; __syncthreads();
        if (F.wave == 0) { float t = 0.f;
#pragma unroll
            for (int w = 0; w < 8; ++w) t += red[w * 64 + F.lane];
            KCN[o * WMIX + c] = rsqrtf(t + EPSN); }
    }
    __syncthreads();
}

#define DFT_BF0(A_, B_) do { const f32x2 a_ = (A_), t_ = (B_); (A_) = a_ + t_; (B_) = a_ - t_; } while (0)
#define DFT_BF8(A_, B_) do { const f32x2 a_ = (A_), b_ = (B_); const f32x2 t_ = {b_.y, -b_.x}; (A_) = a_ + t_; (B_) = a_ - t_; } while (0)
#define DFT_BFW(A_, B_, C_, S_) do { const f32x2 a_ = (A_), b_ = (B_); const f32x2 t_ = {b_.x * (C_) - b_.y * (S_), b_.x * (S_) + b_.y * (C_)}; (A_) = a_ + t_; (B_) = a_ - t_; } while (0)
template <int OFF> __device__ __forceinline__ void dft32(f32x2 (&v)[32]) {
    { const f32x2 t = v[OFF + 1]; v[OFF + 1] = v[OFF + 16]; v[OFF + 16] = t; }
    { const f32x2 t = v[OFF + 2]; v[OFF + 2] = v[OFF + 8]; v[OFF + 8] = t; }
    { const f32x2 t = v[OFF + 3]; v[OFF + 3] = v[OFF + 24]; v[OFF + 24] = t; }
    { const f32x2 t = v[OFF + 5]; v[OFF + 5] = v[OFF + 20]; v[OFF + 20] = t; }
    { const f32x2 t = v[OFF + 6]; v[OFF + 6] = v[OFF + 12]; v[OFF + 12] = t; }
    { const f32x2 t = v[OFF + 7]; v[OFF + 7] = v[OFF + 28]; v[OFF + 28] = t; }
    { const f32x2 t = v[OFF + 9]; v[OFF + 9] = v[OFF + 18]; v[OFF + 18] = t; }
    { const f32x2 t = v[OFF + 11]; v[OFF + 11] = v[OFF + 26]; v[OFF + 26] = t; }
    { const f32x2 t = v[OFF + 13]; v[OFF + 13] = v[OFF + 22]; v[OFF + 22] = t; }
    { const f32x2 t = v[OFF + 15]; v[OFF + 15] = v[OFF + 30]; v[OFF + 30] = t; }
    { const f32x2 t = v[OFF + 19]; v[OFF + 19] = v[OFF + 25]; v[OFF + 25] = t; }
    { const f32x2 t = v[OFF + 23]; v[OFF + 23] = v[OFF + 29]; v[OFF + 29] = t; }
    DFT_BF0(v[OFF + 0], v[OFF + 1]);
    DFT_BF0(v[OFF + 2], v[OFF + 3]);
    DFT_BF0(v[OFF + 4], v[OFF + 5]);
    DFT_BF0(v[OFF + 6], v[OFF + 7]);
    DFT_BF0(v[OFF + 8], v[OFF + 9]);
    DFT_BF0(v[OFF + 10], v[OFF + 11]);
    DFT_BF0(v[OFF + 12], v[OFF + 13]);
    DFT_BF0(v[OFF + 14], v[OFF + 15]);
    DFT_BF0(v[OFF + 16], v[OFF + 17]);
    DFT_BF0(v[OFF + 18], v[OFF + 19]);
    DFT_BF0(v[OFF + 20], v[OFF + 21]);
    DFT_BF0(v[OFF + 22], v[OFF + 23]);
    DFT_BF0(v[OFF + 24], v[OFF + 25]);
    DFT_BF0(v[OFF + 26], v[OFF + 27]);
    DFT_BF0(v[OFF + 28], v[OFF + 29]);
    DFT_BF0(v[OFF + 30], v[OFF + 31]);
    DFT_BF0(v[OFF + 0], v[OFF + 2]);
    DFT_BF8(v[OFF + 1], v[OFF + 3]);
    DFT_BF0(v[OFF + 4], v[OFF + 6]);
    DFT_BF8(v[OFF + 5], v[OFF + 7]);
    DFT_BF0(v[OFF + 8], v[OFF + 10]);
    DFT_BF8(v[OFF + 9], v[OFF + 11]);
    DFT_BF0(v[OFF + 12], v[OFF + 14]);
    DFT_BF8(v[OFF + 13], v[OFF + 15]);
    DFT_BF0(v[OFF + 16], v[OFF + 18]);
    DFT_BF8(v[OFF + 17], v[OFF + 19]);
    DFT_BF0(v[OFF + 20], v[OFF + 22]);
    DFT_BF8(v[OFF + 21], v[OFF + 23]);
    DFT_BF0(v[OFF + 24], v[OFF + 26]);
    DFT_BF8(v[OFF + 25], v[OFF + 27]);
    DFT_BF0(v[OFF + 28], v[OFF + 30]);
    DFT_BF8(v[OFF + 29], v[OFF + 31]);
    DFT_BF0(v[OFF + 0], v[OFF + 4]);
    DFT_BFW(v[OFF + 1], v[OFF + 5], 0.70710678118654757f, -0.70710678118654746f);
    DFT_BF8(v[OFF + 2], v[OFF + 6]);
    DFT_BFW(v[OFF + 3], v[OFF + 7], -0.70710678118654746f, -0.70710678118654757f);
    DFT_BF0(v[OFF + 8], v[OFF + 12]);
    DFT_BFW(v[OFF + 9], v[OFF + 13], 0.70710678118654757f, -0.70710678118654746f);
    DFT_BF8(v[OFF + 10], v[OFF + 14]);
    DFT_BFW(v[OFF + 11], v[OFF + 15], -0.70710678118654746f, -0.70710678118654757f);
    DFT_BF0(v[OFF + 16], v[OFF + 20]);
    DFT_BFW(v[OFF + 17], v[OFF + 21], 0.70710678118654757f, -0.70710678118654746f);
    DFT_BF8(v[OFF + 18], v[OFF + 22]);
    DFT_BFW(v[OFF + 19], v[OFF + 23], -0.70710678118654746f, -0.70710678118654757f);
    DFT_BF0(v[OFF + 24], v[OFF + 28]);
    DFT_BFW(v[OFF + 25], v[OFF + 29], 0.70710678118654757f, -0.70710678118654746f);
    DFT_BF8(v[OFF + 26], v[OFF + 30]);
    DFT_BFW(v[OFF + 27], v[OFF + 31], -0.70710678118654746f, -0.70710678118654757f);
    DFT_BF0(v[OFF + 0], v[OFF + 8]);
    DFT_BFW(v[OFF + 1], v[OFF + 9], 0.92387953251128674f, -0.38268343236508978f);
    DFT_BFW(v[OFF + 2], v[OFF + 10], 0.70710678118654757f, -0.70710678118654746f);
    DFT_BFW(v[OFF + 3], v[OFF + 11], 0.38268343236508984f, -0.92387953251128674f);
    DFT_BF8(v[OFF + 4], v[OFF + 12]);
    DFT_BFW(v[OFF + 5], v[OFF + 13], -0.38268343236508973f, -0.92387953251128674f);
    DFT_BFW(v[OFF + 6], v[OFF + 14], -0.70710678118654746f, -0.70710678118654757f);
    DFT_BFW(v[OFF + 7], v[OFF + 15], -0.92387953251128674f, -0.38268343236508989f);
    DFT_BF0(v[OFF + 16], v[OFF + 24]);
    DFT_BFW(v[OFF + 17], v[OFF + 25], 0.92387953251128674f, -0.38268343236508978f);
    DFT_BFW(v[OFF + 18], v[OFF + 26], 0.70710678118654757f, -0.70710678118654746f);
    DFT_BFW(v[OFF + 19], v[OFF + 27], 0.38268343236508984f, -0.92387953251128674f);
    DFT_BF8(v[OFF + 20], v[OFF + 28]);
    DFT_BFW(v[OFF + 21], v[OFF + 29], -0.38268343236508973f, -0.92387953251128674f);
    DFT_BFW(v[OFF + 22], v[OFF + 30], -0.70710678118654746f, -0.70710678118654757f);
    DFT_BFW(v[OFF + 23], v[OFF + 31], -0.92387953251128674f, -0.38268343236508989f);
    DFT_BF0(v[OFF + 0], v[OFF + 16]);
    DFT_BFW(v[OFF + 1], v[OFF + 17], 0.98078528040323043f, -0.19509032201612825f);
    DFT_BFW(v[OFF + 2], v[OFF + 18], 0.92387953251128674f, -0.38268343236508978f);
    DFT_BFW(v[OFF + 3], v[OFF + 19], 0.83146961230254524f, -0.55557023301960218f);
    DFT_BFW(v[OFF + 4], v[OFF + 20], 0.70710678118654757f, -0.70710678118654746f);
    DFT_BFW(v[OFF + 5], v[OFF + 21], 0.55557023301960229f, -0.83146961230254524f);
    DFT_BFW(v[OFF + 6], v[OFF + 22], 0.38268343236508984f, -0.92387953251128674f);
    DFT_BFW(v[OFF + 7], v[OFF + 23], 0.19509032201612833f, -0.98078528040323043f);
    DFT_BF8(v[OFF + 8], v[OFF + 24]);
    DFT_BFW(v[OFF + 9], v[OFF + 25], -0.19509032201612819f, -0.98078528040323043f);
    DFT_BFW(v[OFF + 10], v[OFF + 26], -0.38268343236508973f, -0.92387953251128674f);
    DFT_BFW(v[OFF + 11], v[OFF + 27], -0.55557023301960196f, -0.83146961230254546f);
    DFT_BFW(v[OFF + 12], v[OFF + 28], -0.70710678118654746f, -0.70710678118654757f);
    DFT_BFW(v[OFF + 13], v[OFF + 29], -0.83146961230254535f, -0.55557023301960218f);
    DFT_BFW(v[OFF + 14], v[OFF + 30], -0.92387953251128674f, -0.38268343236508989f);
    DFT_BFW(v[OFF + 15], v[OFF + 31], -0.98078528040323043f, -0.19509032201612861f);
}
template <int OFF> __device__ __forceinline__ void dft16(f32x2 (&v)[32]) {
    { const f32x2 t = v[OFF + 1]; v[OFF + 1] = v[OFF + 8]; v[OFF + 8] = t; }
    { const f32x2 t = v[OFF + 2]; v[OFF + 2] = v[OFF + 4]; v[OFF + 4] = t; }
    { const f32x2 t = v[OFF + 3]; v[OFF + 3] = v[OFF + 12]; v[OFF + 12] = t; }
    { const f32x2 t = v[OFF + 5]; v[OFF + 5] = v[OFF + 10]; v[OFF + 10] = t; }
    { const f32x2 t = v[OFF + 7]; v[OFF + 7] = v[OFF + 14]; v[OFF + 14] = t; }
    { const f32x2 t = v[OFF + 11]; v[OFF + 11] = v[OFF + 13]; v[OFF + 13] = t; }
    DFT_BF0(v[OFF + 0], v[OFF + 1]);
    DFT_BF0(v[OFF + 2], v[OFF + 3]);
    DFT_BF0(v[OFF + 4], v[OFF + 5]);
    DFT_BF0(v[OFF + 6], v[OFF + 7]);
    DFT_BF0(v[OFF + 8], v[OFF + 9]);
    DFT_BF0(v[OFF + 10], v[OFF + 11]);
    DFT_BF0(v[OFF + 12], v[OFF + 13]);
    DFT_BF0(v[OFF + 14], v[OFF + 15]);
    DFT_BF0(v[OFF + 0], v[OFF + 2]);
    DFT_BF8(v[OFF + 1], v[OFF + 3]);
    DFT_BF0(v[OFF + 4], v[OFF + 6]);
    DFT_BF8(v[OFF + 5], v[OFF + 7]);
    DFT_BF0(v[OFF + 8], v[OFF + 10]);
    DFT_BF8(v[OFF + 9], v[OFF + 11]);
    DFT_BF0(v[OFF + 12], v[OFF + 14]);
    DFT_BF8(v[OFF + 13], v[OFF + 15]);
    DFT_BF0(v[OFF + 0], v[OFF + 4]);
    DFT_BFW(v[OFF + 1], v[OFF + 5], 0.70710678118654757f, -0.70710678118654746f);
    DFT_BF8(v[OFF + 2], v[OFF + 6]);
    DFT_BFW(v[OFF + 3], v[OFF + 7], -0.70710678118654746f, -0.70710678118654757f);
    DFT_BF0(v[OFF + 8], v[OFF + 12]);
    DFT_BFW(v[OFF + 9], v[OFF + 13], 0.70710678118654757f, -0.70710678118654746f);
    DFT_BF8(v[OFF + 10], v[OFF + 14]);
    DFT_BFW(v[OFF + 11], v[OFF + 15], -0.70710678118654746f, -0.70710678118654757f);
    DFT_BF0(v[OFF + 0], v[OFF + 8]);
    DFT_BFW(v[OFF + 1], v[OFF + 9], 0.92387953251128674f, -0.38268343236508978f);
    DFT_BFW(v[OFF + 2], v[OFF + 10], 0.70710678118654757f, -0.70710678118654746f);
    DFT_BFW(v[OFF + 3], v[OFF + 11], 0.38268343236508984f, -0.92387953251128674f);
    DFT_BF8(v[OFF + 4], v[OFF + 12]);
    DFT_BFW(v[OFF + 5], v[OFF + 13], -0.38268343236508973f, -0.92387953251128674f);
    DFT_BFW(v[OFF + 6], v[OFF + 14], -0.70710678118654746f, -0.70710678118654757f);
    DFT_BFW(v[OFF + 7], v[OFF + 15], -0.92387953251128674f, -0.38268343236508989f);
}

__device__ __forceinline__ f32x2 cmul(f32x2 a, f32x2 b) { return (f32x2){a.x * b.x - a.y * b.y, a.x * b.y + a.y * b.x}; }
__device__ __forceinline__ int pidx(int i) { return i + (i >> 5); }
template <int R, int OFF> __device__ __forceinline__ void twiddle_reg(f32x2 (&v)[32], int num, float inv_den) {
    float s, c; __sincosf(-6.283185307179586f * (float)num * inv_den, &s, &c); const f32x2 w = {c, s}; f32x2 wr = w;
#pragma unroll
    for (int r = 1; r < R; ++r) { v[OFF + r] = cmul(v[OFF + r], wr); wr = cmul(wr, w); }
}
template <bool IN_REGS, bool HALF_ZERO, bool OUT_REGS> __device__ __forceinline__ void fft16k(LAS f32x2* Z, f32x2 (&v)[32], int tid) {
    asm volatile("" : "+v"(tid));
    LAS f32x2* Zt = Z + pidx(tid);
    if (!IN_REGS) {
#pragma unroll
        for (int r = 0; r < 32; ++r) v[r] = (HALF_ZERO && r >= 16) ? (f32x2){0.f, 0.f} : Zt[528 * r];
        __syncthreads(); }
    dft32<0>(v);
    { LAS f32x2* Zw = Z + 33 * tid;
#pragma unroll
      for (int q = 0; q < 32; ++q) Zw[q] = v[q]; }
    __syncthreads();
#pragma unroll
    for (int r = 0; r < 32; ++r) v[r] = Zt[528 * r];
    __syncthreads();
    twiddle_reg<32, 0>(v, tid & 31, 1.0f / 1024.0f); dft32<0>(v);
    { LAS f32x2* Zw = Z + (tid >> 5) * 1056 + (tid & 31);
#pragma unroll
      for (int q = 0; q < 32; ++q) Zw[33 * q] = v[q]; }
    __syncthreads();
#pragma unroll
    for (int h = 0; h < 2; ++h)
#pragma unroll
        for (int r = 0; r < 16; ++r) v[h * 16 + r] = Zt[528 * h + 1056 * r];
    __syncthreads();
    twiddle_reg<16, 0>(v, tid, 1.0f / 16384.0f); twiddle_reg<16, 16>(v, tid + 512, 1.0f / 16384.0f); dft16<0>(v); dft16<16>(v);
    if (!OUT_REGS) {
#pragma unroll
        for (int h = 0; h < 2; ++h)
#pragma unroll
            for (int q = 0; q < 16; ++q) Zt[528 * h + 1056 * q] = v[h * 16 + q];
        __syncthreads(); }
}
__device__ __forceinline__ void filt_spectra_unit(const Frame& F_, const Args& A, int u) {
    const Frame F = fresh(F_);
    const float* KT = WSP(float, WS_KT); f32x2* PM = WSP(f32x2, WS_PM); LAS f32x2* Z = (LAS f32x2*)F.lds; LAS float* red = (LAS float*)(F.lds + RED_OFF); constexpr int PMS = 8704;
    { const int o = u / 768, p = u - o * 768;
        const f32x2* kab = (const f32x2*)KT + ((size_t)o * (WMIX / 2) + p) * FFTN + F.tid;
        f32x2 v[32]; float sa = 0.f, sb = 0.f;
#pragma unroll
        for (int r = 0; r < 32; ++r) { v[r] = kab[512 * r]; sa += v[r].x * v[r].x; sb += v[r].y * v[r].y; }
        sa = wave_sum(sa); sb = wave_sum(sb);
        __syncthreads();
        if (F.lane == 0) { red[F.wave * 2] = sa; red[F.wave * 2 + 1] = sb; }
        __syncthreads();
        float ta = 0.f, tb = 0.f;
#pragma unroll
        for (int w = 0; w < 8; ++w) { ta += red[w * 2]; tb += red[w * 2 + 1]; }
        const float na = rsqrtf(ta + EPSN) * 0.5f, nb = rsqrtf(tb + EPSN) * 0.5f;
#pragma unroll
        for (int r = 0; r < 32; ++r) { const float a = v[r].x * na, b = v[r].y * nb; v[r] = (f32x2){a + b, a - b}; }
        fft16k<true, false, false>(Z, v, F.tid);
        f32x4* pm4 = (f32x4*)PM + (size_t)(o * 768 + p) * PMS;
#pragma unroll 4
        for (int i = 0; i < 16; ++i) { const int k = F.tid + 512 * i, km = (FFTN - k) & (FFTN - 1); const f32x2 wk = Z[pidx(k)], wm = Z[pidx(km)];
            pm4[k] = (f32x4){0.5f * (wk.x + wm.x), 0.5f * (wk.y - wm.y), 0.5f * (wk.y + wm.y), -0.5f * (wk.x - wm.x)}; }
        if (F.tid == 0) { const f32x2 wk = Z[pidx(FFTN / 2)]; pm4[FFTN / 2] = (f32x4){wk.x, 0.f, wk.y, 0.f}; }
    }
    __syncthreads();
}
__device__ __forceinline__ void filler(const Frame& F, const Args& A, int kind, int flayer, int base, int j, int nidle, int quota) {
    if (j < 0) return;
    const int total = (kind == 1) ? 1024 : 1536;
#pragma unroll 1
    for (int m = 0; m < quota; ++m) { const int u = base + j + nidle * m; if (u >= total || u >= base + nidle * quota) break;
        if (kind == 1) filt_taps_unit(F, A, flayer, u); else filt_spectra_unit(F, A, u); }
}
__device__ __forceinline__ void hyena_conv_unit(const Frame& F_, const Args& A, int layer, int p) {
    const Frame F = fresh(F_);
    const unsigned* VT2 = WSP(unsigned, WS_VT)  ; unsigned* YBT2 = WSP(unsigned, WS_YBT)  ; const f32x4* PM4 = WSP(f32x4, WS_PM); LAS f32x2* Z = (LAS f32x2*)F.lds; constexpr int PMS = 8704;
    const int tid = F.tid; const float* skip = inp(A, I_HSKIP) + (size_t)layer * 2 * WMIX;
    LAS f32x2* Zt = Z + pidx(tid);
    f32x2 v[32];
    __syncthreads();
    { const unsigned* v0 = VT2 + (size_t)p * SEQ + tid;
#pragma unroll
      for (int r = 0; r < 16; ++r) { const unsigned w = v0[512 * r]; Zt[528 * r] = (f32x2){bflo(w), bfhi(w)}; } }
    __syncthreads();
#pragma unroll 1
    for (int o = 0; o < 2; ++o) {
        const f32x4* pmp = PM4 + (size_t)(o * 768 + p) * PMS;
        f32x4 pm[16];
#pragma unroll
        for (int i = 0; i < 16; ++i) pm[i] = pmp[tid + 512 * i];
        const f32x4 pmh = pmp[FFTN / 2];
        fft16k<false, true, false>(Z, v, tid);
#pragma unroll
        for (int i = 0; i < 16; ++i) { const int k = tid + 512 * i, km = (FFTN - k) & (FFTN - 1); const f32x2 zk = Zt[528 * i], zm = Z[pidx(km)];
            const f32x2 pk = {pm[i].x, pm[i].y}, mk = {pm[i].z, pm[i].w};
            const f32x2 cyk = cmul((f32x2){zk.x, -zk.y}, (f32x2){pk.x, -pk.y}) + cmul(zm, (f32x2){mk.x, -mk.y});
            const f32x2 cym = cmul((f32x2){zm.x, -zm.y}, pk) + cmul(zk, mk);
            Zt[528 * i] = cyk; if (km != k) Z[pidx(km)] = cym; }
        if (tid == 0) { const int k = FFTN / 2; const f32x2 zk = Z[pidx(k)]; const f32x2 pk = {pmh.x, pmh.y}, mk = {pmh.z, pmh.w};
            Z[pidx(k)] = cmul((f32x2){zk.x, -zk.y}, (f32x2){pk.x, -pk.y}) + cmul(zk, (f32x2){mk.x, -mk.y}); }
        __syncthreads();
        const unsigned* gp = VT2 + ((size_t)(o + 1) * (WMIX / 2) + p) * SEQ + tid;
        const unsigned* zp = ((o == 0) ? VT2 : (const unsigned*)YBT2) + (size_t)p * SEQ + tid;
        unsigned gg[16], zz[16];
#pragma unroll
        for (int h = 0; h < 2; ++h)
#pragma unroll
            for (int q = 0; q < 8; ++q) { const int dt = 512 * h + 1024 * q; gg[h * 8 + q] = gp[dt]; zz[h * 8 + q] = zp[dt]; }
        fft16k<false, false, true>(Z, v, tid);
        const float ska = skip[o * WMIX + 2 * p], skb = skip[o * WMIX + 2 * p + 1];
        unsigned* yo = YBT2 + (size_t)p * SEQ + tid;
#pragma unroll
        for (int h = 0; h < 2; ++h)
#pragma unroll
            for (int q = 0; q < 8; ++q) { const f32x2 R = v[h * 16 + q], g = {bflo(gg[h * 8 + q]), bfhi(gg[h * 8 + q])}, z = {bflo(zz[h * 8 + q]), bfhi(zz[h * 8 + q])};
                const f32x2 zn = {g.x * (R.x * (1.0f / FFTN) + ska * z.x), g.y * (-R.y * (1.0f / FFTN) + skb * z.y)};
                const unsigned zw = pk2(zn.x, zn.y); yo[512 * h + 1024 * q] = zw; if (o == 0) Zt[528 * h + 1056 * q] = (f32x2){bflo(zw), bfhi(zw)}; }
        __syncthreads();
    }
}
#ifdef PROBE_FFT
__device__ __forceinline__ void hyena_fft_dummy(const Frame& F_) {
    const Frame F = fresh(F_); LAS f32x2* Z = (LAS f32x2*)F.lds; f32x2 v[32];
    __syncthreads();
#pragma unroll 1
    for (int o = 0; o < 2; ++o) { fft16k<false, true, false>(Z, v, F.tid); fft16k<false, false, true>(Z, v, F.tid);
        if (v[0].x == 123456.789f) Z[0] = v[5];
        __syncthreads(); }
}
#endif
__device__ __forceinline__ void hyena_ctx_unit(const Frame& F_, const Args& A, int layer, int u) {
    const Frame F = fresh(F_);
    const float* UC = WSP(float, WS_UC); const float* KC = WSP(float, WS_KC); const float* KCN = WSP(float, WS_KCN); bf16* YB = WSP(bf16, WS_YB);
    LAS float* zb0 = (LAS float*)F.lds; LAS float* zb1 = zb0 + 256 * 32;
    const int cl = F.tid & 31, tb = F.tid >> 5, c = u * 32 + cl, t0 = tb * 16; const float* skip = inp(A, I_HSKIP) + (size_t)layer * 2 * WMIX;
    float zc[16], g1[16], g2[16];
    __syncthreads();
#pragma unroll
    for (int i = 0; i < 16; ++i) { zc[i] = UC[((size_t)0 * CTXL + t0 + i) * WMIX + c]; g1[i] = UC[((size_t)1 * CTXL + t0 + i) * WMIX + c]; g2[i] = UC[((size_t)2 * CTXL + t0 + i) * WMIX + c]; zb0[(t0 + i) * 32 + cl] = zc[i]; }
    __syncthreads();
#pragma unroll
    for (int o = 0; o < 2; ++o) { const LAS float* zb = o ? zb1 : zb0; const float* kc = KC + (size_t)o * 512 * WMIX + c; float acc[16];
#pragma unroll
        for (int i = 0; i < 16; ++i) acc[i] = 0.f;
#pragma unroll 1
        for (int s0 = 0; s0 < CTXL; s0 += 16) { float w[31]; const float* kb = kc + (size_t)(255 + t0 - s0 - 15) * WMIX;
#pragma unroll
            for (int q = 0; q < 31; ++q) w[q] = kb[(size_t)q * WMIX];
#pragma unroll
            for (int j = 0; j < 16; ++j) { const float zs = zb[(s0 + j) * 32 + cl];
#pragma unroll
                for (int i = 0; i < 16; ++i) acc[i] += w[15 + i - j] * zs; } }
        const float kn = KCN[o * WMIX + c], sk = skip[o * WMIX + c];
#pragma unroll
        for (int i = 0; i < 16; ++i) { const float zn = (o ? g2[i] : g1[i]) * (acc[i] * kn + sk * zc[i]);
            if (o == 0) { zc[i] = zn; zb1[(t0 + i) * 32 + cl] = zn; } else YB[(size_t)(t0 + i) * WMIX + c] = (bf16)f2bf(zn); }
        __syncthreads(); }
}
__device__ __forceinline__ void lru_chunk_agg(const Frame& F_, const Args& A) {
    const Frame F = fresh(F_);
    const unsigned* LAB = WSP(unsigned, WS_LA); float* CA = WSP(float, WS_CA); float* CB = WSP(float, WS_CB);
    for (int u = F.gw; u < NCHUNK * 12; u += F.ngw) { const int chunk = u / 12, rem = u - chunk * 12, dir = rem / 6, c = (rem - dir * 6) * 256 + 4 * F.lane;
        const unsigned* pab = LAB + (((size_t)dir * NCHUNK + chunk) * 6 + (c >> 8)) * 64 * 256 + (c & 255);
        f32x4 Aa = {1.f, 1.f, 1.f, 1.f}, B = {0.f, 0.f, 0.f, 0.f};
#pragma unroll 32
        for (int i = 0; i < 64; ++i) { const int rr = dir ? 63 - i : i; const v4u w = *(const v4u*)(pab + rr * 256);
            const f32x4 a = {__expf(bflo(w.x)), __expf(bflo(w.y)), __expf(bflo(w.z)), __expf(bflo(w.w))}, b = {bfhi(w.x), bfhi(w.y), bfhi(w.z), bfhi(w.w)}; B = a * B + b; Aa = Aa * a; }
        *(f32x4*)(CA + ((size_t)dir * NCHUNK + chunk) * WMIX + c) = Aa; *(f32x4*)(CB + ((size_t)dir * NCHUNK + chunk) * WMIX + c) = B; }
}
__device__ __forceinline__ void lru_carries(const Frame& F_, const Args& A) {
    const Frame F = fresh(F_);
    const float* CA = WSP(float, WS_CA); const float* CB = WSP(float, WS_CB); float* CIN = WSP(float, WS_CIN);
    const int slot = F.bid >> 3; if ((F.bid & 7) != 1 || slot < 4 || slot >= 10) return;
    { const int u = (slot - 4) * 8 + F.wave; const int dir = u / 24, c = (u - dir * 24) * 64 + F.lane; float H = 0.f;
#pragma unroll 1
        for (int i0 = 0; i0 < NCHUNK; i0 += 22) { float ca[22], cb[22];
#pragma unroll
            for (int j = 0; j < 22; ++j) { const int i = i0 + j, chunk = dir ? ((i < 4) ? 3 - i : NCHUNK + 3 - i) : i; const size_t ix = ((size_t)dir * NCHUNK + chunk) * WMIX + c; ca[j] = CA[ix]; cb[j] = CB[ix]; }
#pragma unroll
            for (int j = 0; j < 22; ++j) { const int i = i0 + j, chunk = dir ? ((i < 4) ? 3 - i : NCHUNK + 3 - i) : i; const size_t ix = ((size_t)dir * NCHUNK + chunk) * WMIX + c; CIN[ix] = H; H = ca[j] * H + cb[j]; } } }
}
__device__ __forceinline__ void lru_out(const Frame& F_, const Args& A) {
    const Frame F = fresh(F_);
    const unsigned* LAB = WSP(unsigned, WS_LA); const float* CIN = WSP(float, WS_CIN); const bf16* P = WSP(bf16, WS_P); bf16* YA = WSP(bf16, WS_YA);
    for (int u = F.gw; u < NCHUNK * 12; u += F.ngw) { const int chunk = u / 12, c = (u - chunk * 12) * 128 + 2 * F.lane, base = chunk * 64;
        const unsigned* pf = LAB + (((size_t)chunk) * 6 + (c >> 8)) * 64 * 256 + (c & 255); const unsigned* pr = pf + (size_t)NCHUNK * 6 * 64 * 256;
        f32x2 hf[64]; f32x2 H = *(const f32x2*)(CIN + ((size_t)chunk) * WMIX + c);
#pragma unroll
        for (int i = 0; i < 64; ++i) { const v2u w = *(const v2u*)(pf + i * 256); H = (f32x2){__expf(bflo(w.x)), __expf(bflo(w.y))} * H + (f32x2){bfhi(w.x), bfhi(w.y)}; hf[i] = H; }
        H = *(const f32x2*)(CIN + ((size_t)NCHUNK + chunk) * WMIX + c);
#pragma unroll
        for (int i = 63; i >= 0; --i) { const v2u w = *(const v2u*)(pr + i * 256); H = (f32x2){__expf(bflo(w.x)), __expf(bflo(w.y))} * H + (f32x2){bfhi(w.x), bfhi(w.y)};
            const unsigned gw = *(const unsigned*)(P + (size_t)(base + i) * NIN + COL_AG + c); const f32x2 y = (hf[i] + H) * (f32x2){bflo(gw), bfhi(gw)};
            *(unsigned*)(YA + (size_t)(base + i) * WMIX + c) = pk2(y.x, y.y); } }
}
__device__ __forceinline__ void yb_transpose(const Frame& F_, const Args& A) {
    const Frame F = fresh(F_);
    const float* YBT = WSP(float, WS_YBT); bf16* YB = WSP(bf16, WS_YB); LAS float* scr = (LAS float*)(F.lds + F.wave * WSCR_BYTES);
    for (int u = F.gw; u < (SEQ / 64) * 24; u += F.ngw) { const int tb = u / 24, c0 = (u - tb * 24) * 64, t0 = tb * 64;
#pragma unroll
        for (int i = 0; i < 32; ++i) { const unsigned y = ((const unsigned*)YBT)[(size_t)((c0 >> 1) + i) * SEQ + t0 + F.lane]; scr[(2 * i) * 65 + F.lane] = bflo(y); scr[(2 * i + 1) * 65 + F.lane] = bfhi(y); }
        LDS_WAIT(); asm volatile("" ::: "memory");
#pragma unroll
        for (int g8 = 0; g8 < 8; ++g8) { const int tt = 8 * g8 + (F.lane >> 3), c8 = (F.lane & 7) * 8; const LAS float* sp = scr + c8 * 65 + tt;
            *(v4u*)(YB + (size_t)(CTXL + t0 + tt) * WMIX + c0 + c8) = (v4u){pk2(sp[0], sp[65]), pk2(sp[130], sp[195]), pk2(sp[260], sp[325]), pk2(sp[390], sp[455])}; }
        LDS_WAIT(); asm volatile("" ::: "memory"); }
}
__device__ __forceinline__ void attn_phase(const Frame& F_, const Args& A, bool with_ctx, char* lds) {
    const Frame F = fresh(F_);
    const att::bf16* QN = WSP(att::bf16, WS_QN); const att::bf16* KN = WSP(att::bf16, WS_KN); const att::bf16* VN = WSP(att::bf16, WS_VN); bf16* YC = WSP(bf16, WS_YC);
    const int x = F.bid & 7, slot = F.bid >> 3, kvh = x >> 1, per = F.G >> 2;
    const int nunits = 3 * (with_ctx ? 33 : 32);
    for (int idx = (x & 1) * (F.G >> 3) + slot; idx < nunits; idx += per) { const int qh = kvh * 3 + idx % 3, qb = idx / 3;
        const int row0 = (qb < 32) ? CTXL + qb * 256 : 0, seq = (qb < 32) ? MROWS : CTXL;
        __syncthreads();
        att::attn_dense_body<att::bf16>(QN + (size_t)row0 * WMIX + qh * 128, KN + kvh * 128, VN + kvh * 128, YC + (size_t)row0 * WMIX + qh * 128, seq, lds, F.tid);
    }
    __syncthreads();
}
#ifndef GEMM_SP2
#define GEMM_SP2 true
#endif
#ifndef GEMM_ALIGN
#define GEMM_ALIGN true
#endif
#ifndef WIN_WGM
#define WIN_WGM 4
#endif
#ifndef KH_CTX
#define KH_CTX 1
#endif
#ifndef KH_LAST
#define KH_LAST 0
#endif
#ifndef WIN_NS
#define WIN_NS 1
#endif
#ifndef UP1_QUOTA
#define UP1_QUOTA 2
#endif
#ifndef WIN_SLABS
#define WIN_SLABS 2
#endif
#ifndef MERGE_ALIGN
#define MERGE_ALIGN GEMM_ALIGN
#endif
#ifndef RESID_ALIGN
#define RESID_ALIGN GEMM_ALIGN
#endif
#ifndef MK_PER_PHASE
#define MK_PER_PHASE 0
#endif
constexpr int PH_PER_LAYER = 15, PH_LAYER0 = 2, PH_FINAL = PH_LAYER0 + DEPTH * PH_PER_LAYER, N_PHASES = PH_FINAL + 1;

__global__ void __launch_bounds__(NWAVES * 64, 2) mk_fwd(Args A) {
    extern __shared__ __attribute__((aligned(16))) unsigned char lds[];
    Frame F;
    F.lds = (LAS unsigned char*)lds; F.ws = (unsigned char*)(GAS unsigned char*)A.ws; F.out = (float*)(GAS float*)A.out;
    F.tid = threadIdx.x; F.lane = F.tid & 63; F.wave = __builtin_amdgcn_readfirstlane((int)threadIdx.x >> 6);
    F.G = gridDim.x; F.bid = blockIdx.x; F.gw = blockIdx.x * NWAVES + F.wave; F.ngw = F.G * NWAVES;
    volatile LAS unsigned* MISC = (volatile LAS unsigned*)(F.lds + MISC_OFF);
    for (int u = F.tid; u < (LDS_BYTES - LDSCTL_OFF) / 4; u += NWAVES * 64) ((LAS unsigned*)(F.lds + LDSCTL_OFF))[u] = 0u;
    __syncthreads();
    gu32* ctl = (gu32*)(F.ws + WS_CTL);
    XcdBarrier bar = xcd_barrier_post((unsigned*)(ctl + CW_BAR), MISC + 8);
    const int lo = A.ph_lo, hi = A.ph_hi;
#define IN(k) (lo <= (k) && (k) < hi)
#ifndef EN_MASK
#define EN_MASK 0xffffffffu
#endif
#define EN(b) ((EN_MASK >> (b)) & 1u)
#ifndef REP_MASK
#define REP_MASK 0u
#endif
#define REPS(b) (((REP_MASK >> (b)) & 1u) ? 2 : 1)
#ifdef PROBE_BAR
#define SEAM(k) do { if (IN(k) && IN((k) + 1)) { xcd_barrier(bar); xcd_barrier(bar); } } while (0)
#else
#define SEAM(k) do { if (IN(k) && IN((k) + 1)) xcd_barrier(bar); } while (0)
#endif
    LAS unsigned char* ring = F.lds + RING_OFF;

    if (EN(0) && IN(0)) { for (int rep_ = 0; rep_ < REPS(0); ++rep_) prologue_a(F, A); filt_mlp(F, A, 0, true); }
    SEAM(0);
    if (EN(1) && IN(1)) { prologue_b(F, A); { const Frame L = fresh(F); for (int u = L.bid; u < 1024; u += L.G) filt_taps_unit(F, A, 0, u); } filt_taps_ctx(F, A, 0); }
    SEAM(1);

    for (int layer = 0; layer < DEPTH; ++layer) {
        const int pb = PH_LAYER0 + layer * PH_PER_LAYER;
        if (!(lo < pb + PH_PER_LAYER && pb < hi)) continue;
        const bool ctx_out = layer < DEPTH - 1;
        const int roff = ctx_out ? 0 : CTXL;
        unsigned char* wb = F.ws + WS_W + (size_t)layer * W_LAYER;
        const float* modL = WSP(float, WS_MOD) + (size_t)(layer * 2 + 0) * NMOD * DM; const float* modC = modL + (size_t)NMOD * DM;
        bf16* U = WSP(bf16, WS_U); bf16* H = WSP(bf16, WS_H); float* X = WSP(float, WS_X); bf16* P = WSP(bf16, WS_P);
        for (int half = 0; half < 2; ++half) {
            const int p0 = pb + (half ? 12 : 0), im = half ? 6 : 0;
            if (EN(2) && IN(p0)) { for (int rep_ = 0; rep_ < REPS(2); ++rep_) { __syncthreads(); norm_phase(F, A, inp(A, half ? I_NF2 : I_NF1) + (size_t)layer * DM, modL, modC, im + 0, im + 1, half ? roff : (layer == 0 ? MROWS : 0));
                if (!half && layer == 0) { const Frame L = fresh(F); for (int u = L.bid; u < 480; u += L.G) filt_spectra_unit(F, A, u); }
                if (half && layer + 1 < DEPTH - 1) filt_taps_ctx(F, A, layer + 1); } }
            SEAM(p0);
            const int hro = half ? roff : 0; const size_t hoff = (size_t)hro * DM;
            if (EN(3) && IN(p0 + 1)) { for (int rep_ = 0; rep_ < REPS(3); ++rep_) { __syncthreads(); pg8::Gemm g{U + hoff, (const bf16*)(wb + (half ? WO_GU2 : WO_GU1)), MROWS - hro, 2 * DFF, DM}; pg8::StaticOrder S; S.init(MROWS - hro, 2 * DFF, F.G, fresh(F).bid);
                pg8::EpiSwiglu E{H + hoff, DFF}; pg8::gemm_phase<pg8::EpiSwiglu, pg8::StaticOrder, GEMM_ALIGN, GEMM_SP2>(ring, g, S, E, fresh(F).tid);
                if (!half) filler(F, A, 2, layer, 480, fresh(F).bid - 32, 224, UP1_QUOTA); else if (layer + 1 < DEPTH) filler(F, A, 1, layer + 1, 960, fresh(F).bid - 32, 224, 1); } }
            SEAM(p0 + 1);
            if (EN(4) && IN(p0 + 2)) for (int rep_ = 0; rep_ < REPS(4); ++rep_) { __syncthreads(); pg8::Gemm g{H + hoff, (const bf16*)(wb + (half ? WO_D2 : WO_D1)), MROWS - hro, DM, DFF}; pg8::StaticOrder S; S.init(MROWS - hro, DM, F.G, fresh(F).bid);
                pg8::EpiResid E{WSP(bf16, WS_M32) + hoff, DM, modL + (im + 2) * DM, (hro ? modL : modC) + (im + 2) * DM, 0.5f}; pg8::gemm_phase<pg8::EpiResid, pg8::StaticOrder, RESID_ALIGN, GEMM_SP2>(ring, g, S, E, fresh(F).tid);
                if (!half) filler(F, A, 2, layer, 928, fresh(F).bid - 16, 240, 2); else if (layer + 1 < DEPTH) filler(F, A, 2, layer + 1, 0, fresh(F).bid - 16, 240, 2); }
            if (half) { SEAM(p0 + 2); continue; }
            SEAM(p0 + 2);
            if (EN(5) && IN(pb + 3)) { for (int rep_ = 0; rep_ < REPS(5); ++rep_) { __syncthreads(); norm_phase(F, A, inp(A, I_NMIX) + (size_t)layer * DM, modL, modC, 3, 4, 0); } }
            SEAM(pb + 3);
            if (EN(6) && IN(pb + 4)) { for (int rep_ = 0; rep_ < REPS(6); ++rep_) { __syncthreads();
                constexpr int NSL = WIN_SLABS, NT_SL = (NIN / 256) / NSL, R_SL = (33 * NT_SL) % 256;
#pragma unroll 1
                for (int sl = 0; sl < NSL; ++sl) { pg8::Gemm g{U, (const bf16*)(wb + WO_IN) + (size_t)sl * (NT_SL * 256) * DM, MROWS, NT_SL * 256, DM}; pg8::StaticOrder S; S.init(MROWS, NT_SL * 256, F.G, fresh(F).bid); S.wgm = WIN_WGM;
                    pg8::EpiWin E{P, NIN, sl * NT_SL}; pg8::gemm_phase<pg8::EpiWin, pg8::StaticOrder, GEMM_ALIGN, GEMM_SP2>(ring, g, S, E, fresh(F).tid); }
                filler(F, A, 2, layer, 1408, fresh(F).bid - R_SL, 256 - R_SL, (168 + 255 - R_SL) / (256 - R_SL)); } }
            SEAM(pb + 4);
            if (EN(7) && IN(pb + 5)) { for (int rep_ = 0; rep_ < REPS(7); ++rep_) { __syncthreads(); prep_lru_conv(F, A, layer); prep_qkv(F, A, layer); prep_hyena_t(F, A, layer); if (ctx_out) { prep_hyena_ctx(F, A, layer); filt_norm_ctx(F, A); } } }
            SEAM(pb + 5);
            if (EN(8) && IN(pb + 6)) { for (int rep_ = 0; rep_ < REPS(8); ++rep_) { __syncthreads(); int klru = 256; asm volatile("" : "+s"(klru));
                pg8::Gemm g{WSP(bf16, WS_XA), (const bf16*)(wb + WO_LRU), 6 * MROWS, 6 * 1024, klru}; pg8::LruOrder S; S.init(F.G, fresh(F).bid);
                pg8::EpiLru E{WSP(float, WS_LA), WSP(float, WS_LB), WSP(bf16, WS_XA), inp(A, I_LBA) + (size_t)layer * 2 * WMIX, inp(A, I_LBX) + (size_t)layer * 2 * WMIX, WSP(float, WS_MOD + 1536 * 1024) + (size_t)layer * 2 * WMIX, MROWS, WSP(float, WS_CA), WSP(float, WS_CB)};
                pg8::gemm_phase<pg8::EpiLru, pg8::LruOrder, GEMM_ALIGN, GEMM_SP2>(ring, g, S, E, fresh(F).tid);
                if (layer + 1 < DEPTH) filt_mlp(F, A, layer + 1, layer + 1 < DEPTH - 1, 24); } }
            SEAM(pb + 6);
            if (EN(9) && IN(pb + 7)) {   }
            if (EN(10) && IN(pb + 8)) { for (int rep_ = 0; rep_ < REPS(10); ++rep_) { __syncthreads();
                lru_carries(F, A);
                if (EN(17)) for (int r2_ = 0; r2_ < REPS(17); ++r2_) attn_phase(F, A, ctx_out, (char*)lds);
                { const Frame L = fresh(F); const int x = L.bid & 7, slot = L.bid >> 3, nunits = 3 * (ctx_out ? 33 : 32), thr = nunits - 96, KH = ctx_out ? KH_CTX : KH_LAST;
                  const bool light = (x & 1) && slot >= thr; const int nh = 128 + 4 * thr, nl = 4 * (32 - thr), total = 768 + (ctx_out ? 48 : 0);
                  const int hi_ = (x & 1) ? 128 + (x >> 1) * thr + slot : (x >> 1) * 32 + slot, li = (x >> 1) * (32 - thr) + (slot - thr);
                  for (int r2_ = 0; r2_ < REPS(18); ++r2_)
                  for (int m = 0; ; ++m) { int u; if (light) { u = KH * nh + li + nl * m; if (u >= total) break; } else { if (m >= KH) break; u = hi_ + nh * m; if (u >= total) break; }
                      if (u < 768) { if (EN(18)) hyena_conv_unit(F, A, layer, u);
#ifdef PROBE_FFT
                          hyena_fft_dummy(F);
#endif
                      } else { if (EN(19)) hyena_ctx_unit(F, A, layer, u - 768); } } }
            } }
            SEAM(pb + 8);
            if (EN(11) && IN(pb + 9)) { for (int rep_ = 0; rep_ < REPS(11); ++rep_) { __syncthreads(); lru_out(F, A); yb_transpose(F, A); } }
            SEAM(pb + 9);
            if (EN(12) && IN(pb + 10)) { for (int rep_ = 0; rep_ < REPS(12); ++rep_) { __syncthreads(); const bf16* WB = (const bf16*)(wb + WO_BR); float* M32 = WSP(float, WS_M32) + (size_t)roff * DM; pg8::StaticOrder S; S.init(MROWS - roff, DM, F.G, fresh(F).bid);
                const size_t yo = (size_t)roff * WMIX; bf16* Hm = H + (size_t)roff * DM; const bf16* Pg = P + (size_t)roff * NIN + COL_G; const int Mm = MROWS - roff;
                { pg8::Gemm g{WSP(bf16, WS_YA) + yo, WB, Mm, DM, WMIX}; pg8::EpiMerge<0> E{M32, Hm, Pg, NIN}; pg8::gemm_phase<pg8::EpiMerge<0>, pg8::StaticOrder, MERGE_ALIGN, GEMM_SP2>(ring, g, S, E, fresh(F).tid); }
                { pg8::Gemm g{WSP(bf16, WS_YB) + yo, WB + (size_t)DM * WMIX, Mm, DM, WMIX}; pg8::EpiMerge<1> E{M32, Hm, Pg + DM, NIN}; pg8::gemm_phase<pg8::EpiMerge<1>, pg8::StaticOrder, MERGE_ALIGN, GEMM_SP2>(ring, g, S, E, fresh(F).tid); }
                { pg8::Gemm g{WSP(bf16, WS_YC) + yo, WB + (size_t)2 * DM * WMIX, Mm, DM, WMIX}; pg8::EpiMerge<2> E{M32, Hm, Pg + 2 * DM, NIN}; pg8::gemm_phase<pg8::EpiMerge<2>, pg8::StaticOrder, MERGE_ALIGN, GEMM_SP2>(ring, g, S, E, fresh(F).tid); }
                if (layer + 1 < DEPTH) filler(F, A, 1, layer + 1, 0, fresh(F).bid - 16, 240, 2); } }
            SEAM(pb + 10);
            if (EN(13) && IN(pb + 11)) for (int rep_ = 0; rep_ < REPS(13); ++rep_) { __syncthreads(); pg8::Gemm g{H + (size_t)roff * DM, (const bf16*)(wb + WO_OUT), MROWS - roff, DM, DM}; pg8::StaticOrder S; S.init(MROWS - roff, DM, F.G, fresh(F).bid);
                pg8::EpiResid E{WSP(bf16, WS_M32) + (size_t)roff * DM, DM, modL + 5 * DM, (roff ? modL : modC) + 5 * DM, 1.0f}; pg8::gemm_phase<pg8::EpiResid, pg8::StaticOrder, RESID_ALIGN, GEMM_SP2>(ring, g, S, E, fresh(F).tid);
                if (layer + 1 < DEPTH) filler(F, A, 1, layer + 1, 480, fresh(F).bid - 16, 240, 2); }
            SEAM(pb + 11);
        }
    }
#ifdef DUMP
    if (IN(PH_FINAL)) dump_phase(F, A);
#else
    if (EN(14) && IN(PH_FINAL)) final_norm_phase(F, A);
#endif
#undef IN
#undef SEAM
}

extern "C" void kernel_launch(void* const* d_in, const int* in_sizes, int n_in, void* d_out, int out_size, void* d_ws, size_t ws_size, hipStream_t stream) {
    static int grid = 0;
    if (grid == 0) {
        if (n_in != N_IN_TENSORS || in_sizes[0] != SEQ * DM || out_size != SEQ * DM || ws_size < WS_END) {
            fprintf(stderr, "kernel_launch: shape mismatch: n_in %d in0 %d out %d ws %zu (need %zu)\n", n_in, n_in > 0 ? in_sizes[0] : -1, out_size, ws_size, (size_t)WS_END); grid = -1; return; }
        int dev = 0, cus = 0, per_cu = 0;
        if (hipGetDevice(&dev) != hipSuccess || hipDeviceGetAttribute(&cus, hipDeviceAttributeMultiprocessorCount, dev) != hipSuccess) { fprintf(stderr, "kernel_launch: device query failed\n"); grid = -1; return; }
        if (hipFuncSetAttribute((const void*)mk_fwd, hipFuncAttributeMaxDynamicSharedMemorySize, LDS_BYTES) != hipSuccess) { fprintf(stderr, "kernel_launch: hipFuncSetAttribute failed\n"); grid = -1; return; }
        if (hipOccupancyMaxActiveBlocksPerMultiprocessor(&per_cu, (const void*)mk_fwd, NWAVES * 64, LDS_BYTES) != hipSuccess || per_cu < 1)
            fprintf(stderr, "kernel_launch: note: occupancy query reports %d workgroups per CU\n", per_cu);
        (void)hipGetLastError();
        grid = cus;
        if (grid != 256) { fprintf(stderr, "kernel_launch: built for 256 CUs, found %d\n", cus); grid = -1; return; }
    }
    if (grid < 0) return;
    if (hipMemsetAsync((char*)d_ws + WS_CTL, 0, CTL_ZERO_BYTES, stream) != hipSuccess) { fprintf(stderr, "kernel_launch: memset failed\n"); return; }
    Args a{};
    for (int i = 0; i < N_IN_TENSORS; ++i) a.in[i] = (const float*)d_in[i];
    a.out = (float*)d_out; a.ws = (unsigned char*)d_ws;
#if MK_PER_PHASE
#ifndef STOP_PHASE
#define STOP_PHASE PH_FINAL
#endif
    for (int ph = 0; ph < N_PHASES; ++ph) { if (ph >= STOP_PHASE && ph != PH_FINAL) continue; a.ph_lo = ph; a.ph_hi = ph + 1; hipLaunchKernelGGL(mk_fwd, dim3(grid), dim3(NWAVES * 64), LDS_BYTES, stream, a); }
#else
    a.ph_lo = 0; a.ph_hi = N_PHASES; hipLaunchKernelGGL(mk_fwd, dim3(grid), dim3(NWAVES * 64), LDS_BYTES, stream, a);
#endif
    const hipError_t le = hipPeekAtLastError();
    if (le != hipSuccess) fprintf(stderr, "kernel_launch: launch failed: %s\n", hipGetErrorName(le));
}
```
